# Optimizing an MI355X kernel written in HIP

```python
import jax, jax.numpy as jnp
from jax import lax
import numpy as np

D_MODEL = 1024
BATCH = 32
SEQ = 2048
DEPTH = 2

PLE_DIM = 256
BLOCK = 128
EPS = 1e-6
NEG = -1e30

SWA_HEADS = 8
SWA_KV_HEADS = 2
SWA_HEAD_DIM = 64
SWA_WINDOW = 128
SWA_WIDTH = SWA_HEADS * SWA_HEAD_DIM
SWA_KV_WIDTH = SWA_KV_HEADS * SWA_HEAD_DIM

MLA_HEADS = 8
MLA_NOPE = 64
MLA_ROPE = 32
MLA_V = 64
MLA_Q_LORA = 256
MLA_KV_LORA = 128
MLA_WIDTH = MLA_HEADS * MLA_V
MLA_QK = MLA_NOPE + MLA_ROPE
ROPE_THETA = 10000.0

IN_SIZES = (SWA_WIDTH, SWA_KV_WIDTH, SWA_KV_WIDTH, SWA_WIDTH,
            MLA_Q_LORA, MLA_KV_LORA, MLA_ROPE, MLA_WIDTH,
            D_MODEL, D_MODEL)
IN_WIDTH = sum(IN_SIZES)

kernel_name = "hybrid_swa_sink_mla_gated_merge"


def rms_norm(x, g):
    xf = x.astype(jnp.float32)
    y = xf * lax.rsqrt(jnp.mean(xf * xf, axis=-1, keepdims=True) + EPS)
    return (y * g.astype(jnp.float32)).astype(x.dtype)


def split_columns(z, sizes):
    idx = []
    acc = 0
    for sz in sizes[:-1]:
        acc += sz
        idx.append(acc)
    return jnp.split(z, idx, axis=-1)


def alibi_slopes(n):
    return jnp.exp2(-8.0 * (jnp.arange(n, dtype=jnp.float32) + 1.0) / n)


def apply_rope(x, pos):
    r = x.shape[-1]
    inv = ROPE_THETA ** (-jnp.arange(0, r, 2, dtype=jnp.float32) / r)
    ang = pos.astype(jnp.float32)[..., None] * inv
    cos = jnp.cos(ang)[:, :, None, :]
    sin = jnp.sin(ang)[:, :, None, :]
    xf = x.astype(jnp.float32)
    x1, x2 = xf[..., : r // 2], xf[..., r // 2:]
    out = jnp.concatenate([x1 * cos - x2 * sin, x2 * cos + x1 * sin], axis=-1)
    return out.astype(x.dtype)


def swa_sink_attention(q, k, v, sink, pos):
    b, s, h, dh = q.shape
    kvh = k.shape[2]
    g = h // kvh
    nb = s // BLOCK
    qb = q.reshape(b, nb, BLOCK, kvh, g, dh)

    def band(t):
        tail = t.shape[2:]
        pad = jnp.zeros((b, BLOCK) + tail, t.dtype)
        prev = jnp.concatenate([pad, t[:, :-BLOCK]], axis=1).reshape((b, nb, BLOCK) + tail)
        cur = t.reshape((b, nb, BLOCK) + tail)
        return jnp.concatenate([prev, cur], axis=2)

    kb, vb, pk = band(k), band(v), band(pos)
    pq = pos.reshape(b, nb, BLOCK)
    scores = jnp.einsum('bnqkgd,bnskd->bnkgqs', qb, kb,
                        preferred_element_type=jnp.float32) * (dh ** -0.5)
    dist = (pq[:, :, :, None] - pk[:, :, None, :]).astype(jnp.float32)
    slopes = alibi_slopes(h).reshape(kvh, g)
    scores = scores - slopes[None, None, :, :, None, None] * dist[:, :, None, None, :, :]
    n_i = jnp.arange(nb)[:, None, None]
    q_i = jnp.arange(BLOCK)[None, :, None]
    k_j = jnp.arange(2 * BLOCK)[None, None, :]
    t_abs = n_i * BLOCK + q_i
    s_abs = n_i * BLOCK - BLOCK + k_j
    valid = (s_abs >= 0) & (s_abs <= t_abs) & (t_abs - s_abs < SWA_WINDOW)
    scores = jnp.where(valid[None, :, None, None, :, :], scores, NEG)
    sink_b = sink.astype(jnp.float32).reshape(kvh, g)[None, None, :, :, None]
    m = jnp.maximum(jnp.max(scores, axis=-1), sink_b)
    e = jnp.exp(scores - m[..., None])
    denom = jnp.sum(e, axis=-1) + jnp.exp(sink_b - m)
    probs = e / denom[..., None]
    out = jnp.einsum('bnkgqs,bnskd->bnqkgd', probs.astype(v.dtype), vb)
    return out.reshape(b, s, h * dh)


def mla_causal_attention(q, k, v):
    b, s, h, dq = q.shape
    nb = s // BLOCK
    qb = q.reshape(b, nb, BLOCK, h, dq).transpose(1, 0, 2, 3, 4)
    kpos = jnp.arange(s)
    scale = dq ** -0.5

    def one_block(args):
        qblk, n = args
        sc = jnp.einsum('bqhd,bshd->bhqs', qblk, k,
                        preferred_element_type=jnp.float32) * scale
        qpos = n * BLOCK + jnp.arange(BLOCK)
        sc = jnp.where(kpos[None, :] <= qpos[:, None], sc, NEG)
        pr = jax.nn.softmax(sc, axis=-1)
        return jnp.einsum('bhqs,bshd->bqhd', pr.astype(v.dtype), v)

    out = lax.map(one_block, (qb, jnp.arange(nb)))
    return out.transpose(1, 0, 2, 3, 4).reshape(b, s, h * v.shape[-1])


def setup_inputs(seed: int = 0) -> dict:
    key = jax.random.key(seed)
    ks = jax.random.split(key, 20)
    f32 = jnp.float32

    def nrm(k, shape, fan_in):
        return jax.random.normal(k, shape, f32) * (fan_in ** -0.5)

    def gain(k, shape):
        return 1.0 + 0.02 * jax.random.normal(k, shape, f32)

    x = jax.random.normal(ks[0], (BATCH, SEQ, D_MODEL), f32)
    p = jax.random.normal(ks[1], (DEPTH, BATCH, SEQ, PLE_DIM), f32)
    positions = jnp.broadcast_to(jnp.arange(SEQ, dtype=jnp.int32)[None, :], (BATCH, SEQ))
    return {
        "x": x,
        "p": p,
        "positions": positions,
        "g_mix": gain(ks[2], (DEPTH, D_MODEL)),
        "w_in": nrm(ks[3], (DEPTH, D_MODEL, IN_WIDTH), D_MODEL),
        "sink": 0.5 * jax.random.normal(ks[4], (DEPTH, SWA_HEADS), f32),
        "g_q": gain(ks[5], (DEPTH, MLA_Q_LORA)),
        "w_uq": nrm(ks[6], (DEPTH, MLA_Q_LORA, MLA_HEADS * MLA_QK), MLA_Q_LORA),
        "g_kv": gain(ks[7], (DEPTH, MLA_KV_LORA)),
        "w_ukv": nrm(ks[8], (DEPTH, MLA_KV_LORA, MLA_HEADS * (MLA_NOPE + MLA_V)), MLA_KV_LORA),
        "w_br_a": nrm(ks[9], (DEPTH, SWA_WIDTH, D_MODEL), SWA_WIDTH),
        "w_br_b": nrm(ks[10], (DEPTH, MLA_WIDTH, D_MODEL), MLA_WIDTH),
        "w_out": nrm(ks[11], (DEPTH, D_MODEL, D_MODEL), D_MODEL),
        "g_ple": gain(ks[12], (DEPTH, D_MODEL)),
        "w_ple_gate": nrm(ks[13], (DEPTH, D_MODEL, D_MODEL), D_MODEL),
        "w_ple_proj": nrm(ks[14], (DEPTH, PLE_DIM, D_MODEL), PLE_DIM),
        "g_final": gain(ks[15], (D_MODEL,)),
    }


def reference(x, p, positions, g_mix, w_in, sink, g_q, w_uq, g_kv, w_ukv,
              w_br_a, w_br_b, w_out, g_ple, w_ple_gate, w_ple_proj, g_final):
    b, s, _ = x.shape
    for i in range(DEPTH):
        h = rms_norm(x, g_mix[i])
        z = h @ w_in[i]
        (a_q, a_k, a_v, a_gate, b_qd, b_kvd, b_kr, b_gate,
         m_a, m_b) = split_columns(z, IN_SIZES)

        qa = a_q.reshape(b, s, SWA_HEADS, SWA_HEAD_DIM)
        ka = a_k.reshape(b, s, SWA_KV_HEADS, SWA_HEAD_DIM)
        va = a_v.reshape(b, s, SWA_KV_HEADS, SWA_HEAD_DIM)
        o_a = swa_sink_attention(qa, ka, va, sink[i], positions) * jax.nn.silu(a_gate)

        qb = (rms_norm(b_qd, g_q[i]) @ w_uq[i]).reshape(b, s, MLA_HEADS, MLA_QK)
        q_nope, q_rope = qb[..., :MLA_NOPE], qb[..., MLA_NOPE:]
        q_rope = apply_rope(q_rope, positions)
        kv = (rms_norm(b_kvd, g_kv[i]) @ w_ukv[i]).reshape(b, s, MLA_HEADS, MLA_NOPE + MLA_V)
        k_nope, vb = kv[..., :MLA_NOPE], kv[..., MLA_NOPE:]
        k_rope = apply_rope(b_kr[:, :, None, :], positions)
        q_full = jnp.concatenate([q_nope, q_rope], axis=-1)
        k_full = jnp.concatenate(
            [k_nope, jnp.broadcast_to(k_rope, (b, s, MLA_HEADS, MLA_ROPE))], axis=-1)
        o_b = mla_causal_attention(q_full, k_full, vb) * jax.nn.silu(b_gate)

        y = jax.nn.sigmoid(m_a) * (o_a @ w_br_a[i]) + jax.nn.sigmoid(m_b) * (o_b @ w_br_b[i])
        x = x + y @ w_out[i]

        pg = jax.nn.sigmoid(rms_norm(x, g_ple[i]) @ w_ple_gate[i])
        x = x + pg * (p[i].astype(x.dtype) @ w_ple_proj[i])
    return rms_norm(x, g_final)
```

```cpp
#include <hip/hip_runtime.h>
#include <hip/hip_cooperative_groups.h>
#include <cstdio>
#include <cstdint>
namespace cg = cooperative_groups;

#ifndef PHMASK
#define PHMASK 255
#endif
#ifndef ONE_LAUNCH
#define ONE_LAUNCH 1
#endif

#define LAS __attribute__((address_space(3)))
typedef unsigned short bf16_t;
typedef short bf16x8 __attribute__((ext_vector_type(8)));
typedef float f32x4 __attribute__((ext_vector_type(4)));
typedef float f32x16 __attribute__((ext_vector_type(16)));
typedef unsigned u32x4 __attribute__((ext_vector_type(4)));
typedef unsigned u32x2 __attribute__((ext_vector_type(2)));

constexpr int BATCH = 32, SEQ = 2048, T = BATCH * SEQ, D = 1024, DEPTH = 2, PLE = 256;
constexpr int ZW = 4352;
constexpr int ZC_QA = 0, ZC_KA = 512, ZC_VA = 640, ZC_GA = 768, ZC_BQD = 1280, ZC_BKVD = 1536, ZC_KR = 1664, ZC_GB = 1792, ZC_MA = 2304, ZC_MB = 3328;
constexpr int ZC_X1B = ZC_MA, ZC_T2 = 0;
constexpr int IN_WIDTH = 4256;
constexpr float EPS = 1e-6f;
constexpr float LOG2E = 1.4426950408889634f;

constexpr size_t WO_IN = 0, WO_UQ = WO_IN + (size_t)ZW * 1024, WO_UKV = WO_UQ + 768 * 256, WO_A = WO_UKV + 1024 * 128, WO_B = WO_A + 1024 * 512,
                 WO_OUT = WO_B + 1024 * 512, WO_PG = WO_OUT + 1024 * 1024, WO_PP = WO_PG + 1024 * 1024, WO_END = WO_PP + 1024 * 256;
constexpr size_t MiB = 1u << 20;
constexpr size_t WS_W = 0, WS_SSXA = 32 * MiB, WS_SSXB = 36 * MiB, WS_SSQ = 40 * MiB, WS_SSKV = 41 * MiB, WS_PB = 42 * MiB, WS_XB = 106 * MiB,
                 WS_QB = 234 * MiB, WS_KVB = 330 * MiB, WS_Z = 458 * MiB, WS_END = 1002 * MiB;
static_assert(2 * WO_END * 2 <= 32 * MiB, "weights fit");
static_assert((size_t)T * ZW * 2 == 544 * MiB, "Z size");

struct Params {
    const float* x; const float* p; const int* pos;
    const float *g_mix, *w_in, *sink, *g_q, *w_uq, *g_kv, *w_ukv, *w_br_a, *w_br_b, *w_out, *g_ple, *w_ple_gate, *w_ple_proj, *g_final;
    float* out; unsigned char* ws;
    int ph_lo, ph_hi;
};

__device__ __forceinline__ unsigned cvt_pk_bf16(float lo, float hi) { unsigned r; asm volatile("v_cvt_pk_bf16_f32 %0, %1, %2" : "=v"(r) : "v"(lo), "v"(hi)); return r; }
__device__ __forceinline__ float bflo(unsigned w) { return __uint_as_float(w << 16); }
__device__ __forceinline__ float bfhi(unsigned w) { return __uint_as_float(w & 0xffff0000u); }
__device__ __forceinline__ float fsigmoid(float x) { return __builtin_amdgcn_rcpf(1.f + __expf(-x)); }
__device__ __forceinline__ float fsilu(float x) { return x * fsigmoid(x); }
__device__ __forceinline__ u32x4 pack8(const float* v) { u32x4 w; w.x = cvt_pk_bf16(v[0], v[1]); w.y = cvt_pk_bf16(v[2], v[3]); w.z = cvt_pk_bf16(v[4], v[5]); w.w = cvt_pk_bf16(v[6], v[7]); return w; }
__device__ __forceinline__ void unpack8(u32x4 w, float* v) { v[0] = bflo(w.x); v[1] = bfhi(w.x); v[2] = bflo(w.y); v[3] = bfhi(w.y); v[4] = bflo(w.z); v[5] = bfhi(w.z); v[6] = bflo(w.w); v[7] = bfhi(w.w); }
__device__ __forceinline__ float sum16(const float* s) { const f32x4 a = *(const f32x4*)s, b = *(const f32x4*)(s + 4), c = *(const f32x4*)(s + 8), d = *(const f32x4*)(s + 12);
    return ((a.x + a.y) + (a.z + a.w)) + ((b.x + b.y) + (b.z + b.w)) + ((c.x + c.y) + (c.z + c.w)) + ((d.x + d.y) + (d.z + d.w)); }
__device__ __forceinline__ float sum4(const float* s) { const f32x4 a = *(const f32x4*)s; return (a.x + a.y) + (a.z + a.w); }
__device__ __forceinline__ void rope8(float* v, int i0, float posf) {
#pragma unroll
    for (int j = 0; j < 4; ++j) {
        const float ci = __builtin_amdgcn_exp2f(-(float)(i0 + j) * 0.83048202372184059f) * 0.15915494309189535f;
        float r = posf * ci; r = r - rintf(r);
        const float sn = __builtin_amdgcn_sinf(r), cs = __builtin_amdgcn_cosf(r);
        const float x1 = v[2 * j], x2 = v[2 * j + 1];
        v[2 * j] = x1 * cs - x2 * sn; v[2 * j + 1] = x2 * cs + x1 * sn;
    }
}

namespace pg8 {
constexpr int BM = 256, BK = 64, HALF = 128, HTB = HALF * BK * 2, STAGE_BYTES = 8 * HTB, NXCD = 8, WGM = 8;
__host__ __device__ __forceinline__ int lds_byte(int r, int c) { const int st = (r >> 4) * 2 + (c >> 5), rr = r & 15, cc = c & 31, ob = rr * 64 + cc * 2; return st * 1024 + (ob ^ (((ob >> 9) & 1) << 5)); }
__host__ __device__ __forceinline__ void stage_rc(int b, int& R, int& C) { const int st = b / 1024, sb = b % 1024, swz = sb ^ (((sb >> 9) & 1) << 5); R = (st >> 1) * 16 + swz / 64; C = (st & 1) * 32 + (swz % 64) / 2; }
__host__ __device__ __forceinline__ int perm32(int rho) { const int n = rho >> 4, i = rho & 15; return 8 * (i >> 2) + 4 * n + (i & 3); }

struct Unit { int pm, pn; };
struct Gemm { const bf16_t* A; const bf16_t* Bt; int M, N, K, lda; };

struct StaticOrder {
    int nM, nN, nwg, G, c;
    __host__ __device__ void init(int M, int N, int G_, int c_) { nM = M / BM; nN = N / BM; nwg = nM * nN; G = G_; c = c_; }
    __host__ __device__ bool next(int i, Unit& u) const {
        const long L = (long)i * G + c; if (L >= nwg) return false;
        int wgid = (int)L; { const int q = nwg / NXCD, r = nwg % NXCD, xcd = wgid % NXCD, off = wgid / NXCD; wgid = (xcd < r ? xcd * (q + 1) : r * (q + 1) + (xcd - r) * q) + off; }
        const int nig = WGM * nN, gid = wgid / nig, fm = gid * WGM, gsz = (nM - fm) < WGM ? (nM - fm) : WGM;
        u.pm = fm + ((wgid % nig) % gsz); u.pn = (wgid % nig) / gsz; return true;
    }
};

template <class Epi>
__device__ __forceinline__ void gemm_phase(LAS unsigned char* lds, const Gemm g, const StaticOrder& S, const Epi& E) {
    int tid_ = threadIdx.x; asm volatile("" : "+v"(tid_));
    const int tid = tid_, wid = __builtin_amdgcn_readfirstlane(tid >> 6), lane = tid & 63, wr = wid >> 2, wc = wid & 3, fr = lane & 15, fq = lane >> 4;
    const int K = g.K, nt = K / BK, lda = g.lda;
    unsigned voffA[2], voffB[2];
#pragma unroll
    for (int i = 0; i < 2; ++i) { int R, C; stage_rc(tid * 16 + i * 8192, R, C); const int Rb = (R & ~31) + perm32(R & 31);
        voffA[i] = (unsigned)(R * lda + C) * 2u; voffB[i] = (unsigned)(Rb * K + C) * 2u; }
    const size_t kstep = (size_t)(BK * 2);
    const size_t hstepA = (size_t)HALF * lda * 2, hstepB = (size_t)HALF * K * 2;
    const size_t tstepA = 2 * hstepA, tstepB = 2 * hstepB;
    const unsigned ldsw = (unsigned)wid * 1024u;
    const int aoff = lds_byte(wr * 64 + fr, fq * 8), boff = lds_byte(wc * 32 + fr, fq * 8);
#define PG8_SA(b, h) (((b) * 2 + (h)) * HTB)
#define PG8_SB(b, h) ((4 + (b) * 2 + (h)) * HTB)
#define PG8_STAGE(bufoff, gbase, voff) do { _Pragma("unroll") for (int _i = 0; _i < 2; ++_i) \
        { unsigned vo_ = (voff)[_i]; asm volatile("" : "+v"(vo_)); __builtin_amdgcn_global_load_lds((const unsigned*)((const char*)(gbase) + vo_), (LAS unsigned*)(lds + (bufoff) + ldsw + _i * 8192), 16, 0, 0); } } while (0)
#define PG8_LDA(dst, b, h) do { _Pragma("unroll") for (int m = 0; m < 4; ++m) _Pragma("unroll") for (int k = 0; k < 2; ++k) dst[m][k] = *(const LAS bf16x8*)(lds + PG8_SA(b, h) + aoff + m * 2048 + k * 1024); } while (0)
#define PG8_LDB(dst, b, h) do { _Pragma("unroll") for (int n = 0; n < 2; ++n) _Pragma("unroll") for (int k = 0; k < 2; ++k) dst[n][k] = *(const LAS bf16x8*)(lds + PG8_SB(b, h) + boff + n * 2048 + k * 1024); } while (0)
#define PG8_MMA(ai, bj, At, Bt) do { __builtin_amdgcn_s_setprio(1); _Pragma("unroll") for (int m = 0; m < 4; ++m) _Pragma("unroll") for (int n = 0; n < 2; ++n) _Pragma("unroll") for (int k = 0; k < 2; ++k) \
        acc[ai][bj][m][n] = __builtin_amdgcn_mfma_f32_16x16x32_bf16(Bt[n][k], At[m][k], acc[ai][bj][m][n], 0, 0, 0); __builtin_amdgcn_s_setprio(0); } while (0)
#define PG8_WAIT_V(n) asm volatile("s_waitcnt vmcnt(" #n ")" ::: "memory")
#define PG8_WAIT_L(n) asm volatile("s_waitcnt lgkmcnt(" #n ")" ::: "memory")
#define PG8_BAR __builtin_amdgcn_s_barrier()
#define PG8_SCHED __builtin_amdgcn_sched_barrier(0)
    Unit cur, nxt; int ui = 0;
    if (!S.next(0, cur)) return;
    f32x4 acc[2][2][4][2];
#pragma unroll
    for (int a = 0; a < 2; ++a)
#pragma unroll
        for (int b = 0; b < 2; ++b)
#pragma unroll
            for (int m = 0; m < 4; ++m)
#pragma unroll
                for (int n = 0; n < 2; ++n) acc[a][b][m][n] = (f32x4){0.f, 0.f, 0.f, 0.f};
    bf16x8 At[4][2], B0[2][2], B1[2][2];
    const char* cA = (const char*)g.A + (size_t)cur.pm * tstepA; const char* cB = (const char*)g.Bt + (size_t)cur.pn * tstepB;
    PG8_STAGE(PG8_SB(0, 0), cB, voffB); PG8_STAGE(PG8_SB(0, 1), cB + hstepB, voffB); PG8_STAGE(PG8_SA(0, 0), cA, voffA); PG8_STAGE(PG8_SA(0, 1), cA + hstepA, voffA);
    if (wr == 1) PG8_BAR;
    PG8_WAIT_V(2); PG8_BAR;
    PG8_STAGE(PG8_SB(1, 0), cB + kstep, voffB); PG8_STAGE(PG8_SA(1, 0), cA + kstep, voffA); PG8_STAGE(PG8_SB(1, 1), cB + hstepB + kstep, voffB);
    PG8_WAIT_V(6); PG8_BAR;
    for (;;) {
        const bool has_next = S.next(ui + 1, nxt);
        const char* nA = has_next ? (const char*)g.A + (size_t)nxt.pm * tstepA : cA; const char* nB = has_next ? (const char*)g.Bt + (size_t)nxt.pn * tstepB : cB;
        for (int t = 0; t < nt; t += 2) {
            const bool last = (t == nt - 2);
            const char* a1 = cA + (size_t)(t + 1) * kstep;
            const char* a2 = last ? nA : cA + (size_t)(t + 2) * kstep; const char* b2 = last ? nB : cB + (size_t)(t + 2) * kstep;
            const char* a3 = a2 + kstep; const char* b3 = b2 + kstep;
            PG8_LDB(B0, 0, 0); PG8_LDB(B1, 0, 1); PG8_SCHED; PG8_LDA(At, 0, 0); PG8_STAGE(PG8_SA(1, 1), a1 + hstepA, voffA);
            PG8_WAIT_V(8); PG8_WAIT_L(0); PG8_BAR; PG8_MMA(0, 0, At, B0); PG8_MMA(0, 1, At, B1); PG8_BAR; PG8_SCHED;
            PG8_LDA(At, 0, 1); PG8_STAGE(PG8_SB(0, 0), b2, voffB); PG8_STAGE(PG8_SB(0, 1), b2 + hstepB, voffB); PG8_STAGE(PG8_SA(0, 0), a2, voffA);
            PG8_WAIT_V(8); PG8_WAIT_L(0); PG8_BAR; PG8_MMA(1, 0, At, B0); PG8_MMA(1, 1, At, B1); PG8_BAR; PG8_SCHED;
            PG8_LDB(B0, 1, 0); PG8_LDB(B1, 1, 1); PG8_SCHED; PG8_LDA(At, 1, 0); PG8_STAGE(PG8_SA(0, 1), a2 + hstepA, voffA);
            PG8_WAIT_V(8); PG8_WAIT_L(0); PG8_BAR; PG8_MMA(0, 0, At, B0); PG8_MMA(0, 1, At, B1); PG8_BAR; PG8_SCHED;
            PG8_LDA(At, 1, 1); PG8_STAGE(PG8_SB(1, 0), b3, voffB); PG8_STAGE(PG8_SB(1, 1), b3 + hstepB, voffB); PG8_STAGE(PG8_SA(1, 0), a3, voffA);
            PG8_WAIT_V(8); PG8_WAIT_L(0); PG8_BAR; PG8_MMA(1, 0, At, B0); PG8_MMA(1, 1, At, B1); PG8_BAR; PG8_SCHED;
        }
        if (wr == 0) PG8_BAR;
        E(acc, cur, wr, wc, fr, fq);
        if (!has_next) break;
#pragma unroll
        for (int a = 0; a < 2; ++a)
#pragma unroll
            for (int b = 0; b < 2; ++b)
#pragma unroll
                for (int m = 0; m < 4; ++m)
#pragma unroll
                    for (int n = 0; n < 2; ++n) acc[a][b][m][n] = (f32x4){0.f, 0.f, 0.f, 0.f};
        cur = nxt; cA = nA; cB = nB; ++ui;
        if (wr == 1) PG8_BAR;
    }
    PG8_WAIT_V(0);
    PG8_BAR;
#undef PG8_SA
#undef PG8_SB
#undef PG8_STAGE
#undef PG8_LDA
#undef PG8_LDB
#undef PG8_MMA
#undef PG8_WAIT_V
#undef PG8_WAIT_L
#undef PG8_BAR
#undef PG8_SCHED
}
}

typedef f32x4 Acc[2][2][4][2];
#define EPI_ROWS(u, wr, fr) const int row0_ = (u).pm * 256 + (wr) * 64 + (fr);
#define EPI_FOR_ROWS _Pragma("unroll") for (int ai = 0; ai < 2; ++ai) _Pragma("unroll") for (int m = 0; m < 4; ++m) if (epi_fence())
__device__ __forceinline__ bool epi_fence() { asm volatile("" ::: "memory"); return true; }
#define EPI_LOADV(v) float v[8]; { const f32x4 a0_ = acc[ai][bj][m][0], a1_ = acc[ai][bj][m][1]; v[0] = a0_[0]; v[1] = a0_[1]; v[2] = a0_[2]; v[3] = a0_[3]; v[4] = a1_[0]; v[5] = a1_[1]; v[6] = a1_[2]; v[7] = a1_[3]; }

struct EpiZ {
    bf16_t* Z; const float* ssx; float* ssq; float* sskv; const int* pos;
    __device__ __forceinline__ void operator()(const Acc& acc, const pg8::Unit& u, int wr, int wc, int fr, int fq) const {
        EPI_ROWS(u, wr, fr)
        const int pn = u.pn;
        const int cbase = pn * 256 + wc * 32 + 8 * fq;
        EPI_FOR_ROWS {
            const int row = row0_ + ai * 128 + m * 16;
            const float rstd = rsqrtf(sum16(ssx + (size_t)row * 16) * (1.f / 1024.f) + EPS);
            bf16_t* zr = Z + (size_t)row * ZW + cbase;
            float st = 0.f;
#pragma unroll
            for (int bj = 0; bj < 2; ++bj) {
                EPI_LOADV(v)
#pragma unroll
                for (int j = 0; j < 8; ++j) v[j] *= rstd;
                bool store = true;
                if (pn <= 1) {
#pragma unroll
                    for (int j = 0; j < 8; ++j) v[j] *= (0.125f * LOG2E);
                } else if (pn == 3 || pn == 4 || pn == 7 || pn == 8) {
#pragma unroll
                    for (int j = 0; j < 8; ++j) v[j] = fsilu(v[j]);
                } else if (pn >= 9) {
#pragma unroll
                    for (int j = 0; j < 8; ++j) v[j] = fsigmoid(v[j]);
                } else if (pn == 5) {
#pragma unroll
                    for (int j = 0; j < 8; ++j) st += v[j] * v[j];
                } else if (pn == 6) {
                    if (bj == 0) {
#pragma unroll
                        for (int j = 0; j < 8; ++j) st += v[j] * v[j];
                    } else {
                        if (wc == 0) rope8(v, 4 * fq, (float)pos[row]); else store = false;
                    }
                }
                if (store) *(u32x4*)(zr + bj * 128) = pack8(v);
            }
            if (pn == 5 || pn == 6) {
                st += __shfl_xor(st, 16); st += __shfl_xor(st, 32);
                if (fq == 0) { if (pn == 5) ssq[(size_t)row * 4 + wc] = st; else sskv[(size_t)row * 4 + wc] = st; }
            }
        }
    }
};
struct EpiQB {
    bf16_t* QB; const float* ssq; const int* pos;
    __device__ __forceinline__ void operator()(const Acc& acc, const pg8::Unit& u, int wr, int wc, int fr, int fq) const {
        EPI_ROWS(u, wr, fr)
        const int cbase = u.pn * 256 + wc * 32 + 8 * fq;
        EPI_FOR_ROWS {
            const int row = row0_ + ai * 128 + m * 16;
            const float rstd = rsqrtf(sum4(ssq + (size_t)row * 4) * (1.f / 256.f) + EPS) * (0.10206207261596577f * LOG2E);
            const float posf = (float)pos[row];
#pragma unroll
            for (int bj = 0; bj < 2; ++bj) {
                EPI_LOADV(v)
#pragma unroll
                for (int j = 0; j < 8; ++j) v[j] *= rstd;
                const int c = cbase + bj * 128, cc = c % 96;
                if (cc >= 64) rope8(v, (cc - 64) >> 1, posf);
                *(u32x4*)(QB + (size_t)row * 768 + c) = pack8(v);
            }
        }
    }
};
struct EpiKVB {
    bf16_t* KVB; const float* sskv;
    __device__ __forceinline__ void operator()(const Acc& acc, const pg8::Unit& u, int wr, int wc, int fr, int fq) const {
        EPI_ROWS(u, wr, fr)
        const int cbase = u.pn * 256 + wc * 32 + 8 * fq;
        EPI_FOR_ROWS {
            const int row = row0_ + ai * 128 + m * 16;
            const float rstd = rsqrtf(sum4(sskv + (size_t)row * 4) * (1.f / 128.f) + EPS);
#pragma unroll
            for (int bj = 0; bj < 2; ++bj) {
                EPI_LOADV(v)
#pragma unroll
                for (int j = 0; j < 8; ++j) v[j] *= rstd;
                *(u32x4*)(KVB + (size_t)row * 1024 + cbase + bj * 128) = pack8(v);
            }
        }
    }
};
template <int SECOND> struct EpiMerge {
    bf16_t* Z;
    __device__ __forceinline__ void operator()(const Acc& acc, const pg8::Unit& u, int wr, int wc, int fr, int fq) const {
        EPI_ROWS(u, wr, fr)
        const int cbase = u.pn * 256 + wc * 32 + 8 * fq;
        EPI_FOR_ROWS {
            const int row = row0_ + ai * 128 + m * 16;
            bf16_t* zr = Z + (size_t)row * ZW + cbase;
#pragma unroll
            for (int bj = 0; bj < 2; ++bj) {
                EPI_LOADV(v)
                float s[8]; unpack8(*(const u32x4*)(zr + (SECOND ? ZC_MB : ZC_MA) + bj * 128), s);
#pragma unroll
                for (int j = 0; j < 8; ++j) v[j] *= s[j];
                if (SECOND) { float t[8]; unpack8(*(const u32x4*)(zr + ZC_MA + bj * 128), t);
#pragma unroll
                    for (int j = 0; j < 8; ++j) v[j] += t[j]; }
                *(u32x4*)(zr + (SECOND ? ZC_MB : ZC_MA) + bj * 128) = pack8(v);
            }
        }
    }
};
struct EpiX1 {
    const float* xin; float* xout; bf16_t* Z; float* ssb;
    __device__ __forceinline__ void operator()(const Acc& acc, const pg8::Unit& u, int wr, int wc, int fr, int fq) const {
        EPI_ROWS(u, wr, fr)
        const int cbase = u.pn * 256 + wc * 32 + 8 * fq;
        EPI_FOR_ROWS {
            const int row = row0_ + ai * 128 + m * 16;
            float st = 0.f;
#pragma unroll
            for (int bj = 0; bj < 2; ++bj) {
                EPI_LOADV(v)
                const size_t off = (size_t)row * D + cbase + bj * 128;
                const f32x4 x0 = *(const f32x4*)(xin + off), x1 = *(const f32x4*)(xin + off + 4);
                v[0] += x0[0]; v[1] += x0[1]; v[2] += x0[2]; v[3] += x0[3]; v[4] += x1[0]; v[5] += x1[1]; v[6] += x1[2]; v[7] += x1[3];
#pragma unroll
                for (int j = 0; j < 8; ++j) st += v[j] * v[j];
                *(f32x4*)(xout + off) = (f32x4){v[0], v[1], v[2], v[3]}; *(f32x4*)(xout + off + 4) = (f32x4){v[4], v[5], v[6], v[7]};
                *(u32x4*)(Z + (size_t)row * ZW + ZC_X1B + cbase + bj * 128) = pack8(v);
            }
            st += __shfl_xor(st, 16); st += __shfl_xor(st, 32);
            if (fq == 0) ssb[(size_t)row * 16 + u.pn * 4 + wc] = st;
        }
    }
};
struct EpiPP {
    bf16_t* Z;
    __device__ __forceinline__ void operator()(const Acc& acc, const pg8::Unit& u, int wr, int wc, int fr, int fq) const {
        EPI_ROWS(u, wr, fr)
        const int cbase = u.pn * 256 + wc * 32 + 8 * fq;
        EPI_FOR_ROWS {
            const int row = row0_ + ai * 128 + m * 16;
#pragma unroll
            for (int bj = 0; bj < 2; ++bj) { EPI_LOADV(v) *(u32x4*)(Z + (size_t)row * ZW + ZC_T2 + cbase + bj * 128) = pack8(v); }
        }
    }
};
struct EpiX2 {
    float* xio; const bf16_t* Z; bf16_t* xb; const float* ssb; float* ssa;
    __device__ __forceinline__ void operator()(const Acc& acc, const pg8::Unit& u, int wr, int wc, int fr, int fq) const {
        EPI_ROWS(u, wr, fr)
        const int cbase = u.pn * 256 + wc * 32 + 8 * fq;
        EPI_FOR_ROWS {
            const int row = row0_ + ai * 128 + m * 16;
            const float rstd = rsqrtf(sum16(ssb + (size_t)row * 16) * (1.f / 1024.f) + EPS);
            float st = 0.f;
#pragma unroll
            for (int bj = 0; bj < 2; ++bj) {
                EPI_LOADV(v)
                const size_t off = (size_t)row * D + cbase + bj * 128;
                float t[8]; unpack8(*(const u32x4*)(Z + (size_t)row * ZW + ZC_T2 + cbase + bj * 128), t);
                const f32x4 x0 = *(const f32x4*)(xio + off), x1 = *(const f32x4*)(xio + off + 4);
                const float xv[8] = {x0[0], x0[1], x0[2], x0[3], x1[0], x1[1], x1[2], x1[3]};
#pragma unroll
                for (int j = 0; j < 8; ++j) { v[j] = xv[j] + fsigmoid(v[j] * rstd) * t[j]; st += v[j] * v[j]; }
                *(f32x4*)(xio + off) = (f32x4){v[0], v[1], v[2], v[3]}; *(f32x4*)(xio + off + 4) = (f32x4){v[4], v[5], v[6], v[7]};
                *(u32x4*)(xb + off) = pack8(v);
            }
            st += __shfl_xor(st, 16); st += __shfl_xor(st, 32);
            if (fq == 0) ssa[(size_t)row * 16 + u.pn * 4 + wc] = st;
        }
    }
};

namespace att {
constexpr int VROW = 68;
template <int MODE> struct Cfg { static constexpr int DQK = MODE == 0 ? 96 : 64, KROW = DQK + 8, KBUF = 64 * KROW * 2, VBUF = 64 * VROW * 2, PBUF = 256, BUF = KBUF + VBUF + PBUF; };

template <int MODE>
__device__ __forceinline__ void attn_unit(LAS unsigned char* lds, const bf16_t* QB, const bf16_t* KVB, bf16_t* Z, const int* pos, const float* sink, int b, int hk, int qblk) {
    typedef Cfg<MODE> C;
    constexpr int DQK = C::DQK, KROW = C::KROW, NKS = DQK / 16;
    int tid_ = threadIdx.x; asm volatile("" : "+v"(tid_));
    const int tid = tid_, w = __builtin_amdgcn_readfirstlane(tid >> 6), lane = tid & 63, lq = lane & 31, hh = lane >> 5;
    const size_t tok0 = (size_t)b * SEQ;
    int q0, wq0, hq;
    if (MODE == 0) { q0 = qblk * 256; wq0 = q0 + 32 * w; hq = hk; }
    else { q0 = qblk * 64; wq0 = q0 + 32 * (w >> 2); hq = hk * 4 + (w & 3); }
    const int qq = wq0 + lq;
    const size_t tq = tok0 + qq;
    bf16x8 qf[NKS];
#pragma unroll
    for (int ks = 0; ks < NKS; ++ks) {
        if (MODE == 0) qf[ks] = *(const bf16x8*)(QB + tq * 768 + hq * 96 + ks * 16 + hh * 8);
        else qf[ks] = *(const bf16x8*)(Z + tq * ZW + ZC_QA + hq * 64 + ks * 16 + hh * 8);
    }
    int j0, j1;
    if (MODE == 0) { j0 = 0; j1 = (q0 + 256) / 64 - 1; } else { j0 = q0 / 64 - 2; if (j0 < 0) j0 = 0; j1 = q0 / 64; }
    float slope_l2 = 0.f, pqf = 0.f, mrun, lrun;
    if (MODE == 1) { slope_l2 = exp2f(-(float)(hq + 1)) * LOG2E; pqf = (float)pos[tq]; mrun = sink[hq] * LOG2E; lrun = hh == 0 ? 1.f : 0.f; }
    else { mrun = -1e30f; lrun = 0.f; }
    f32x16 O0, O1;
#pragma unroll
    for (int i = 0; i < 16; ++i) { O0[i] = 0.f; O1[i] = 0.f; }

    u32x4 sk0, sk1, sv; int sp = 0;
    sk1 = (u32x4){0u, 0u, 0u, 0u};
    const int vkey = tid >> 3, vpart = tid & 7;
#define ATT_LOAD(j) do { const size_t kt = tok0 + (size_t)(j) * 64; \
        if (MODE == 0) { { const int key = tid / 12, part = tid % 12; const bf16_t* s = part < 8 ? KVB + (kt + key) * 1024 + hk * 128 + part * 8 : Z + (kt + key) * ZW + ZC_KR + (part - 8) * 8; sk0 = *(const u32x4*)s; } \
            if (tid < 256) { const int c2 = tid + 512, key = c2 / 12, part = c2 % 12; const bf16_t* s = part < 8 ? KVB + (kt + key) * 1024 + hk * 128 + part * 8 : Z + (kt + key) * ZW + ZC_KR + (part - 8) * 8; sk1 = *(const u32x4*)s; } \
            sv = *(const u32x4*)(KVB + (kt + vkey) * 1024 + hk * 128 + 64 + vpart * 8); } \
        else { sk0 = *(const u32x4*)(Z + (kt + vkey) * ZW + ZC_KA + hk * 64 + vpart * 8); sv = *(const u32x4*)(Z + (kt + vkey) * ZW + ZC_VA + hk * 64 + vpart * 8); if (tid < 64) sp = pos[kt + tid]; } } while (0)
#define ATT_STORE(bufi) do { LAS unsigned char* bb = lds + (bufi) * C::BUF; LAS bf16_t* Kb = (LAS bf16_t*)bb; LAS bf16_t* Vt = (LAS bf16_t*)(bb + C::KBUF); \
        if (MODE == 0) { { const int key = tid / 12, part = tid % 12; *(LAS u32x4*)(Kb + key * KROW + part * 8) = sk0; } \
            if (tid < 256) { const int c2 = tid + 512, key = c2 / 12, part = c2 % 12; *(LAS u32x4*)(Kb + key * KROW + part * 8) = sk1; } } \
        else { *(LAS u32x4*)(Kb + vkey * KROW + vpart * 8) = sk0; if (tid < 64) ((LAS int*)(bb + C::KBUF + C::VBUF))[tid] = sp; } \
        { LAS bf16_t* vp = Vt + (vpart * 8) * VROW + vkey; \
          vp[0 * VROW] = (bf16_t)(sv.x & 0xffffu); vp[1 * VROW] = (bf16_t)(sv.x >> 16); vp[2 * VROW] = (bf16_t)(sv.y & 0xffffu); vp[3 * VROW] = (bf16_t)(sv.y >> 16); \
          vp[4 * VROW] = (bf16_t)(sv.z & 0xffffu); vp[5 * VROW] = (bf16_t)(sv.z >> 16); vp[6 * VROW] = (bf16_t)(sv.w & 0xffffu); vp[7 * VROW] = (bf16_t)(sv.w >> 16); } } while (0)

    ATT_LOAD(j0);
    ATT_STORE(0);
    __syncthreads();
    for (int j = j0; j <= j1; ++j) {
        const int bufi = (j - j0) & 1;
        if (j < j1) ATT_LOAD(j + 1);
        const int k0 = j * 64;
        const bool active = (MODE == 1) || (k0 <= wq0 + 31);
        if (active) {
            LAS unsigned char* bb = lds + bufi * C::BUF; const LAS bf16_t* Kb = (const LAS bf16_t*)bb; const LAS bf16_t* Vt = (const LAS bf16_t*)(bb + C::KBUF);
            f32x16 S0, S1;
#pragma unroll
            for (int i = 0; i < 16; ++i) { S0[i] = 0.f; S1[i] = 0.f; }
#pragma unroll
            for (int ks = 0; ks < NKS; ++ks) {
                const bf16x8 ka = *(const LAS bf16x8*)(Kb + lq * KROW + ks * 16 + hh * 8);
                const bf16x8 kb2 = *(const LAS bf16x8*)(Kb + (32 + lq) * KROW + ks * 16 + hh * 8);
                S0 = __builtin_amdgcn_mfma_f32_32x32x16_bf16(ka, qf[ks], S0, 0, 0, 0);
                S1 = __builtin_amdgcn_mfma_f32_32x32x16_bf16(kb2, qf[ks], S1, 0, 0, 0);
            }
            if (MODE == 1) {
                const LAS int* pk = (const LAS int*)(bb + C::KBUF + C::VBUF);
#pragma unroll
                for (int i4 = 0; i4 < 4; ++i4) {
                    const int kofs = 8 * i4 + 4 * hh;
                    const int pa0 = pk[kofs], pa1 = pk[kofs + 1], pa2 = pk[kofs + 2], pa3 = pk[kofs + 3];
                    const int pb0 = pk[32 + kofs], pb1 = pk[32 + kofs + 1], pb2 = pk[32 + kofs + 2], pb3 = pk[32 + kofs + 3];
                    const int pa[4] = {pa0, pa1, pa2, pa3}, pbb[4] = {pb0, pb1, pb2, pb3};
#pragma unroll
                    for (int ii = 0; ii < 4; ++ii) {
                        const int ka_i = k0 + kofs + ii, kb_i = ka_i + 32;
                        float sa = S0[4 * i4 + ii] - slope_l2 * (pqf - (float)pa[ii]);
                        float sb = S1[4 * i4 + ii] - slope_l2 * (pqf - (float)pbb[ii]);
                        const bool va = (ka_i <= qq) && (qq - ka_i < 128), vb = (kb_i <= qq) && (qq - kb_i < 128);
                        S0[4 * i4 + ii] = va ? sa : -1e30f; S1[4 * i4 + ii] = vb ? sb : -1e30f;
                    }
                }
            } else if (k0 + 63 > wq0) {
#pragma unroll
                for (int i = 0; i < 16; ++i) {
                    const int ka_i = k0 + 8 * (i >> 2) + 4 * hh + (i & 3);
                    if (ka_i > qq) S0[i] = -1e30f;
                    if (ka_i + 32 > qq) S1[i] = -1e30f;
                }
            }
            float mx = S0[0];
#pragma unroll
            for (int i = 1; i < 16; ++i) mx = fmaxf(mx, S0[i]);
#pragma unroll
            for (int i = 0; i < 16; ++i) mx = fmaxf(mx, S1[i]);
            mx = fmaxf(mx, __shfl_xor(mx, 32));
            const float mnew = fmaxf(mrun, mx);
            const float alpha = __builtin_amdgcn_exp2f(mrun - mnew);
            mrun = mnew;
            float ps = 0.f;
#pragma unroll
            for (int i = 0; i < 16; ++i) { S0[i] = __builtin_amdgcn_exp2f(S0[i] - mnew); ps += S0[i]; }
#pragma unroll
            for (int i = 0; i < 16; ++i) { S1[i] = __builtin_amdgcn_exp2f(S1[i] - mnew); ps += S1[i]; }
            lrun = lrun * alpha + ps;
#pragma unroll
            for (int i = 0; i < 16; ++i) { O0[i] *= alpha; O1[i] *= alpha; }
            bf16x8 pf[2][2];
#pragma unroll
            for (int s2 = 0; s2 < 2; ++s2) {
                u32x4 a, c;
                a.x = cvt_pk_bf16(S0[8 * s2 + 0], S0[8 * s2 + 1]); a.y = cvt_pk_bf16(S0[8 * s2 + 2], S0[8 * s2 + 3]); a.z = cvt_pk_bf16(S0[8 * s2 + 4], S0[8 * s2 + 5]); a.w = cvt_pk_bf16(S0[8 * s2 + 6], S0[8 * s2 + 7]);
                c.x = cvt_pk_bf16(S1[8 * s2 + 0], S1[8 * s2 + 1]); c.y = cvt_pk_bf16(S1[8 * s2 + 2], S1[8 * s2 + 3]); c.z = cvt_pk_bf16(S1[8 * s2 + 4], S1[8 * s2 + 5]); c.w = cvt_pk_bf16(S1[8 * s2 + 6], S1[8 * s2 + 7]);
                pf[0][s2] = __builtin_bit_cast(bf16x8, a); pf[1][s2] = __builtin_bit_cast(bf16x8, c);
            }
#pragma unroll
            for (int kb = 0; kb < 2; ++kb)
#pragma unroll
                for (int s2 = 0; s2 < 2; ++s2) {
                    const int kbase = kb * 32 + 16 * s2 + 4 * hh;
                    const u32x2 a0l = *(const LAS u32x2*)(Vt + lq * VROW + kbase), a0h = *(const LAS u32x2*)(Vt + lq * VROW + kbase + 8);
                    const u32x2 a1l = *(const LAS u32x2*)(Vt + (32 + lq) * VROW + kbase), a1h = *(const LAS u32x2*)(Vt + (32 + lq) * VROW + kbase + 8);
                    const u32x4 a0 = (u32x4){a0l.x, a0l.y, a0h.x, a0h.y}, a1 = (u32x4){a1l.x, a1l.y, a1h.x, a1h.y};
                    O0 = __builtin_amdgcn_mfma_f32_32x32x16_bf16(__builtin_bit_cast(bf16x8, a0), pf[kb][s2], O0, 0, 0, 0);
                    O1 = __builtin_amdgcn_mfma_f32_32x32x16_bf16(__builtin_bit_cast(bf16x8, a1), pf[kb][s2], O1, 0, 0, 0);
                }
        }
        if (j < j1) ATT_STORE(bufi ^ 1);
        __syncthreads();
    }
#undef ATT_LOAD
#undef ATT_STORE
    const float ltot = lrun + __shfl_xor(lrun, 32);
    const float inv = 1.f / ltot;
    bf16_t* orow = Z + tq * ZW + (MODE == 0 ? ZC_GB : ZC_GA) + hq * 64;
#pragma unroll
    for (int i4 = 0; i4 < 4; ++i4) {
        const int dv0 = 8 * i4 + 4 * hh;
        { const u32x2 g = *(const u32x2*)(orow + dv0); u32x2 o;
          o.x = cvt_pk_bf16(O0[4 * i4 + 0] * inv * bflo(g.x), O0[4 * i4 + 1] * inv * bfhi(g.x)); o.y = cvt_pk_bf16(O0[4 * i4 + 2] * inv * bflo(g.y), O0[4 * i4 + 3] * inv * bfhi(g.y));
          *(u32x2*)(orow + dv0) = o; }
        { const u32x2 g = *(const u32x2*)(orow + 32 + dv0); u32x2 o;
          o.x = cvt_pk_bf16(O1[4 * i4 + 0] * inv * bflo(g.x), O1[4 * i4 + 1] * inv * bfhi(g.x)); o.y = cvt_pk_bf16(O1[4 * i4 + 2] * inv * bflo(g.y), O1[4 * i4 + 3] * inv * bfhi(g.y));
          *(u32x2*)(orow + 32 + dv0) = o; }
    }
}
}

__device__ __forceinline__ int colmap(int type, int n) {
    if (type == 1) {
        if (n < 1664) return n;
        if (n < 1696) { const int j = n - 1664; return 1664 + (j >> 1) + 16 * (j & 1); }
        if (n < 1792) return -1;
        return n - 96;
    }
    if (type == 2) {
        const int h = n / 96, c = n % 96; if (c < 64) return n; const int j = c - 64; return h * 96 + 64 + (j >> 1) + 16 * (j & 1);
    }
    return n;
}
__device__ __forceinline__ void wprep(const float* W, int K, int Nsrc, const float* g, bf16_t* dst, int Ndst, int type, size_t gtid, size_t gthreads) {
    const size_t total = (size_t)Ndst * (K / 8);
    for (size_t idx = gtid; idx < total; idx += gthreads) {
        const int n = (int)(idx % Ndst), kc = (int)(idx / Ndst);
        const int src = colmap(type, n);
        float v[8];
#pragma unroll
        for (int j = 0; j < 8; ++j) { const int k = kc * 8 + j; v[j] = src < 0 ? 0.f : W[(size_t)k * Nsrc + src] * (g ? g[k] : 1.f); }
        *(u32x4*)(dst + (size_t)n * K + kc * 8) = pack8(v);
    }
}

constexpr int LDS_BYTES = 131072 + 1024;
constexpr int N_PHASES = 1 + 6 * DEPTH + 1;

__global__ void __launch_bounds__(512, 2) fwd_megakernel(Params P) {
    extern __shared__ __attribute__((aligned(16))) unsigned char lds_raw[];
    LAS unsigned char* lds = (LAS unsigned char*)lds_raw;
    cg::grid_group grid = cg::this_grid();
    const int G = gridDim.x, bid = blockIdx.x;
    unsigned char* ws = P.ws;
    bf16_t* Wb = (bf16_t*)(ws + WS_W);
    float* SSXA = (float*)(ws + WS_SSXA); float* SSXB = (float*)(ws + WS_SSXB); float* SSQ = (float*)(ws + WS_SSQ); float* SSKV = (float*)(ws + WS_SSKV);
    bf16_t* PB = (bf16_t*)(ws + WS_PB); bf16_t* XB = (bf16_t*)(ws + WS_XB); bf16_t* QB = (bf16_t*)(ws + WS_QB); bf16_t* KVB = (bf16_t*)(ws + WS_KVB); bf16_t* Z = (bf16_t*)(ws + WS_Z);
    const int lo = P.ph_lo, hi = P.ph_hi;
    int ph = 0;
#define PHASE_BEGIN if (ph >= lo && ph < hi) {
#define PHASE_END   if (ph + 1 < hi) grid.sync(); } ++ph;

    PHASE_BEGIN
#if (PHMASK >> 0) & 1
    {
        int tid_ = threadIdx.x; asm volatile("" : "+v"(tid_)); const int tid = tid_, lane = tid & 63, wave = tid >> 6;
        const size_t gtid = (size_t)bid * 512 + tid, gthreads = (size_t)G * 512;
        for (int L = 0; L < DEPTH; ++L) {
            bf16_t* wl = Wb + (size_t)L * WO_END;
            wprep(P.w_in + (size_t)L * 1024 * IN_WIDTH, 1024, IN_WIDTH, P.g_mix + L * 1024, wl + WO_IN, ZW, 1, gtid, gthreads);
            wprep(P.w_uq + (size_t)L * 256 * 768, 256, 768, P.g_q + L * 256, wl + WO_UQ, 768, 2, gtid, gthreads);
            wprep(P.w_ukv + (size_t)L * 128 * 1024, 128, 1024, P.g_kv + L * 128, wl + WO_UKV, 1024, 0, gtid, gthreads);
            wprep(P.w_br_a + (size_t)L * 512 * 1024, 512, 1024, nullptr, wl + WO_A, 1024, 0, gtid, gthreads);
            wprep(P.w_br_b + (size_t)L * 512 * 1024, 512, 1024, nullptr, wl + WO_B, 1024, 0, gtid, gthreads);
            wprep(P.w_out + (size_t)L * 1024 * 1024, 1024, 1024, nullptr, wl + WO_OUT, 1024, 0, gtid, gthreads);
            wprep(P.w_ple_gate + (size_t)L * 1024 * 1024, 1024, 1024, P.g_ple + L * 1024, wl + WO_PG, 1024, 0, gtid, gthreads);
            wprep(P.w_ple_proj + (size_t)L * 256 * 1024, 256, 1024, nullptr, wl + WO_PP, 1024, 0, gtid, gthreads);
        }
        const int gw = bid * 8 + wave, NGW = G * 8;
        for (int r = gw; r < T; r += NGW) {
            const f32x4* xr = (const f32x4*)(P.x + (size_t)r * D) + lane;
            float s = 0.f;
#pragma unroll
            for (int j = 0; j < 4; ++j) { const f32x4 v = xr[64 * j]; s += (v.x * v.x + v.y * v.y) + (v.z * v.z + v.w * v.w);
                u32x2 o; o.x = cvt_pk_bf16(v.x, v.y); o.y = cvt_pk_bf16(v.z, v.w); *((u32x2*)(XB + (size_t)r * D) + lane + 64 * j) = o; }
#pragma unroll
            for (int o = 1; o < 64; o <<= 1) s += __shfl_xor(s, o);
            if (lane < 16) SSXA[(size_t)r * 16 + lane] = lane == 0 ? s : 0.f;
        }
        const size_t np8 = (size_t)DEPTH * T * PLE / 8;
        for (size_t i = gtid; i < np8; i += gthreads) { const f32x4 a = *(const f32x4*)(P.p + i * 8), c = *(const f32x4*)(P.p + i * 8 + 4);
            u32x4 o; o.x = cvt_pk_bf16(a.x, a.y); o.y = cvt_pk_bf16(a.z, a.w); o.z = cvt_pk_bf16(c.x, c.y); o.w = cvt_pk_bf16(c.z, c.w); *(u32x4*)(PB + i * 8) = o; }
    }
#endif
    PHASE_END

#pragma unroll 1
    for (int L = 0; L < DEPTH; ++L) {
        const bf16_t* wl = Wb + (size_t)L * WO_END;
        PHASE_BEGIN
#if (PHMASK >> 1) & 1
        { pg8::Gemm g{XB, wl + WO_IN, T, ZW, 1024, 1024}; pg8::StaticOrder S; S.init(T, ZW, G, bid);
          EpiZ E{Z, SSXA, SSQ, SSKV, P.pos}; pg8::gemm_phase(lds, g, S, E); }
    #endif
    PHASE_END
        PHASE_BEGIN
#if (PHMASK >> 2) & 1
        { pg8::Gemm g{Z + ZC_BQD, wl + WO_UQ, T, 768, 256, ZW}; pg8::StaticOrder S; S.init(T, 768, G, bid);
          EpiQB E{QB, SSQ, P.pos}; pg8::gemm_phase(lds, g, S, E); }
        { pg8::Gemm g{Z + ZC_BKVD, wl + WO_UKV, T, 1024, 128, ZW}; pg8::StaticOrder S; S.init(T, 1024, G, bid);
          EpiKVB E{KVB, SSKV}; pg8::gemm_phase(lds, g, S, E); }
    #endif
    PHASE_END
        PHASE_BEGIN
#if (PHMASK >> 3) & 1
        {
            __syncthreads();
            for (int u = bid; u < 4096; u += G) {
                if (u < 2048) { const int qb = 7 - (u >> 8), bh = u & 255; att::attn_unit<0>(lds, QB, KVB, Z, P.pos, nullptr, bh >> 3, bh & 7, qb); }
                else { const int v = u - 2048; att::attn_unit<1>(lds, QB, KVB, Z, P.pos, P.sink + L * 8, v >> 6, (v >> 5) & 1, v & 31); }
            }
        }
    #endif
    PHASE_END
        PHASE_BEGIN
#if (PHMASK >> 4) & 1
        { pg8::Gemm g{Z + ZC_GA, wl + WO_A, T, 1024, 512, ZW}; pg8::StaticOrder S; S.init(T, 1024, G, bid);
          EpiMerge<0> E{Z}; pg8::gemm_phase(lds, g, S, E); }
        { pg8::Gemm g{Z + ZC_GB, wl + WO_B, T, 1024, 512, ZW}; pg8::StaticOrder S; S.init(T, 1024, G, bid);
          EpiMerge<1> E{Z}; pg8::gemm_phase(lds, g, S, E); }
    #endif
    PHASE_END
        PHASE_BEGIN
#if (PHMASK >> 5) & 1
        { pg8::Gemm g{Z + ZC_MB, wl + WO_OUT, T, 1024, 1024, ZW}; pg8::StaticOrder S; S.init(T, 1024, G, bid);
          EpiX1 E{L == 0 ? P.x : P.out, P.out, Z, SSXB}; pg8::gemm_phase(lds, g, S, E); }
        { pg8::Gemm g{PB + (size_t)L * T * PLE, wl + WO_PP, T, 1024, 256, 256}; pg8::StaticOrder S; S.init(T, 1024, G, bid);
          EpiPP E{Z}; pg8::gemm_phase(lds, g, S, E); }
    #endif
    PHASE_END
        PHASE_BEGIN
#if (PHMASK >> 6) & 1
        { pg8::Gemm g{Z + ZC_X1B, wl + WO_PG, T, 1024, 1024, ZW}; pg8::StaticOrder S; S.init(T, 1024, G, bid);
          EpiX2 E{P.out, Z, XB, SSXB, SSXA}; pg8::gemm_phase(lds, g, S, E); }
    #endif
    PHASE_END
    }
    PHASE_BEGIN
#if (PHMASK >> 7) & 1
    {
        int tid_ = threadIdx.x; asm volatile("" : "+v"(tid_)); const int tid = tid_, lane = tid & 63, wave = tid >> 6;
        const int gw = bid * 8 + wave, NGW = G * 8;
        for (int r = gw; r < T; r += NGW) {
            const float rstd = rsqrtf(sum16(SSXA + (size_t)r * 16) * (1.f / 1024.f) + EPS);
            f32x4* xr = (f32x4*)(P.out + (size_t)r * D) + lane; const f32x4* gr = (const f32x4*)P.g_final + lane;
#pragma unroll
            for (int j = 0; j < 4; ++j) { f32x4 v = xr[64 * j]; const f32x4 gg = gr[64 * j]; v.x *= rstd * gg.x; v.y *= rstd * gg.y; v.z *= rstd * gg.z; v.w *= rstd * gg.w; xr[64 * j] = v; }
        }
    }
#endif
    PHASE_END
#undef PHASE_BEGIN
#undef PHASE_END
}

extern "C" void kernel_launch(void* const* d_in, const int* in_sizes, int n_in, void* d_out, int out_size, void* d_ws, size_t ws_size, hipStream_t stream) {
    static int grid = 0;
    if (grid == 0) {
        if (n_in != 17 || in_sizes[0] != T * D || out_size != T * D || ws_size < WS_END) {
            fprintf(stderr, "kernel_launch: unexpected shapes/workspace: n_in %d in0 %d out %d ws %zu (need %zu)\n", n_in, n_in > 0 ? in_sizes[0] : -1, out_size, ws_size, (size_t)WS_END); grid = -1; return; }
        int dev = 0, cus = 0, per_cu = 0;
        hipGetDevice(&dev); hipDeviceGetAttribute(&cus, hipDeviceAttributeMultiprocessorCount, dev);
        if (hipFuncSetAttribute((const void*)fwd_megakernel, hipFuncAttributeMaxDynamicSharedMemorySize, LDS_BYTES) != hipSuccess) { fprintf(stderr, "kernel_launch: hipFuncSetAttribute failed\n"); grid = -1; return; }
        if (hipOccupancyMaxActiveBlocksPerMultiprocessor(&per_cu, (const void*)fwd_megakernel, 512, LDS_BYTES) != hipSuccess || per_cu < 1) { fprintf(stderr, "kernel_launch: occupancy query gave %d\n", per_cu); per_cu = 1; }
        (void)hipGetLastError();
        grid = cus * 1;
        fprintf(stderr, "kernel_launch: grid %d (cus %d, per_cu %d)\n", grid, cus, per_cu);
    }
    if (grid < 0) return;
    Params p{};
    p.x = (const float*)d_in[0]; p.p = (const float*)d_in[1]; p.pos = (const int*)d_in[2];
    p.g_mix = (const float*)d_in[3]; p.w_in = (const float*)d_in[4]; p.sink = (const float*)d_in[5]; p.g_q = (const float*)d_in[6]; p.w_uq = (const float*)d_in[7];
    p.g_kv = (const float*)d_in[8]; p.w_ukv = (const float*)d_in[9]; p.w_br_a = (const float*)d_in[10]; p.w_br_b = (const float*)d_in[11]; p.w_out = (const float*)d_in[12];
    p.g_ple = (const float*)d_in[13]; p.w_ple_gate = (const float*)d_in[14]; p.w_ple_proj = (const float*)d_in[15]; p.g_final = (const float*)d_in[16];
    p.out = (float*)d_out; p.ws = (unsigned char*)d_ws;
#if ONE_LAUNCH
    p.ph_lo = 0; p.ph_hi = N_PHASES;
    { void* args[] = {&p}; hipError_t e = hipLaunchCooperativeKernel((const void*)fwd_megakernel, dim3(grid), dim3(512), args, LDS_BYTES, stream);
      if (e != hipSuccess) fprintf(stderr, "cooperative launch failed: %s (grid %d)\n", hipGetErrorString(e), grid); }
#else
    for (int ph = 0; ph < N_PHASES; ++ph) {
        p.ph_lo = ph; p.ph_hi = ph + 1;
        void* args[] = {&p}; hipError_t e = hipLaunchCooperativeKernel((const void*)fwd_megakernel, dim3(grid), dim3(512), args, LDS_BYTES, stream);
        if (e != hipSuccess) { fprintf(stderr, "cooperative launch %d failed: %s (grid %d)\n", ph, hipGetErrorString(e), grid); break; }
    }
#endif
}
```

```cpp
#include <hip/hip_runtime.h>
#include <hip/hip_cooperative_groups.h>
#include <cstdio>
#include <cstdint>
namespace cg = cooperative_groups;

#ifndef PHMASK
#define PHMASK 255
#endif
#ifndef PROBE_SET
#define PROBE_SET 0
#endif
#ifndef ONE_LAUNCH
#define ONE_LAUNCH 1
#endif

#define LAS __attribute__((address_space(3)))
typedef unsigned short bf16_t;
typedef short bf16x8 __attribute__((ext_vector_type(8)));
typedef float f32x4 __attribute__((ext_vector_type(4)));
typedef float f32x16 __attribute__((ext_vector_type(16)));
typedef unsigned u32x4 __attribute__((ext_vector_type(4)));
typedef unsigned u32x2 __attribute__((ext_vector_type(2)));

constexpr int BATCH = 32, SEQ = 2048, T = BATCH * SEQ, D = 1024, DEPTH = 2, PLE = 256;
constexpr int ZW = 4352;
constexpr int ZC_QA = 0, ZC_KA = 512, ZC_VA = 640, ZC_GA = 768, ZC_BQD = 1280, ZC_BKVD = 1536, ZC_KR = 1664, ZC_GB = 1792, ZC_MA = 2304, ZC_MB = 3328;
constexpr int ZC_X1B = ZC_MA, ZC_T2 = 0;
constexpr int IN_WIDTH = 4256;
constexpr float EPS = 1e-6f;
constexpr float LOG2E = 1.4426950408889634f;

constexpr size_t WO_IN = 0, WO_UQ = WO_IN + (size_t)ZW * 1024, WO_UKV = WO_UQ + 768 * 256, WO_A = WO_UKV + 1024 * 128, WO_B = WO_A + 1024 * 512,
                 WO_OUT = WO_B + 1024 * 512, WO_PG = WO_OUT + 1024 * 1024, WO_PP = WO_PG + 1024 * 1024, WO_END = WO_PP + 1024 * 256;
constexpr size_t MiB = 1u << 20;
constexpr size_t WS_W = 0, WS_SSXA = 32 * MiB, WS_SSXB = 36 * MiB, WS_SSQ = 40 * MiB, WS_SSKV = 41 * MiB, WS_PB = 42 * MiB, WS_XB = 106 * MiB,
                 WS_QB = 234 * MiB, WS_KVB = 330 * MiB, WS_Z = 458 * MiB, WS_END = 1002 * MiB;
static_assert(2 * WO_END * 2 <= 32 * MiB, "weights fit");
static_assert((size_t)T * ZW * 2 == 544 * MiB, "Z size");

struct Params {
    const float* x; const float* p; const int* pos;
    const float *g_mix, *w_in, *sink, *g_q, *w_uq, *g_kv, *w_ukv, *w_br_a, *w_br_b, *w_out, *g_ple, *w_ple_gate, *w_ple_proj, *g_final;
    float* out; unsigned char* ws;
    int ph_lo, ph_hi;
};

__device__ __forceinline__ unsigned cvt_pk_bf16(float lo, float hi) { unsigned r; asm volatile("v_cvt_pk_bf16_f32 %0, %1, %2" : "=v"(r) : "v"(lo), "v"(hi)); return r; }
__device__ __forceinline__ float bflo(unsigned w) { return __uint_as_float(w << 16); }
__device__ __forceinline__ float bfhi(unsigned w) { return __uint_as_float(w & 0xffff0000u); }
__device__ __forceinline__ float fsigmoid(float x) { return __builtin_amdgcn_rcpf(1.f + __expf(-x)); }
__device__ __forceinline__ float fsilu(float x) { return x * fsigmoid(x); }
__device__ __forceinline__ u32x4 pack8(const float* v) { u32x4 w; w.x = cvt_pk_bf16(v[0], v[1]); w.y = cvt_pk_bf16(v[2], v[3]); w.z = cvt_pk_bf16(v[4], v[5]); w.w = cvt_pk_bf16(v[6], v[7]); return w; }
__device__ __forceinline__ void unpack8(u32x4 w, float* v) { v[0] = bflo(w.x); v[1] = bfhi(w.x); v[2] = bflo(w.y); v[3] = bfhi(w.y); v[4] = bflo(w.z); v[5] = bfhi(w.z); v[6] = bflo(w.w); v[7] = bfhi(w.w); }
__device__ __forceinline__ float sum16(const float* s) { const f32x4 a = *(const f32x4*)s, b = *(const f32x4*)(s + 4), c = *(const f32x4*)(s + 8), d = *(const f32x4*)(s + 12);
    return ((a.x + a.y) + (a.z + a.w)) + ((b.x + b.y) + (b.z + b.w)) + ((c.x + c.y) + (c.z + c.w)) + ((d.x + d.y) + (d.z + d.w)); }
__device__ __forceinline__ float sum4(const float* s) { const f32x4 a = *(const f32x4*)s; return (a.x + a.y) + (a.z + a.w); }
__device__ __forceinline__ void rope8(float* v, int i0, float posf) {
#pragma unroll
    for (int j = 0; j < 4; ++j) {
        const float ci = __builtin_amdgcn_exp2f(-(float)(i0 + j) * 0.83048202372184059f) * 0.15915494309189535f;
        float r = posf * ci; r = r - rintf(r);
        const float sn = __builtin_amdgcn_sinf(r), cs = __builtin_amdgcn_cosf(r);
        const float x1 = v[2 * j], x2 = v[2 * j + 1];
        v[2 * j] = x1 * cs - x2 * sn; v[2 * j + 1] = x2 * cs + x1 * sn;
    }
}

namespace pg8 {
constexpr int BM = 256, BK = 64, HALF = 128, HTB = HALF * BK * 2, STAGE_BYTES = 8 * HTB, NXCD = 8, WGM = 8;
__host__ __device__ __forceinline__ int lds_byte(int r, int c) { const int st = (r >> 4) * 2 + (c >> 5), rr = r & 15, cc = c & 31, ob = rr * 64 + cc * 2; return st * 1024 + (ob ^ (((ob >> 9) & 1) << 5)); }
__host__ __device__ __forceinline__ void stage_rc(int b, int& R, int& C) { const int st = b / 1024, sb = b % 1024, swz = sb ^ (((sb >> 9) & 1) << 5); R = (st >> 1) * 16 + swz / 64; C = (st & 1) * 32 + (swz % 64) / 2; }
__host__ __device__ __forceinline__ int perm32(int rho) { const int n = rho >> 4, i = rho & 15; return 8 * (i >> 2) + 4 * n + (i & 3); }

struct Unit { int pm, pn; };
struct Gemm { const bf16_t* A; const bf16_t* Bt; int M, N, K, lda; };

struct StaticOrder {
    int nM, nN, nwg, G, c;
    __host__ __device__ void init(int M, int N, int G_, int c_) { nM = M / BM; nN = N / BM; nwg = nM * nN; G = G_; c = c_; }
    __host__ __device__ bool next(int i, Unit& u) const {
        const long L = (long)i * G + c; if (L >= nwg) return false;
        int wgid = (int)L; { const int q = nwg / NXCD, r = nwg % NXCD, xcd = wgid % NXCD, off = wgid / NXCD; wgid = (xcd < r ? xcd * (q + 1) : r * (q + 1) + (xcd - r) * q) + off; }
        const int nig = WGM * nN, gid = wgid / nig, fm = gid * WGM, gsz = (nM - fm) < WGM ? (nM - fm) : WGM;
        u.pm = fm + ((wgid % nig) % gsz); u.pn = (wgid % nig) / gsz; return true;
    }
};

template <class Epi>
__device__ __forceinline__ void gemm_phase(LAS unsigned char* lds, const Gemm g, const StaticOrder& S, const Epi& E, int stag = 0) {
    if (stag > 0) {
        const unsigned long long t0_ = __builtin_amdgcn_s_memrealtime(); const unsigned long long w_ = (unsigned long long)(((blockIdx.x >> 3) & 3) * stag);
        while (__builtin_amdgcn_s_memrealtime() - t0_ < w_) __builtin_amdgcn_s_sleep(8);
    }
    int tid_ = threadIdx.x; asm volatile("" : "+v"(tid_));
    const int tid = tid_, wid = __builtin_amdgcn_readfirstlane(tid >> 6), lane = tid & 63, wr = wid >> 2, wc = wid & 3, fr = lane & 15, fq = lane >> 4;
    const int K = g.K, nt = K / BK, lda = g.lda;
    unsigned voffA[2], voffB[2];
#pragma unroll
    for (int i = 0; i < 2; ++i) { int R, C; stage_rc(tid * 16 + i * 8192, R, C); const int Rb = (R & ~31) + perm32(R & 31);
        voffA[i] = (unsigned)(R * lda + C) * 2u; voffB[i] = (unsigned)(Rb * K + C) * 2u; }
    const size_t kstep = (size_t)(BK * 2);
    const size_t hstepA = (size_t)HALF * lda * 2, hstepB = (size_t)HALF * K * 2;
    const size_t tstepA = 2 * hstepA, tstepB = 2 * hstepB;
    const unsigned ldsw = (unsigned)wid * 1024u;
    const int aoff = lds_byte(wr * 64 + fr, fq * 8), boff = lds_byte(wc * 32 + fr, fq * 8);
#define PG8_SA(b, h) (((b) * 2 + (h)) * HTB)
#define PG8_SB(b, h) ((4 + (b) * 2 + (h)) * HTB)
#define PG8_STAGE(bufoff, gbase, voff) do { _Pragma("unroll") for (int _i = 0; _i < 2; ++_i) \
        { unsigned vo_ = (voff)[_i]; asm volatile("" : "+v"(vo_)); __builtin_amdgcn_global_load_lds((const unsigned*)((const char*)(gbase) + vo_), (LAS unsigned*)(lds + (bufoff) + ldsw + _i * 8192), 16, 0, 0); } } while (0)
#define PG8_LDA(dst, b, h) do { _Pragma("unroll") for (int m = 0; m < 4; ++m) _Pragma("unroll") for (int k = 0; k < 2; ++k) dst[m][k] = *(const LAS bf16x8*)(lds + PG8_SA(b, h) + aoff + m * 2048 + k * 1024); } while (0)
#define PG8_LDB(dst, b, h) do { _Pragma("unroll") for (int n = 0; n < 2; ++n) _Pragma("unroll") for (int k = 0; k < 2; ++k) dst[n][k] = *(const LAS bf16x8*)(lds + PG8_SB(b, h) + boff + n * 2048 + k * 1024); } while (0)
#define PG8_MMA(ai, bj, At, Bt) do { __builtin_amdgcn_s_setprio(1); _Pragma("unroll") for (int m = 0; m < 4; ++m) _Pragma("unroll") for (int n = 0; n < 2; ++n) _Pragma("unroll") for (int k = 0; k < 2; ++k) \
        acc[ai][bj][m][n] = __builtin_amdgcn_mfma_f32_16x16x32_bf16(Bt[n][k], At[m][k], acc[ai][bj][m][n], 0, 0, 0); __builtin_amdgcn_s_setprio(0); } while (0)
#define PG8_WAIT_V(n) asm volatile("s_waitcnt vmcnt(" #n ")" ::: "memory")
#define PG8_WAIT_L(n) asm volatile("s_waitcnt lgkmcnt(" #n ")" ::: "memory")
#define PG8_BAR __builtin_amdgcn_s_barrier()
#define PG8_SCHED __builtin_amdgcn_sched_barrier(0)
    Unit cur, nxt; int ui = 0;
    if (!S.next(0, cur)) return;
    f32x4 acc[2][2][4][2];
#pragma unroll
    for (int a = 0; a < 2; ++a)
#pragma unroll
        for (int b = 0; b < 2; ++b)
#pragma unroll
            for (int m = 0; m < 4; ++m)
#pragma unroll
                for (int n = 0; n < 2; ++n) acc[a][b][m][n] = (f32x4){0.f, 0.f, 0.f, 0.f};
    bf16x8 At[4][2], B0[2][2], B1[2][2];
    const char* cA = (const char*)g.A + (size_t)cur.pm * tstepA; const char* cB = (const char*)g.Bt + (size_t)cur.pn * tstepB;
    PG8_STAGE(PG8_SB(0, 0), cB, voffB); PG8_STAGE(PG8_SB(0, 1), cB + hstepB, voffB); PG8_STAGE(PG8_SA(0, 0), cA, voffA); PG8_STAGE(PG8_SA(0, 1), cA + hstepA, voffA);
    if (wr == 1) PG8_BAR;
    PG8_WAIT_V(2); PG8_BAR;
    PG8_STAGE(PG8_SB(1, 0), cB + kstep, voffB); PG8_STAGE(PG8_SA(1, 0), cA + kstep, voffA); PG8_STAGE(PG8_SB(1, 1), cB + hstepB + kstep, voffB);
    PG8_WAIT_V(6); PG8_BAR;
    for (;;) {
        const bool has_next = S.next(ui + 1, nxt);
        const char* nA = has_next ? (const char*)g.A + (size_t)nxt.pm * tstepA : cA; const char* nB = has_next ? (const char*)g.Bt + (size_t)nxt.pn * tstepB : cB;
#pragma unroll 1
        for (int t = 0; t < nt; t += 2) {
            const bool last = (t == nt - 2);
            const char* a1 = cA + (size_t)(t + 1) * kstep;
            const char* a2 = last ? nA : cA + (size_t)(t + 2) * kstep; const char* b2 = last ? nB : cB + (size_t)(t + 2) * kstep;
            const char* a3 = a2 + kstep; const char* b3 = b2 + kstep;
            PG8_LDB(B0, 0, 0); PG8_LDB(B1, 0, 1); PG8_SCHED; PG8_LDA(At, 0, 0); PG8_STAGE(PG8_SA(1, 1), a1 + hstepA, voffA);
            PG8_WAIT_V(8); PG8_WAIT_L(0); PG8_BAR; PG8_MMA(0, 0, At, B0); PG8_MMA(0, 1, At, B1); PG8_BAR; PG8_SCHED;
            PG8_LDA(At, 0, 1); PG8_STAGE(PG8_SB(0, 0), b2, voffB); PG8_STAGE(PG8_SB(0, 1), b2 + hstepB, voffB); PG8_STAGE(PG8_SA(0, 0), a2, voffA);
            PG8_WAIT_V(8); PG8_WAIT_L(0); PG8_BAR; PG8_MMA(1, 0, At, B0); PG8_MMA(1, 1, At, B1); PG8_BAR; PG8_SCHED;
            PG8_LDB(B0, 1, 0); PG8_LDB(B1, 1, 1); PG8_SCHED; PG8_LDA(At, 1, 0); PG8_STAGE(PG8_SA(0, 1), a2 + hstepA, voffA);
            PG8_WAIT_V(8); PG8_WAIT_L(0); PG8_BAR; PG8_MMA(0, 0, At, B0); PG8_MMA(0, 1, At, B1); PG8_BAR; PG8_SCHED;
            PG8_LDA(At, 1, 1); PG8_STAGE(PG8_SB(1, 0), b3, voffB); PG8_STAGE(PG8_SB(1, 1), b3 + hstepB, voffB); PG8_STAGE(PG8_SA(1, 0), a3, voffA);
            PG8_WAIT_V(8); PG8_WAIT_L(0); PG8_BAR; PG8_MMA(1, 0, At, B0); PG8_MMA(1, 1, At, B1); PG8_BAR; PG8_SCHED;
        }
        if (wr == 0) PG8_BAR;
        E(acc, cur, wr, wc, fr, fq);
        if (!has_next) break;
#pragma unroll
        for (int a = 0; a < 2; ++a)
#pragma unroll
            for (int b = 0; b < 2; ++b)
#pragma unroll
                for (int m = 0; m < 4; ++m)
#pragma unroll
                    for (int n = 0; n < 2; ++n) acc[a][b][m][n] = (f32x4){0.f, 0.f, 0.f, 0.f};
        cur = nxt; cA = nA; cB = nB; ++ui;
        if (wr == 1) PG8_BAR;
    }
    PG8_WAIT_V(0);
    PG8_BAR;
}
template <class Epi1, class Epi2>
__device__ __forceinline__ void gemm_phase_pair(LAS unsigned char* lds, const Gemm g, const Gemm g2, const StaticOrder& S, const Epi1& E, const Epi2& E2) {
    const int stag = 0;
    if (stag > 0) {
        const unsigned long long t0_ = __builtin_amdgcn_s_memrealtime(); const unsigned long long w_ = (unsigned long long)(((blockIdx.x >> 3) & 3) * stag);
        while (__builtin_amdgcn_s_memrealtime() - t0_ < w_) __builtin_amdgcn_s_sleep(8);
    }
    int tid_ = threadIdx.x; asm volatile("" : "+v"(tid_));
    const int tid = tid_, wid = __builtin_amdgcn_readfirstlane(tid >> 6), lane = tid & 63, wr = wid >> 2, wc = wid & 3, fr = lane & 15, fq = lane >> 4;
    const int K = g.K, nt = K / BK, lda = g.lda;
    unsigned voffA[2], voffB[2];
#pragma unroll
    for (int i = 0; i < 2; ++i) { int R, C; stage_rc(tid * 16 + i * 8192, R, C); const int Rb = (R & ~31) + perm32(R & 31);
        voffA[i] = (unsigned)(R * lda + C) * 2u; voffB[i] = (unsigned)(Rb * K + C) * 2u; }
    const size_t kstep = (size_t)(BK * 2);
    const size_t hstepA = (size_t)HALF * lda * 2, hstepB = (size_t)HALF * K * 2;
    const size_t tstepA = 2 * hstepA, tstepB = 2 * hstepB;
    const unsigned ldsw = (unsigned)wid * 1024u;
    const int aoff = lds_byte(wr * 64 + fr, fq * 8), boff = lds_byte(wc * 32 + fr, fq * 8);
#define PG8_SA(b, h) (((b) * 2 + (h)) * HTB)
#define PG8_SB(b, h) ((4 + (b) * 2 + (h)) * HTB)
#define PG8_STAGE(bufoff, gbase, voff) do { _Pragma("unroll") for (int _i = 0; _i < 2; ++_i) \
        { unsigned vo_ = (voff)[_i]; asm volatile("" : "+v"(vo_)); __builtin_amdgcn_global_load_lds((const unsigned*)((const char*)(gbase) + vo_), (LAS unsigned*)(lds + (bufoff) + ldsw + _i * 8192), 16, 0, 0); } } while (0)
#define PG8_LDA(dst, b, h) do { _Pragma("unroll") for (int m = 0; m < 4; ++m) _Pragma("unroll") for (int k = 0; k < 2; ++k) dst[m][k] = *(const LAS bf16x8*)(lds + PG8_SA(b, h) + aoff + m * 2048 + k * 1024); } while (0)
#define PG8_LDB(dst, b, h) do { _Pragma("unroll") for (int n = 0; n < 2; ++n) _Pragma("unroll") for (int k = 0; k < 2; ++k) dst[n][k] = *(const LAS bf16x8*)(lds + PG8_SB(b, h) + boff + n * 2048 + k * 1024); } while (0)
#define PG8_MMA(ai, bj, At, Bt) do { __builtin_amdgcn_s_setprio(1); _Pragma("unroll") for (int m = 0; m < 4; ++m) _Pragma("unroll") for (int n = 0; n < 2; ++n) _Pragma("unroll") for (int k = 0; k < 2; ++k) \
        acc[ai][bj][m][n] = __builtin_amdgcn_mfma_f32_16x16x32_bf16(Bt[n][k], At[m][k], acc[ai][bj][m][n], 0, 0, 0); __builtin_amdgcn_s_setprio(0); } while (0)
#define PG8_WAIT_V(n) asm volatile("s_waitcnt vmcnt(" #n ")" ::: "memory")
#define PG8_WAIT_L(n) asm volatile("s_waitcnt lgkmcnt(" #n ")" ::: "memory")
#define PG8_BAR __builtin_amdgcn_s_barrier()
#define PG8_SCHED __builtin_amdgcn_sched_barrier(0)
    Unit cur, nxt; int ui = 0;
    if (!S.next(0, cur)) return;
    int which = 0;
    f32x4 acc[2][2][4][2];
#pragma unroll
    for (int a = 0; a < 2; ++a)
#pragma unroll
        for (int b = 0; b < 2; ++b)
#pragma unroll
            for (int m = 0; m < 4; ++m)
#pragma unroll
                for (int n = 0; n < 2; ++n) acc[a][b][m][n] = (f32x4){0.f, 0.f, 0.f, 0.f};
    bf16x8 At[4][2], B0[2][2], B1[2][2];
    const char* cA = (const char*)g.A + (size_t)cur.pm * tstepA; const char* cB = (const char*)g.Bt + (size_t)cur.pn * tstepB;
    PG8_STAGE(PG8_SB(0, 0), cB, voffB); PG8_STAGE(PG8_SB(0, 1), cB + hstepB, voffB); PG8_STAGE(PG8_SA(0, 0), cA, voffA); PG8_STAGE(PG8_SA(0, 1), cA + hstepA, voffA);
    if (wr == 1) PG8_BAR;
    PG8_WAIT_V(2); PG8_BAR;
    PG8_STAGE(PG8_SB(1, 0), cB + kstep, voffB); PG8_STAGE(PG8_SA(1, 0), cA + kstep, voffA); PG8_STAGE(PG8_SB(1, 1), cB + hstepB + kstep, voffB);
    PG8_WAIT_V(6); PG8_BAR;
    for (;;) {
        const int nwhich = which ^ 1;
        bool has_next = true; if (which == 0) nxt = cur; else has_next = S.next((ui >> 1) + 1, nxt);
        const char* nA = has_next ? (const char*)(nwhich ? g2.A : g.A) + (size_t)nxt.pm * tstepA : cA; const char* nB = has_next ? (const char*)(nwhich ? g2.Bt : g.Bt) + (size_t)nxt.pn * tstepB : cB;
#pragma unroll 1
        for (int t = 0; t < nt; t += 2) {
            const bool last = (t == nt - 2);
            const char* a1 = cA + (size_t)(t + 1) * kstep;
            const char* a2 = last ? nA : cA + (size_t)(t + 2) * kstep; const char* b2 = last ? nB : cB + (size_t)(t + 2) * kstep;
            const char* a3 = a2 + kstep; const char* b3 = b2 + kstep;
            PG8_LDB(B0, 0, 0); PG8_LDB(B1, 0, 1); PG8_SCHED; PG8_LDA(At, 0, 0); PG8_STAGE(PG8_SA(1, 1), a1 + hstepA, voffA);
            PG8_WAIT_V(8); PG8_WAIT_L(0); PG8_BAR; PG8_MMA(0, 0, At, B0); PG8_MMA(0, 1, At, B1); PG8_BAR; PG8_SCHED;
            PG8_LDA(At, 0, 1); PG8_STAGE(PG8_SB(0, 0), b2, voffB); PG8_STAGE(PG8_SB(0, 1), b2 + hstepB, voffB); PG8_STAGE(PG8_SA(0, 0), a2, voffA);
            PG8_WAIT_V(8); PG8_WAIT_L(0); PG8_BAR; PG8_MMA(1, 0, At, B0); PG8_MMA(1, 1, At, B1); PG8_BAR; PG8_SCHED;
            PG8_LDB(B0, 1, 0); PG8_LDB(B1, 1, 1); PG8_SCHED; PG8_LDA(At, 1, 0); PG8_STAGE(PG8_SA(0, 1), a2 + hstepA, voffA);
            PG8_WAIT_V(8); PG8_WAIT_L(0); PG8_BAR; PG8_MMA(0, 0, At, B0); PG8_MMA(0, 1, At, B1); PG8_BAR; PG8_SCHED;
            PG8_LDA(At, 1, 1); PG8_STAGE(PG8_SB(1, 0), b3, voffB); PG8_STAGE(PG8_SB(1, 1), b3 + hstepB, voffB); PG8_STAGE(PG8_SA(1, 0), a3, voffA);
            PG8_WAIT_V(8); PG8_WAIT_L(0); PG8_BAR; PG8_MMA(1, 0, At, B0); PG8_MMA(1, 1, At, B1); PG8_BAR; PG8_SCHED;
        }
        if (wr == 0) PG8_BAR;
        if (which) E2(acc, cur, wr, wc, fr, fq); else E(acc, cur, wr, wc, fr, fq);
        if (!has_next) break;
#pragma unroll
        for (int a = 0; a < 2; ++a)
#pragma unroll
            for (int b = 0; b < 2; ++b)
#pragma unroll
                for (int m = 0; m < 4; ++m)
#pragma unroll
                    for (int n = 0; n < 2; ++n) acc[a][b][m][n] = (f32x4){0.f, 0.f, 0.f, 0.f};
        cur = nxt; cA = nA; cB = nB; ++ui; which = nwhich;
        if (wr == 1) PG8_BAR;
    }
    PG8_WAIT_V(0);
    PG8_BAR;
#undef PG8_SA
#undef PG8_SB
#undef PG8_STAGE
#undef PG8_LDA
#undef PG8_LDB
#undef PG8_MMA
#undef PG8_WAIT_V
#undef PG8_WAIT_L
#undef PG8_BAR
#undef PG8_SCHED
}
}

typedef f32x4 Acc[2][2][4][2];
__device__ __forceinline__ bool epi_fence() { asm volatile("" ::: "memory"); return true; }
#define EPI_ROWS(u, wr, fr) const int row0_ = (u).pm * 256 + (wr) * 64 + (fr);
#define EPI_LOADV(v) float v[8]; { const f32x4 a0_ = acc[ai][bj][m][0], a1_ = acc[ai][bj][m][1]; v[0] = a0_[0]; v[1] = a0_[1]; v[2] = a0_[2]; v[3] = a0_[3]; v[4] = a1_[0]; v[5] = a1_[1]; v[6] = a1_[2]; v[7] = a1_[3]; }
constexpr int RTAB_OFF = 131072;
template <int NSLOT>
__device__ __forceinline__ void fill_rtab(LAS unsigned char* lds, const float* ss, int pm, float inv_n, float mul) {
    int tid_ = threadIdx.x; asm volatile("" : "+v"(tid_));
    if (tid_ < 256) { const float* s = ss + ((size_t)pm * 256 + tid_) * NSLOT; const float t = NSLOT == 16 ? sum16(s) : sum4(s);
        ((LAS float*)(lds + RTAB_OFF))[tid_] = rsqrtf(t * inv_n + EPS) * mul; }
    asm volatile("s_waitcnt lgkmcnt(0)" ::: "memory"); __builtin_amdgcn_s_barrier(); asm volatile("" ::: "memory");
}
#define RTAB(ai, m) (((const LAS float*)(lds + RTAB_OFF))[(ai) * 128 + wr * 64 + (m) * 16 + fr])

struct EpiZ {
    bf16_t* Z; const float* ssx; float* ssq; float* sskv; const int* pos; LAS unsigned char* lds;
    __device__ __forceinline__ void operator()(const Acc& acc, const pg8::Unit& u, int wr, int wc, int fr, int fq) const {
        EPI_ROWS(u, wr, fr)
        fill_rtab<16>(lds, ssx, u.pm, 1.f / 1024.f, 1.f);
        const int pn = u.pn;
        const int cbase = pn * 256 + wc * 32 + 8 * fq;
#pragma unroll
        for (int ai = 0; ai < 2; ++ai)
#pragma unroll
        for (int m = 0; m < 4; ++m) {
            const int row = row0_ + ai * 128 + m * 16;
            const float rstd = RTAB(ai, m); const float nrl = rstd * (-LOG2E);
            bf16_t* zr = Z + (size_t)row * ZW + cbase;
            float st = 0.f;
#pragma unroll
            for (int bj = 0; bj < 2; ++bj) {
                EPI_LOADV(v)
                if (pn < 9) {
#pragma unroll
                    for (int j = 0; j < 8; ++j) v[j] *= rstd;
                }
                bool store = true;
                if (pn <= 1) {
#pragma unroll
                    for (int j = 0; j < 8; ++j) v[j] *= (0.125f * LOG2E);
                } else if (pn == 3 || pn == 4 || pn == 7 || pn == 8) {
#pragma unroll
                    for (int j = 0; j < 8; ++j) v[j] = v[j] * __builtin_amdgcn_rcpf(1.f + __builtin_amdgcn_exp2f(v[j] * (-LOG2E)));
                } else if (pn >= 9) {
#pragma unroll
                    for (int j = 0; j < 8; ++j) v[j] = __builtin_amdgcn_rcpf(1.f + __builtin_amdgcn_exp2f(v[j] * nrl));
                } else if (pn == 5) {
#pragma unroll
                    for (int j = 0; j < 8; ++j) st += v[j] * v[j];
                } else if (pn == 6) {
                    if (bj == 0) {
#pragma unroll
                        for (int j = 0; j < 8; ++j) st += v[j] * v[j];
                    } else {
                        if (wc == 0) rope8(v, 4 * fq, (float)pos[row]); else store = false;
                    }
                }
                if (pn >= 9) {
                    u32x2 q8;
                    q8.x = (unsigned)(v[0] * 255.f + 0.5f) | ((unsigned)(v[1] * 255.f + 0.5f) << 8) | ((unsigned)(v[2] * 255.f + 0.5f) << 16) | ((unsigned)(v[3] * 255.f + 0.5f) << 24);
                    q8.y = (unsigned)(v[4] * 255.f + 0.5f) | ((unsigned)(v[5] * 255.f + 0.5f) << 8) | ((unsigned)(v[6] * 255.f + 0.5f) << 16) | ((unsigned)(v[7] * 255.f + 0.5f) << 24);
                    *(u32x2*)((unsigned char*)(Z + (size_t)row * ZW + ZC_MA) + (cbase + bj * 128 - ZC_MA)) = q8;
                } else if (store) *(u32x4*)(zr + bj * 128) = pack8(v);
            }
            if (pn == 5 || pn == 6) {
                st += __shfl_xor(st, 16); st += __shfl_xor(st, 32);
                if (fq == 0) { if (pn == 5) ssq[(size_t)row * 4 + wc] = st; else sskv[(size_t)row * 4 + wc] = st; }
            }
        }
    }
};
struct EpiQB {
    bf16_t* QB; const float* ssq; const int* pos; LAS unsigned char* lds;
    __device__ __forceinline__ void operator()(const Acc& acc, const pg8::Unit& u, int wr, int wc, int fr, int fq) const {
        EPI_ROWS(u, wr, fr)
        fill_rtab<4>(lds, ssq, u.pm, 1.f / 256.f, 0.10206207261596577f * LOG2E);
        const int cbase = u.pn * 256 + wc * 32 + 8 * fq;
        const int c0 = cbase, c1 = cbase + 128, cc0 = c0 % 96, cc1 = c1 % 96;
        const bool anyrope = (cc0 >= 64) || (cc1 >= 64);
#pragma unroll
        for (int ai = 0; ai < 2; ++ai)
#pragma unroll
        for (int m = 0; m < 4; ++m) {
            const int row = row0_ + ai * 128 + m * 16;
            epi_fence();
            const float rstd = RTAB(ai, m);
            float posf = 0.f; if (anyrope) posf = (float)pos[row];
#pragma unroll
            for (int bj = 0; bj < 2; ++bj) {
                EPI_LOADV(v)
#pragma unroll
                for (int j = 0; j < 8; ++j) v[j] *= rstd;
                const int cc = bj ? cc1 : cc0;
                if (cc >= 64) rope8(v, (cc - 64) >> 1, posf);
                *(u32x4*)(QB + (size_t)row * 768 + cbase + bj * 128) = pack8(v);
            }
        }
    }
};
struct EpiKVB {
    bf16_t* KVB; const float* sskv; LAS unsigned char* lds;
    __device__ __forceinline__ void operator()(const Acc& acc, const pg8::Unit& u, int wr, int wc, int fr, int fq) const {
        EPI_ROWS(u, wr, fr)
        fill_rtab<4>(lds, sskv, u.pm, 1.f / 128.f, 1.f);
        const int cbase = u.pn * 256 + wc * 32 + 8 * fq;
#pragma unroll
        for (int ai = 0; ai < 2; ++ai)
#pragma unroll
        for (int m = 0; m < 4; ++m) {
            const int row = row0_ + ai * 128 + m * 16;
            const float rstd = RTAB(ai, m);
#pragma unroll
            for (int bj = 0; bj < 2; ++bj) {
                EPI_LOADV(v)
#pragma unroll
                for (int j = 0; j < 8; ++j) v[j] *= rstd;
                *(u32x4*)(KVB + (size_t)row * 1024 + cbase + bj * 128) = pack8(v);
            }
        }
    }
};
template <int SECOND> struct EpiMerge {
    bf16_t* Z; bf16_t* Y;
    __device__ __forceinline__ void operator()(const Acc& acc, const pg8::Unit& u, int wr, int wc, int fr, int fq) const {
        EPI_ROWS(u, wr, fr)
        const int cbase = u.pn * 256 + wc * 32 + 8 * fq;
#pragma unroll
        for (int ai = 0; ai < 2; ++ai) {
            epi_fence();
            u32x2 sg[4][2]; u32x4 tg[4][2];
#pragma unroll
            for (int m = 0; m < 4; ++m)
#pragma unroll
                for (int bj = 0; bj < 2; ++bj) { const bf16_t* zr = Z + (size_t)(row0_ + ai * 128 + m * 16) * ZW;
                    sg[m][bj] = *(const u32x2*)((const unsigned char*)(zr + ZC_MA) + (SECOND ? 1024 : 0) + cbase + bj * 128);
                    if (SECOND) tg[m][bj] = *(const u32x4*)(zr + ZC_MB + cbase + bj * 128); }
#pragma unroll
            for (int m = 0; m < 4; ++m)
#pragma unroll
                for (int bj = 0; bj < 2; ++bj) {
                    EPI_LOADV(v)
                    const unsigned g0 = sg[m][bj].x, g1 = sg[m][bj].y;
                    const float s[8] = {(float)(g0 & 255u), (float)((g0 >> 8) & 255u), (float)((g0 >> 16) & 255u), (float)(g0 >> 24), (float)(g1 & 255u), (float)((g1 >> 8) & 255u), (float)((g1 >> 16) & 255u), (float)(g1 >> 24)};
#pragma unroll
                    for (int j = 0; j < 8; ++j) v[j] *= s[j] * (1.f / 255.f);
                    if (SECOND) { float t[8]; unpack8(tg[m][bj], t);
#pragma unroll
                        for (int j = 0; j < 8; ++j) v[j] += t[j];
                        *(u32x4*)(Y + (size_t)(row0_ + ai * 128 + m * 16) * 1024 + cbase + bj * 128) = pack8(v); }
                    else *(u32x4*)(Z + (size_t)(row0_ + ai * 128 + m * 16) * ZW + ZC_MB + cbase + bj * 128) = pack8(v);
                }
        }
    }
};
template <int BF> struct EpiX1 {
    const float* xin; const bf16_t* xinb; bf16_t* Z; float* ssb;
    __device__ __forceinline__ void operator()(const Acc& acc, const pg8::Unit& u, int wr, int wc, int fr, int fq) const {
        EPI_ROWS(u, wr, fr)
        const int cbase = u.pn * 256 + wc * 32 + 8 * fq;
#pragma unroll
        for (int ai = 0; ai < 2; ++ai) {
            epi_fence();
            f32x4 xa[4][2][2]; u32x4 xh[4][2];
#pragma unroll
            for (int m = 0; m < 4; ++m)
#pragma unroll
                for (int bj = 0; bj < 2; ++bj) { const size_t o_ = (size_t)(row0_ + ai * 128 + m * 16) * D + cbase + bj * 128;
                    if (BF) xh[m][bj] = *(const u32x4*)(xinb + o_); else { xa[m][bj][0] = *(const f32x4*)(xin + o_); xa[m][bj][1] = *(const f32x4*)(xin + o_ + 4); } }
#pragma unroll
            for (int m = 0; m < 4; ++m) {
                const int row = row0_ + ai * 128 + m * 16;
                float st = 0.f;
#pragma unroll
                for (int bj = 0; bj < 2; ++bj) {
                    EPI_LOADV(v)
                    if (BF) { float xv[8]; unpack8(xh[m][bj], xv);
#pragma unroll
                        for (int j = 0; j < 8; ++j) v[j] += xv[j]; }
                    else { const f32x4 x0 = xa[m][bj][0], x1 = xa[m][bj][1];
                        v[0] += x0[0]; v[1] += x0[1]; v[2] += x0[2]; v[3] += x0[3]; v[4] += x1[0]; v[5] += x1[1]; v[6] += x1[2]; v[7] += x1[3]; }
#pragma unroll
                    for (int j = 0; j < 8; ++j) st += v[j] * v[j];
                    *(u32x4*)(Z + (size_t)row * ZW + ZC_X1B + cbase + bj * 128) = pack8(v);
                }
                st += __shfl_xor(st, 16); st += __shfl_xor(st, 32);
                if (fq == 0) ssb[(size_t)row * 16 + u.pn * 4 + wc] = st;
            }
        }
    }
};
struct EpiPP {
    bf16_t* Z;
    __device__ __forceinline__ void operator()(const Acc& acc, const pg8::Unit& u, int wr, int wc, int fr, int fq) const {
        EPI_ROWS(u, wr, fr)
        const int cbase = u.pn * 256 + wc * 32 + 8 * fq;
#pragma unroll
        for (int ai = 0; ai < 2; ++ai)
#pragma unroll
        for (int m = 0; m < 4; ++m) {
            const int row = row0_ + ai * 128 + m * 16;
#pragma unroll
            for (int bj = 0; bj < 2; ++bj) { EPI_LOADV(v) *(u32x4*)(Z + (size_t)row * ZW + ZC_T2 + cbase + bj * 128) = pack8(v); }
        }
    }
};
struct EpiX2 {
    float* xio; const bf16_t* Z; bf16_t* xb; const float* ssb; float* ssa; LAS unsigned char* lds; bool write_xb;
    __device__ __forceinline__ void operator()(const Acc& acc, const pg8::Unit& u, int wr, int wc, int fr, int fq) const {
        EPI_ROWS(u, wr, fr)
        fill_rtab<16>(lds, ssb, u.pm, 1.f / 1024.f, 1.f);
        const int cbase = u.pn * 256 + wc * 32 + 8 * fq;
#pragma unroll
        for (int ai = 0; ai < 2; ++ai)
#pragma unroll
        for (int mp = 0; mp < 2; ++mp) {
            epi_fence();
            u32x4 xa[2][2], tg[2][2];
#pragma unroll
            for (int mm = 0; mm < 2; ++mm)
#pragma unroll
                for (int bj = 0; bj < 2; ++bj) { const int row = row0_ + ai * 128 + (mp * 2 + mm) * 16; const bf16_t* zp = Z + (size_t)row * ZW + cbase + bj * 128;
                    xa[mm][bj] = *(const u32x4*)(zp + ZC_X1B); tg[mm][bj] = *(const u32x4*)(zp + ZC_T2); }
#pragma unroll
            for (int mm = 0; mm < 2; ++mm) {
                const int m = mp * 2 + mm;
                const int row = row0_ + ai * 128 + m * 16;
                const float rstd = RTAB(ai, m);
                float st = 0.f;
#pragma unroll
                for (int bj = 0; bj < 2; ++bj) {
                    EPI_LOADV(v)
                    const size_t off = (size_t)row * D + cbase + bj * 128;
                    float t[8]; unpack8(tg[mm][bj], t);
                    float xv[8]; unpack8(xa[mm][bj], xv);
#pragma unroll
                    for (int j = 0; j < 8; ++j) { v[j] = xv[j] + fsigmoid(v[j] * rstd) * t[j]; st += v[j] * v[j]; }
                    *(u32x4*)(xb + off) = pack8(v);
                }
                st += __shfl_xor(st, 16); st += __shfl_xor(st, 32);
                if (fq == 0) ssa[(size_t)row * 16 + u.pn * 4 + wc] = st;
            }
        }
    }
};


struct EpiX2F {
    float* out; const bf16_t* Z; const float* ssb; float* ssa; const float* gfin; unsigned* cnt; LAS unsigned char* lds;
    __device__ __forceinline__ void operator()(Acc& acc, const pg8::Unit& u, int wr, int wc, int fr, int fq) const {
        EPI_ROWS(u, wr, fr)
        fill_rtab<16>(lds, ssb, u.pm, 1.f / 1024.f, 1.f);
        const int cbase = u.pn * 256 + wc * 32 + 8 * fq;
#pragma unroll
        for (int ai = 0; ai < 2; ++ai)
#pragma unroll
        for (int mp = 0; mp < 2; ++mp) {
            epi_fence();
            u32x4 xa[2][2], tg[2][2];
#pragma unroll
            for (int mm = 0; mm < 2; ++mm)
#pragma unroll
                for (int bj = 0; bj < 2; ++bj) { const int row = row0_ + ai * 128 + (mp * 2 + mm) * 16; const bf16_t* zp = Z + (size_t)row * ZW + cbase + bj * 128;
                    xa[mm][bj] = *(const u32x4*)(zp + ZC_X1B); tg[mm][bj] = *(const u32x4*)(zp + ZC_T2); }
#pragma unroll
            for (int mm = 0; mm < 2; ++mm) {
                const int m = mp * 2 + mm;
                const int row = row0_ + ai * 128 + m * 16;
                const float rstd = RTAB(ai, m);
                float st = 0.f;
#pragma unroll
                for (int bj = 0; bj < 2; ++bj) {
                    EPI_LOADV(v)
                    float t[8]; unpack8(tg[mm][bj], t);
                    float xv[8]; unpack8(xa[mm][bj], xv);
#pragma unroll
                    for (int j = 0; j < 8; ++j) { v[j] = xv[j] + fsigmoid(v[j] * rstd) * t[j]; st += v[j] * v[j]; }
                    acc[ai][bj][m][0] = (f32x4){v[0], v[1], v[2], v[3]}; acc[ai][bj][m][1] = (f32x4){v[4], v[5], v[6], v[7]};
                }
                st += __shfl_xor(st, 16); st += __shfl_xor(st, 32);
                if (fq == 0) __hip_atomic_store(ssa + (size_t)row * 16 + u.pn * 4 + wc, st, __ATOMIC_RELAXED, __HIP_MEMORY_SCOPE_AGENT);
            }
        }
        asm volatile("s_waitcnt vmcnt(0)" ::: "memory"); __builtin_amdgcn_s_barrier(); asm volatile("" ::: "memory");
        int tid_ = threadIdx.x; asm volatile("" : "+v"(tid_));
        if (tid_ == 0) {
            __hip_atomic_fetch_add(cnt + u.pm, 1u, __ATOMIC_RELAXED, __HIP_MEMORY_SCOPE_AGENT);
            unsigned sp = 0; while (__hip_atomic_load(cnt + u.pm, __ATOMIC_RELAXED, __HIP_MEMORY_SCOPE_AGENT) < 4u && ++sp < (1u << 22)) __builtin_amdgcn_s_sleep(1);
            __builtin_amdgcn_fence(__ATOMIC_ACQUIRE, "agent"); asm volatile("s_waitcnt vmcnt(0)" ::: "memory");
        }
        asm volatile("s_waitcnt vmcnt(0) lgkmcnt(0)" ::: "memory"); __builtin_amdgcn_s_barrier(); asm volatile("" ::: "memory");
        if (tid_ < 256) { const float* sp_ = ssa + ((size_t)u.pm * 256 + tid_) * 16; float t = 0.f;
#pragma unroll
            for (int k = 0; k < 16; ++k) t += __hip_atomic_load(sp_ + k, __ATOMIC_RELAXED, __HIP_MEMORY_SCOPE_AGENT);
            ((LAS float*)(lds + RTAB_OFF))[tid_] = rsqrtf(t * (1.f / 1024.f) + EPS); }
        asm volatile("s_waitcnt lgkmcnt(0)" ::: "memory"); __builtin_amdgcn_s_barrier(); asm volatile("" ::: "memory");
        f32x4 gq[2][2];
#pragma unroll
        for (int bj = 0; bj < 2; ++bj) { gq[bj][0] = *(const f32x4*)(gfin + cbase + bj * 128); gq[bj][1] = *(const f32x4*)(gfin + cbase + bj * 128 + 4); }
#pragma unroll
        for (int ai = 0; ai < 2; ++ai)
#pragma unroll
        for (int m = 0; m < 4; ++m) {
            const int row = row0_ + ai * 128 + m * 16;
            const float r2 = RTAB(ai, m);
#pragma unroll
            for (int bj = 0; bj < 2; ++bj) { const size_t off = (size_t)row * D + cbase + bj * 128;
                *(f32x4*)(out + off) = acc[ai][bj][m][0] * r2 * gq[bj][0]; *(f32x4*)(out + off + 4) = acc[ai][bj][m][1] * r2 * gq[bj][1]; }
        }
    }
};

namespace att {
typedef short v4i16_t __attribute__((ext_vector_type(4)));
template <int MODE> struct Cfg { static constexpr int DQK = MODE == 0 ? 96 : 64, KROW = DQK + 8, KBUF = 64 * KROW * 2, VBUF = 8192, PBUF = 256, BUF = KBUF + VBUF + PBUF; };
#define MX3(a, b, c) __builtin_fmaxf(__builtin_fmaxf((a), (b)), (c))
__device__ __forceinline__ float rowmax32(const f32x16& p0, const f32x16& p1) {
    float a = MX3(p0[0], p0[1], p1[0]), b = MX3(p0[2], p0[3], p1[1]); a = MX3(a, p1[2], p1[3]);
#pragma unroll
    for (int r = 4; r < 16; r += 4) { a = MX3(a, p0[r], p0[r + 1]); b = MX3(b, p0[r + 2], p0[r + 3]); a = MX3(a, p1[r], p1[r + 1]); b = MX3(b, p1[r + 2], p1[r + 3]); }
    const float m = __builtin_fmaxf(a, b); auto rr = __builtin_amdgcn_permlane32_swap(__float_as_uint(m), __float_as_uint(m), false, false);
    return __builtin_fmaxf(__uint_as_float(rr[0]), __uint_as_float(rr[1])); }
__device__ __forceinline__ bf16x8 vfrag(const LAS unsigned char* p) {
    const v4i16_t lo = __builtin_amdgcn_ds_read_tr16_b64_v4i16((LAS v4i16_t*)p), hi = __builtin_amdgcn_ds_read_tr16_b64_v4i16((LAS v4i16_t*)(p + 512));
    return (bf16x8){lo[0], lo[1], lo[2], lo[3], hi[0], hi[1], hi[2], hi[3]}; }

template <int MODE>
__device__ __forceinline__ void attn_mode(LAS unsigned char* lds, const bf16_t* QB, const bf16_t* KVB, bf16_t* Z, const int* pos, const float* sink, int u_begin, int u_end, int u_step) {
    typedef Cfg<MODE> C;
    constexpr int DQK = C::DQK, KROW = C::KROW, NKS = DQK / 16;
    asm volatile("" : "+s"(u_begin));
    if (u_begin >= u_end) return;
    int tid_ = threadIdx.x; asm volatile("" : "+v"(tid_));
    const int tid = tid_, w = __builtin_amdgcn_readfirstlane(tid >> 6), lane = tid & 63, lq = lane & 31, hh = lane >> 5;
#define ATT_DECODE(u_, b_, hk_, qblk_) do { if (MODE == 0) { const int bh_ = (u_) & 255; qblk_ = 7 - ((u_) >> 8); b_ = bh_ >> 3; hk_ = bh_ & 7; } else { const int v_ = (u_) - 2048; b_ = v_ >> 6; hk_ = (v_ >> 5) & 1; qblk_ = v_ & 31; } } while (0)
#define ATT_GEOM(qblk_, hk_, wq0_, hq_, j0_) do { if (MODE == 0) { wq0_ = (qblk_) * 256 + 32 * w; hq_ = (hk_); j0_ = 0; } else { wq0_ = (qblk_) * 64 + 32 * (w >> 2); hq_ = (hk_) * 4 + (w & 3); j0_ = (qblk_) - 2; if (j0_ < 0) j0_ = 0; } } while (0)
#define ATT_QLOAD(tq_, hq_) do { _Pragma("unroll") for (int ks = 0; ks < NKS; ++ks) { \
        if (MODE == 0) qf[ks] = *(const bf16x8*)(QB + (tq_) * 768 + (hq_) * 96 + ks * 16 + hh * 8); \
        else qf[ks] = *(const bf16x8*)(Z + (tq_) * ZW + ZC_QA + (hq_) * 64 + ks * 16 + hh * 8); } } while (0)
    bf16x8 qf[NKS];
    u32x4 sk0, sk1, sv; int sp = 0;
    sk1 = (u32x4){0u, 0u, 0u, 0u};
    u32x4 nk0, nk1, nv; int np = 0;
    nk0 = nk1 = nv = (u32x4){0u, 0u, 0u, 0u};
    const int vkey = tid >> 3, vpart = tid & 7;
    const int vwr = (vpart >> 2) * 4096 + vkey * 64 + (vpart & 3) * 16;
    const int vrd = (4 * hh + ((lane & 15) >> 2)) * 64 + ((lane >> 4) & 1) * 32 + (lane & 3) * 8;
    const char *pk0 = nullptr, *pk1 = nullptr, *pvv = nullptr, *ppp = nullptr; unsigned inc0 = 0, inc1 = 0;
    int kst0, kst1;
    if (MODE == 0) { kst0 = ((tid / 12) * KROW + (tid % 12) * 8) * 2; kst1 = (((tid + 512) / 12) * KROW + ((tid + 512) % 12) * 8) * 2; }
    else { kst0 = (vkey * KROW + vpart * 8) * 2; kst1 = 0; }
#define ATT_SETUP(tok0, hk, j) do { const size_t kt = (tok0) + (size_t)(j) * 64; \
        if (MODE == 0) { { const int key = tid / 12, part = tid % 12; pk0 = (const char*)(part < 8 ? KVB + (kt + key) * 1024 + (hk) * 128 + part * 8 : Z + (kt + key) * ZW + ZC_KR + (part - 8) * 8); inc0 = part < 8 ? 64u * 1024u * 2u : 64u * ZW * 2u; } \
            { const int c2 = tid + 512, key = c2 / 12, part = c2 % 12; pk1 = (const char*)(part < 8 ? KVB + (kt + key) * 1024 + (hk) * 128 + part * 8 : Z + (kt + key) * ZW + ZC_KR + (part - 8) * 8); inc1 = part < 8 ? 64u * 1024u * 2u : 64u * ZW * 2u; } \
            pvv = (const char*)(KVB + (kt + vkey) * 1024 + (hk) * 128 + 64 + vpart * 8); } \
        else { pk0 = (const char*)(Z + (kt + vkey) * ZW + ZC_KA + (hk) * 64 + vpart * 8); pvv = (const char*)(Z + (kt + vkey) * ZW + ZC_VA + (hk) * 64 + vpart * 8); ppp = (const char*)(pos + kt + (tid & 63)); } } while (0)
#define ATT_LOADP(K0, K1, VV, PP) do { \
        if (MODE == 0) { K0 = *(const u32x4*)pk0; pk0 += inc0; if (tid < 256) { K1 = *(const u32x4*)pk1; pk1 += inc1; } VV = *(const u32x4*)pvv; pvv += 64 * 1024 * 2; } \
        else { K0 = *(const u32x4*)pk0; pk0 += 64 * ZW * 2; VV = *(const u32x4*)pvv; pvv += 64 * ZW * 2; if (tid < 64) PP = *(const int*)ppp; ppp += 256; } } while (0)
    { int b_, hk_, qblk_, wq0_, hq_, j0_; ATT_DECODE(u_begin, b_, hk_, qblk_); ATT_GEOM(qblk_, hk_, wq0_, hq_, j0_);
      const size_t tok0_ = (size_t)b_ * SEQ; ATT_QLOAD(tok0_ + wq0_ + lq, hq_); ATT_SETUP(tok0_, hk_, j0_); ATT_LOADP(sk0, sk1, sv, sp); if (MODE == 0 || qblk_ >= 1) ATT_LOADP(nk0, nk1, nv, np); }
    for (int u = u_begin; u < u_end; u += u_step) {
    int b, hk, qblk; ATT_DECODE(u, b, hk, qblk);
    const size_t tok0 = (size_t)b * SEQ;
    int wq0, hq, j0; ATT_GEOM(qblk, hk, wq0, hq, j0);
    const int q0 = MODE == 0 ? qblk * 256 : qblk * 64;
    const int qq = wq0 + lq;
    const size_t tq = tok0 + qq;
    const int j1 = MODE == 0 ? (q0 + 256) / 64 - 1 : q0 / 64;
    float slope_l2 = 0.f, pqf = 0.f, mrun, lrun;
    if (MODE == 1) { slope_l2 = exp2f(-(float)(hq + 1)) * LOG2E; pqf = (float)pos[tq]; mrun = sink[hq] * LOG2E; lrun = hh == 0 ? 1.f : 0.f; }
    else { mrun = 0.f; lrun = 0.f; }
    f32x16 O0, O1, negm;
#pragma unroll
    for (int i = 0; i < 16; ++i) { O0[i] = 0.f; O1[i] = 0.f; negm[i] = 0.f; }
    bool first = true;
    if (MODE == 1) {
#pragma unroll
        for (int i = 0; i < 16; ++i) negm[i] = -slope_l2 * pqf; }

#define ATT_STORE(bufi) do { LAS unsigned char* bb = lds + (bufi) * C::BUF; \
        *(LAS u32x4*)(bb + kst0) = sk0; \
        if (MODE == 0) { if (tid < 256) *(LAS u32x4*)(bb + kst1) = sk1; } \
        else { if (tid < 64) ((LAS float*)(bb + C::KBUF + C::VBUF))[tid] = (float)sp; } \
        *(LAS u32x4*)(bb + C::KBUF + vwr) = sv; } while (0)
#define ATT_BAR() do { asm volatile("s_waitcnt lgkmcnt(0)" ::: "memory"); __builtin_amdgcn_s_barrier(); asm volatile("" ::: "memory"); } while (0)

    ATT_STORE(0);
    ATT_BAR();
    if (j0 < j1) { sk0 = nk0; sk1 = nk1; sv = nv; sp = np; }
    for (int j = j0; j <= j1; ++j) {
        const int bufi = (j - j0) & 1;
        if (j + 2 <= j1) ATT_LOADP(nk0, nk1, nv, np);
        const int k0 = j * 64;
        const bool active = (MODE == 1) || (k0 <= wq0 + 31);
        if (active) {
            const LAS unsigned char* bb = lds + bufi * C::BUF; const LAS bf16_t* Kb = (const LAS bf16_t*)bb; const LAS unsigned char* Vb = bb + C::KBUF + vrd;
            f32x16 S0, S1;
            S0 = negm; S1 = negm;
            bf16x8 kf[2 * NKS];
#pragma unroll
            for (int ks = 0; ks < NKS; ++ks) {
                kf[2 * ks] = *(const LAS bf16x8*)(Kb + lq * KROW + ks * 16 + hh * 8);
                kf[2 * ks + 1] = *(const LAS bf16x8*)(Kb + (32 + lq) * KROW + ks * 16 + hh * 8);
            }
            __builtin_amdgcn_sched_barrier(0);
#pragma unroll
            for (int ks = 0; ks < NKS; ++ks) {
                S0 = __builtin_amdgcn_mfma_f32_32x32x16_bf16(kf[2 * ks], qf[ks], S0, 0, 0, 0);
                S1 = __builtin_amdgcn_mfma_f32_32x32x16_bf16(kf[2 * ks + 1], qf[ks], S1, 0, 0, 0);
            }
            if (MODE == 1) {
                const LAS float* pk = (const LAS float*)(bb + C::KBUF + C::VBUF) + 4 * hh;
                const bool allv = (k0 + 63 <= wq0) && (wq0 + 31 - k0 < 128);
                const int d0 = qq - k0 - 4 * hh;
                if (allv) {
#pragma unroll
                    for (int i4 = 0; i4 < 4; ++i4) {
                        const f32x4 pa = *(const LAS f32x4*)(pk + 8 * i4), pb = *(const LAS f32x4*)(pk + 32 + 8 * i4);
#pragma unroll
                        for (int ii = 0; ii < 4; ++ii) { S0[4 * i4 + ii] = __builtin_fmaf(slope_l2, pa[ii], S0[4 * i4 + ii]); S1[4 * i4 + ii] = __builtin_fmaf(slope_l2, pb[ii], S1[4 * i4 + ii]); }
                    }
                } else {
#pragma unroll
                    for (int i4 = 0; i4 < 4; ++i4) {
                        const f32x4 pa = *(const LAS f32x4*)(pk + 8 * i4), pb = *(const LAS f32x4*)(pk + 32 + 8 * i4);
#pragma unroll
                        for (int ii = 0; ii < 4; ++ii) {
                            const float sa = __builtin_fmaf(slope_l2, pa[ii], S0[4 * i4 + ii]), sb = __builtin_fmaf(slope_l2, pb[ii], S1[4 * i4 + ii]);
                            S0[4 * i4 + ii] = ((unsigned)(d0 - (8 * i4 + ii)) < 128u) ? sa : -1e30f; S1[4 * i4 + ii] = ((unsigned)(d0 - (32 + 8 * i4 + ii)) < 128u) ? sb : -1e30f;
                        }
                    }
                }
            } else if (k0 + 63 > wq0) {
#pragma unroll
                for (int i = 0; i < 16; ++i) {
                    const int ka_i = k0 + 8 * (i >> 2) + 4 * hh + (i & 3);
                    if (ka_i > qq) S0[i] = -1e30f;
                    if (ka_i + 32 > qq) S1[i] = -1e30f;
                }
            }
            const float mx = rowmax32(S0, S1);
            if (MODE == 0) {
                if (first || __builtin_amdgcn_ballot_w64(mx > 8.f) != 0ull) {
                    const float delta = first ? mx : fmaxf(mx, 0.f);
                    const float alpha = first ? 1.f : __builtin_amdgcn_exp2f(-delta);
                    mrun += delta; lrun *= alpha;
#pragma unroll
                    for (int i = 0; i < 16; ++i) { S0[i] -= delta; S1[i] -= delta; O0[i] *= alpha; O1[i] *= alpha; negm[i] = -mrun; }
                    first = false;
                }
            } else {
                const float mnew = fmaxf(mrun, mx);
                const float alpha = __builtin_amdgcn_exp2f(mrun - mnew);
                mrun = mnew; lrun *= alpha;
#pragma unroll
                for (int i = 0; i < 16; ++i) { S0[i] -= mnew; S1[i] -= mnew; O0[i] *= alpha; O1[i] *= alpha; }
            }
            bf16x8 va0[4], va1[4];
#pragma unroll
            for (int t4 = 0; t4 < 4; ++t4) { va0[t4] = vfrag(Vb + t4 * 1024); va1[t4] = vfrag(Vb + 4096 + t4 * 1024); }
            float ps = 0.f;
#pragma unroll
            for (int g = 0; g < 4; ++g) {
                float e[8];
#pragma unroll
                for (int i = 0; i < 8; ++i) { e[i] = __builtin_amdgcn_exp2f(g < 2 ? S0[8 * (g & 1) + i] : S1[8 * (g & 1) + i]); }
                ps += ((e[0] + e[1]) + (e[2] + e[3])) + ((e[4] + e[5]) + (e[6] + e[7]));
                u32x4 a; a.x = cvt_pk_bf16(e[0], e[1]); a.y = cvt_pk_bf16(e[2], e[3]); a.z = cvt_pk_bf16(e[4], e[5]); a.w = cvt_pk_bf16(e[6], e[7]);
                const bf16x8 pfg = __builtin_bit_cast(bf16x8, a);
                O0 = __builtin_amdgcn_mfma_f32_32x32x16_bf16(va0[g], pfg, O0, 0, 0, 0);
                O1 = __builtin_amdgcn_mfma_f32_32x32x16_bf16(va1[g], pfg, O1, 0, 0, 0);
                __builtin_amdgcn_sched_barrier(0);
            }
            lrun += ps;
        }
        if (j < j1) ATT_STORE(bufi ^ 1);
        sk0 = nk0; sk1 = nk1; sv = nv; sp = np;
        ATT_BAR();
    }
    const float ltot = lrun + __shfl_xor(lrun, 32);
    const float inv = 1.f / ltot;
    if (u + u_step < u_end) {
        int b_, hk_, qblk_, wq0_, hq_, j0_; ATT_DECODE(u + u_step, b_, hk_, qblk_); ATT_GEOM(qblk_, hk_, wq0_, hq_, j0_);
        const size_t tok0_ = (size_t)b_ * SEQ; ATT_QLOAD(tok0_ + wq0_ + lq, hq_); ATT_SETUP(tok0_, hk_, j0_); ATT_LOADP(sk0, sk1, sv, sp); if (MODE == 0 || qblk_ >= 1) ATT_LOADP(nk0, nk1, nv, np); }
    LAS unsigned char* ost = lds + 65536 + w * 4608;
#pragma unroll
    for (int i4 = 0; i4 < 4; ++i4) {
        const int dv0 = 8 * i4 + 4 * hh;
        u32x2 o;
        o.x = cvt_pk_bf16(O0[4 * i4 + 0] * inv, O0[4 * i4 + 1] * inv); o.y = cvt_pk_bf16(O0[4 * i4 + 2] * inv, O0[4 * i4 + 3] * inv);
        *(LAS u32x2*)(ost + lq * 144 + dv0 * 2) = o;
        o.x = cvt_pk_bf16(O1[4 * i4 + 0] * inv, O1[4 * i4 + 1] * inv); o.y = cvt_pk_bf16(O1[4 * i4 + 2] * inv, O1[4 * i4 + 3] * inv);
        *(LAS u32x2*)(ost + lq * 144 + 64 + dv0 * 2) = o;
    }
    asm volatile("s_waitcnt lgkmcnt(0)" ::: "memory");
    {
        const int chunk = lane & 7;
        bf16_t* obase = Z + (tok0 + wq0) * ZW + (MODE == 0 ? ZC_GB : ZC_GA) + hq * 64 + chunk * 8;
        u32x4 gv[4], ov[4];
#pragma unroll
        for (int k = 0; k < 4; ++k) { const int row = (lane >> 3) + 8 * k; gv[k] = *(const u32x4*)(obase + (size_t)row * ZW); ov[k] = *(const LAS u32x4*)(ost + row * 144 + chunk * 16); }
#pragma unroll
        for (int k = 0; k < 4; ++k) { const int row = (lane >> 3) + 8 * k; float a[8], g[8]; unpack8(ov[k], a); unpack8(gv[k], g);
#pragma unroll
            for (int e = 0; e < 8; ++e) a[e] *= g[e];
            *(u32x4*)(obase + (size_t)row * ZW) = pack8(a); }
    }
    }
#undef ATT_SETUP
#undef ATT_LOADP
#undef ATT_STORE
#undef ATT_BAR
#undef ATT_DECODE
#undef ATT_GEOM
#undef ATT_QLOAD
}
#undef MX3
}

#define XB_TMO      128
#define XB_XCNT(j)  (256  + 64 * (j))
#define XB_XSUB(j)  (1280 + 64 * (j))
#define XB_XGEN(j)  (2304 + 64 * (j))
#define XB_TOP      3328
#define XB_TOPGEN   3392
#define XCD_BAR_WORDS 3456
#define XB_SPIN_CAP (1u << 18)

__device__ __forceinline__ unsigned xb_ld(unsigned* p)              { return __hip_atomic_load(p, __ATOMIC_RELAXED, __HIP_MEMORY_SCOPE_AGENT); }
__device__ __forceinline__ unsigned xb_add(unsigned* p, unsigned v) { return __hip_atomic_fetch_add(p, v, __ATOMIC_RELAXED, __HIP_MEMORY_SCOPE_AGENT); }
__device__ __forceinline__ unsigned xb_xcc_id() { return (unsigned)__builtin_amdgcn_s_getreg((3 << 11) | 20) & 0xFu; }
#define XB_SPIN(cond, bar) do { unsigned _sp = 0; while (cond) { __builtin_amdgcn_s_sleep(1); \
    if ((++_sp & 255u) == 0u) { if (xb_ld(&(bar)[XB_TMO])) break; if (_sp > XB_SPIN_CAP) { atomicAdd(&(bar)[XB_TMO], 1u); break; } } } } while (0)

struct XcdBarrier {
    unsigned* bar; unsigned x;
    volatile LAS unsigned* st;
};

__device__ __forceinline__ XcdBarrier xcd_barrier_post(unsigned* bar, volatile LAS unsigned* st) {
    XcdBarrier b; b.bar = bar; b.x = xb_xcc_id(); b.st = st;
    if (threadIdx.x == 0) (void)xb_add(&bar[XB_XCNT(b.x)], 1u);
    return b;
}
__device__ __forceinline__ void xcd_barrier_complete(unsigned* bar, unsigned x, unsigned& nloc, unsigned& nx) {
    const unsigned G = gridDim.x * gridDim.y * gridDim.z;
    unsigned sum, cnt, mine, sp = 0u;
    for (;;) {
        sum = 0u; cnt = 0u; mine = 0u;
#pragma unroll
        for (unsigned j = 0; j < 16; ++j) { const unsigned c = xb_ld(&bar[XB_XCNT(j)]); sum += c; cnt += (c > 0u) ? 1u : 0u; mine = (j == x) ? c : mine; }
        if (sum == G) break;
        __builtin_amdgcn_s_sleep(1);
        if ((++sp & 255u) == 0u) { if (xb_ld(&bar[XB_TMO])) break; if (sp > XB_SPIN_CAP) { atomicAdd(&bar[XB_TMO], 1u); break; } }
    }
    nloc = mine > 0u ? mine : 1u; nx = cnt > 0u ? cnt : 1u;
}

__device__ __forceinline__ void xcd_barrier(const XcdBarrier& b) {
    asm volatile("s_waitcnt vmcnt(0)" ::: "memory");
    __syncthreads();
    if (threadIdx.x == 0) {
        unsigned* bar = b.bar;
        __builtin_amdgcn_s_waitcnt(0);
        unsigned nloc = b.st[0], nx = b.st[1];
        if (nloc == 0u) { xcd_barrier_complete(bar, b.x, nloc, nx); b.st[0] = nloc; b.st[1] = nx; }
        const unsigned old = xb_add(&bar[XB_XSUB(b.x)], 1u);
        const unsigned gen = old / nloc;
        if (old + 1u == (gen + 1u) * nloc) {
            __builtin_amdgcn_fence(__ATOMIC_RELEASE, "agent");
            asm volatile("s_waitcnt vmcnt(0)" ::: "memory");
            const unsigned og = xb_add(&bar[XB_TOP], 1u);
            const unsigned tg = og / nx;
            if (og + 1u == (tg + 1u) * nx) xb_add(&bar[XB_TOPGEN], 1u);
            else XB_SPIN(xb_ld(&bar[XB_TOPGEN]) == tg, bar);
            __builtin_amdgcn_fence(__ATOMIC_ACQUIRE, "agent");
            xb_add(&bar[XB_XGEN(b.x)], 1u);
            asm volatile("s_waitcnt vmcnt(0)" ::: "memory");
        } else {
            XB_SPIN(xb_ld(&bar[XB_XGEN(b.x)]) == gen, bar);
            __builtin_amdgcn_fence(__ATOMIC_ACQUIRE, "agent");
            asm volatile("s_waitcnt vmcnt(0)" ::: "memory");
        }
    }
    __syncthreads();
}


__device__ __forceinline__ int colmap(int type, int n) {
    if (type == 1) {
        if (n < 1664) return n;
        if (n < 1696) { const int j = n - 1664; return 1664 + (j >> 1) + 16 * (j & 1); }
        if (n < 1792) return -1;
        return n - 96;
    }
    if (type == 2) {
        const int h = n / 96, c = n % 96; if (c < 64) return n; const int j = c - 64; return h * 96 + 64 + (j >> 1) + 16 * (j & 1);
    }
    return n;
}
__device__ __forceinline__ void wprep(const float* W, int K, int Nsrc, const float* g, bf16_t* dst, int Ndst, int type, size_t gtid, size_t gthreads) {
    const size_t total = (size_t)Ndst * (K / 8);
    for (size_t idx = gtid; idx < total; idx += gthreads) {
        const int n = (int)(idx % Ndst), kc = (int)(idx / Ndst);
        const int src = colmap(type, n);
        float v[8];
#pragma unroll
        for (int j = 0; j < 8; ++j) { const int k = kc * 8 + j; v[j] = src < 0 ? 0.f : W[(size_t)k * Nsrc + src] * (g ? g[k] : 1.f); }
        *(u32x4*)(dst + (size_t)n * K + kc * 8) = pack8(v);
    }
}

__device__ __forceinline__ void wprep_item(const float* W, int K, int Nsrc, const float* g, bf16_t* dst, int Ndst, int type, LAS float* scr, int item, int lane) {
    const int nblk = Ndst / 32, kb = item / nblk, nb = item % nblk, k0 = 64 * kb, n0 = 32 * nb;
    const int src = colmap(type, n0 + (lane & 31));
#pragma unroll 8
    for (int i = 0; i < 32; ++i) { const int kk = 2 * i + (lane >> 5); scr[kk * 33 + (lane & 31)] = src < 0 ? 0.f : W[(size_t)(k0 + kk) * Nsrc + src] * (g ? g[k0 + kk] : 1.f); }
    asm volatile("s_waitcnt lgkmcnt(0)" ::: "memory");
    const int c = lane & 7;
#pragma unroll
    for (int j = 0; j < 4; ++j) { const int n = (lane >> 3) + 8 * j; const LAS float* sp = scr + (8 * c) * 33 + n;
        u32x4 o; o.x = cvt_pk_bf16(sp[0 * 33], sp[1 * 33]); o.y = cvt_pk_bf16(sp[2 * 33], sp[3 * 33]); o.z = cvt_pk_bf16(sp[4 * 33], sp[5 * 33]); o.w = cvt_pk_bf16(sp[6 * 33], sp[7 * 33]);
        *(u32x4*)(dst + (size_t)(n0 + n) * K + k0 + 8 * c) = o; }
    asm volatile("s_waitcnt lgkmcnt(0)" ::: "memory");
}
constexpr int LDS_BYTES = 131072 + 1024 + 64;
constexpr int BARST_OFF = 131072 + 1024;
constexpr size_t WS_BAR = WS_W + 31 * MiB + 768 * 1024;
constexpr int STAG_P1 = 0, STAG_P4 = 0, STAG_P5 = 0, STAG_P6 = 0;
constexpr int N_PHASES = 1 + 6 * DEPTH + 1;

__global__ void __launch_bounds__(512, 2) fwd_megakernel(Params P) {
    extern __shared__ __attribute__((aligned(16))) unsigned char lds_raw[];
    LAS unsigned char* lds = (LAS unsigned char*)lds_raw;
    cg::grid_group grid = cg::this_grid();
    const int G = gridDim.x, bid = blockIdx.x;
    if (threadIdx.x < 2) ((LAS unsigned*)(lds + BARST_OFF))[threadIdx.x] = 0u;
    __syncthreads();
    XcdBarrier xbar; xbar.bar = (unsigned*)(P.ws + WS_BAR); xbar.x = 0; xbar.st = (volatile LAS unsigned*)(lds + BARST_OFF);
    unsigned char* ws = P.ws;
    bf16_t* Wb = (bf16_t*)(ws + WS_W);
    float* SSXA = (float*)(ws + WS_SSXA); float* SSXB = (float*)(ws + WS_SSXB); float* SSQ = (float*)(ws + WS_SSQ); float* SSKV = (float*)(ws + WS_SSKV);
    bf16_t* PB = (bf16_t*)(ws + WS_PB); bf16_t* XB = (bf16_t*)(ws + WS_XB); bf16_t* QB = (bf16_t*)(ws + WS_QB); bf16_t* KVB = (bf16_t*)(ws + WS_KVB); bf16_t* Z = (bf16_t*)(ws + WS_Z);
    const int lo = P.ph_lo, hi = P.ph_hi;
    int ph = 0;
    if (bid == 0) { unsigned* bw = (unsigned*)(P.ws + WS_BAR); for (int i = threadIdx.x; i < 4096 + 256; i += 512) bw[i] = 0u; }
#define PHASE_BEGIN if (ph >= lo && ph < hi) {
#if PROBE_SET
    unsigned long long* TS = (unsigned long long*)(ws + WS_W + 31 * MiB + 512 * 1024);
    if (bid == 0 && threadIdx.x == 0) TS[15] = __builtin_amdgcn_s_memrealtime();
#define PHASE_END   if (ph == 12 && bid == 0 && threadIdx.x == 0) TS[ph] = __builtin_amdgcn_s_memrealtime(); if (ph + 1 < hi) { if (ph == lo) { grid.sync(); xbar = xcd_barrier_post((unsigned*)(P.ws + WS_BAR), (volatile LAS unsigned*)(lds + BARST_OFF)); } else xcd_barrier(xbar); } if (ph < 12 && bid == 0 && threadIdx.x == 0) TS[ph] = __builtin_amdgcn_s_memrealtime(); } ++ph;
#else
#define PHASE_END   if (ph + 1 < hi && !(ph + 2 == N_PHASES && G == 256)) { if (ph == lo) { grid.sync(); xbar = xcd_barrier_post((unsigned*)(P.ws + WS_BAR), (volatile LAS unsigned*)(lds + BARST_OFF)); } else xcd_barrier(xbar); } } ++ph;
#endif

    PHASE_BEGIN
#if (PHMASK >> 0) & 1
    {
        int tid_ = threadIdx.x; asm volatile("" : "+v"(tid_)); const int tid = tid_, lane = tid & 63, wave = tid >> 6;
        const size_t gtid = (size_t)bid * 512 + tid, gthreads = (size_t)G * 512;
        {
            LAS float* scr = (LAS float*)(lds + wave * 16384);
            const int gwv = bid * 8 + wave, ngw = G * 8;
            constexpr int I_IN = 16 * 136, I_UQ = 4 * 24, I_UKV = 2 * 32, I_A = 8 * 32, I_OUT = 16 * 32, I_PP = 4 * 32, I_L = I_IN + I_UQ + I_UKV + 2 * I_A + 2 * I_OUT + I_PP;
            for (int it = gwv; it < DEPTH * I_L; it += ngw) {
                const int L = it / I_L; int r = it % I_L;
                bf16_t* wl = Wb + (size_t)L * WO_END;
                if (r < I_IN) { wprep_item(P.w_in + (size_t)L * 1024 * IN_WIDTH, 1024, IN_WIDTH, P.g_mix + L * 1024, wl + WO_IN, ZW, 1, scr, r, lane); continue; } r -= I_IN;
                if (r < I_UQ) { wprep_item(P.w_uq + (size_t)L * 256 * 768, 256, 768, P.g_q + L * 256, wl + WO_UQ, 768, 2, scr, r, lane); continue; } r -= I_UQ;
                if (r < I_UKV) { wprep_item(P.w_ukv + (size_t)L * 128 * 1024, 128, 1024, P.g_kv + L * 128, wl + WO_UKV, 1024, 0, scr, r, lane); continue; } r -= I_UKV;
                if (r < I_A) { wprep_item(P.w_br_a + (size_t)L * 512 * 1024, 512, 1024, nullptr, wl + WO_A, 1024, 0, scr, r, lane); continue; } r -= I_A;
                if (r < I_A) { wprep_item(P.w_br_b + (size_t)L * 512 * 1024, 512, 1024, nullptr, wl + WO_B, 1024, 0, scr, r, lane); continue; } r -= I_A;
                if (r < I_OUT) { wprep_item(P.w_out + (size_t)L * 1024 * 1024, 1024, 1024, nullptr, wl + WO_OUT, 1024, 0, scr, r, lane); continue; } r -= I_OUT;
                if (r < I_OUT) { wprep_item(P.w_ple_gate + (size_t)L * 1024 * 1024, 1024, 1024, P.g_ple + L * 1024, wl + WO_PG, 1024, 0, scr, r, lane); continue; } r -= I_OUT;
                wprep_item(P.w_ple_proj + (size_t)L * 256 * 1024, 256, 1024, nullptr, wl + WO_PP, 1024, 0, scr, r, lane);
            }
        }
        const int gw = bid * 8 + wave, NGW = G * 8;
        for (int r = gw; r < T; r += NGW) {
            const f32x4* xr = (const f32x4*)(P.x + (size_t)r * D) + lane;
            float s = 0.f;
#pragma unroll
            for (int j = 0; j < 4; ++j) { const f32x4 v = xr[64 * j]; s += (v.x * v.x + v.y * v.y) + (v.z * v.z + v.w * v.w);
                u32x2 o; o.x = cvt_pk_bf16(v.x, v.y); o.y = cvt_pk_bf16(v.z, v.w); *((u32x2*)(XB + (size_t)r * D) + lane + 64 * j) = o; }
#pragma unroll
            for (int o = 1; o < 64; o <<= 1) s += __shfl_xor(s, o);
            if (lane < 16) SSXA[(size_t)r * 16 + lane] = lane == 0 ? s : 0.f;
        }
        const size_t np8 = (size_t)DEPTH * T * PLE / 8;
        for (size_t i = gtid; i < np8; i += gthreads) { const f32x4 a = *(const f32x4*)(P.p + i * 8), c = *(const f32x4*)(P.p + i * 8 + 4);
            u32x4 o; o.x = cvt_pk_bf16(a.x, a.y); o.y = cvt_pk_bf16(a.z, a.w); o.z = cvt_pk_bf16(c.x, c.y); o.w = cvt_pk_bf16(c.z, c.w); *(u32x4*)(PB + i * 8) = o; }
    }
#endif
    PHASE_END

#pragma unroll 1
    for (int L = 0; L < DEPTH; ++L) {
        const bf16_t* wl = Wb + (size_t)L * WO_END;
        PHASE_BEGIN
#if (PHMASK >> 1) & 1
        { pg8::Gemm g{XB, wl + WO_IN, T, ZW, 1024, 1024}; pg8::StaticOrder S; S.init(T, ZW, G, bid);
          EpiZ E{Z, SSXA, SSQ, SSKV, P.pos, lds}; pg8::gemm_phase(lds, g, S, E, STAG_P1); }
    #endif
    PHASE_END
        PHASE_BEGIN
#if (PHMASK >> 2) & 1
        { pg8::Gemm g{Z + ZC_BQD, wl + WO_UQ, T, 768, 256, ZW}; pg8::StaticOrder S; S.init(T, 768, G, bid);
          EpiQB E{QB, SSQ, P.pos, lds}; pg8::gemm_phase(lds, g, S, E); }
        { pg8::Gemm g{Z + ZC_BKVD, wl + WO_UKV, T, 1024, 128, ZW}; pg8::StaticOrder S; S.init(T, 1024, G, bid);
          EpiKVB E{KVB, SSKV, lds}; pg8::gemm_phase(lds, g, S, E); }
    #endif
    PHASE_END
        PHASE_BEGIN
#if (PHMASK >> 3) & 1
        {
            __syncthreads();
            att::attn_mode<0>(lds, QB, KVB, Z, P.pos, nullptr, bid, 2048, G);
            { const int u1 = bid + ((2048 - bid + G - 1) / G) * G; att::attn_mode<1>(lds, QB, KVB, Z, P.pos, P.sink + L * 8, u1, 4096, G); }
        }
    #endif
    PHASE_END
        PHASE_BEGIN
#if (PHMASK >> 4) & 1
        { pg8::Gemm g{Z + ZC_GA, wl + WO_A, T, 1024, 512, ZW}; pg8::Gemm g2{Z + ZC_GB, wl + WO_B, T, 1024, 512, ZW}; pg8::StaticOrder S; S.init(T, 1024, G, bid);
          EpiMerge<0> E{Z, KVB}; EpiMerge<1> E2{Z, KVB}; pg8::gemm_phase_pair(lds, g, g2, S, E, E2); }
    #endif
    PHASE_END
        PHASE_BEGIN
#if (PHMASK >> 5) & 1
        { pg8::Gemm g{KVB, wl + WO_OUT, T, 1024, 1024, 1024}; pg8::StaticOrder S; S.init(T, 1024, G, bid);
          EpiX1<1> E{P.x, XB, Z, SSXB}; pg8::gemm_phase(lds, g, S, E, STAG_P5); }
        { pg8::Gemm g{PB + (size_t)L * T * PLE, wl + WO_PP, T, 1024, 256, 256}; pg8::StaticOrder S; S.init(T, 1024, G, bid);
          EpiPP E{Z}; pg8::gemm_phase(lds, g, S, E); }
    #endif
    PHASE_END
        PHASE_BEGIN
#if (PHMASK >> 6) & 1
        { pg8::Gemm g{Z + ZC_X1B, wl + WO_PG, T, 1024, 1024, ZW}; pg8::StaticOrder S; S.init(T, 1024, G, bid);
          if (L + 1 == DEPTH && G == 256) { EpiX2F E{P.out, Z, SSXB, SSXA, P.g_final, (unsigned*)(P.ws + WS_BAR) + 4096, lds}; pg8::gemm_phase(lds, g, S, E, STAG_P6); }
          else { EpiX2 E{P.out, Z, XB, SSXB, SSXA, lds, L + 1 < DEPTH}; pg8::gemm_phase(lds, g, S, E, STAG_P6); } }
    #endif
    PHASE_END
    }
    PHASE_BEGIN
#if (PHMASK >> 7) & 1
    {
        int tid_ = threadIdx.x; asm volatile("" : "+v"(tid_)); const int tid = tid_, lane = tid & 63, wave = tid >> 6;
        const int gw = G == 256 ? T : bid * 8 + wave, NGW = G * 8;
#if PROBE_SET
        int krows = 0;
        { unsigned long long prev = TS[15], sel = 0; const unsigned long long t0 = prev;
          for (int k = 0; k <= 12; ++k) { const unsigned long long tk = TS[k]; if ((PROBE_SET >> k) & 1) sel += tk - prev; prev = tk; }
          krows = (int)((float)sel / (float)(prev - t0) * 4096.f + 0.5f); }
#endif
        for (int r = gw; r < T; r += NGW) {
            const float rstd = rsqrtf(sum16(SSXA + (size_t)r * 16) * (1.f / 1024.f) + EPS);
            f32x4* xr = (f32x4*)(P.out + (size_t)r * D) + lane; const f32x4* gr = (const f32x4*)P.g_final + lane; const u32x2* xbr = (const u32x2*)(XB + (size_t)r * D) + lane;
#pragma unroll
            for (int j = 0; j < 4; ++j) { const u32x2 xw = xbr[64 * j]; f32x4 v = (f32x4){bflo(xw.x), bfhi(xw.x), bflo(xw.y), bfhi(xw.y)}; const f32x4 gg = gr[64 * j]; v.x *= rstd * gg.x; v.y *= rstd * gg.y; v.z *= rstd * gg.z; v.w *= rstd * gg.w;
#if PROBE_SET
                if (r < krows) { v.x += 0.015f; v.y += 0.015f; v.z += 0.015f; v.w += 0.015f; }
#endif
                xr[64 * j] = v; }
        }
    }
#endif
    PHASE_END
#undef PHASE_BEGIN
#undef PHASE_END
}

extern "C" void kernel_launch(void* const* d_in, const int* in_sizes, int n_in, void* d_out, int out_size, void* d_ws, size_t ws_size, hipStream_t stream) {
    static int grid = 0;
    if (grid == 0) {
        if (n_in != 17 || in_sizes[0] != T * D || out_size != T * D || ws_size < WS_END) {
            fprintf(stderr, "kernel_launch: unexpected shapes/workspace: n_in %d in0 %d out %d ws %zu (need %zu)\n", n_in, n_in > 0 ? in_sizes[0] : -1, out_size, ws_size, (size_t)WS_END); grid = -1; return; }
        int dev = 0, cus = 0, per_cu = 0;
        hipGetDevice(&dev); hipDeviceGetAttribute(&cus, hipDeviceAttributeMultiprocessorCount, dev);
        if (hipFuncSetAttribute((const void*)fwd_megakernel, hipFuncAttributeMaxDynamicSharedMemorySize, LDS_BYTES) != hipSuccess) { fprintf(stderr, "kernel_launch: hipFuncSetAttribute failed\n"); grid = -1; return; }
        if (hipOccupancyMaxActiveBlocksPerMultiprocessor(&per_cu, (const void*)fwd_megakernel, 512, LDS_BYTES) != hipSuccess || per_cu < 1) { fprintf(stderr, "kernel_launch: occupancy query gave %d\n", per_cu); per_cu = 1; }
        (void)hipGetLastError();
        grid = cus * 1;
        fprintf(stderr, "kernel_launch: grid %d (cus %d, per_cu %d)\n", grid, cus, per_cu);
    }
    if (grid < 0) return;
    Params p{};
    p.x = (const float*)d_in[0]; p.p = (const float*)d_in[1]; p.pos = (const int*)d_in[2];
    p.g_mix = (const float*)d_in[3]; p.w_in = (const float*)d_in[4]; p.sink = (const float*)d_in[5]; p.g_q = (const float*)d_in[6]; p.w_uq = (const float*)d_in[7];
    p.g_kv = (const float*)d_in[8]; p.w_ukv = (const float*)d_in[9]; p.w_br_a = (const float*)d_in[10]; p.w_br_b = (const float*)d_in[11]; p.w_out = (const float*)d_in[12];
    p.g_ple = (const float*)d_in[13]; p.w_ple_gate = (const float*)d_in[14]; p.w_ple_proj = (const float*)d_in[15]; p.g_final = (const float*)d_in[16];
    p.out = (float*)d_out; p.ws = (unsigned char*)d_ws;
#if ONE_LAUNCH
    p.ph_lo = 0; p.ph_hi = N_PHASES;
    { void* args[] = {&p}; hipError_t e = hipLaunchCooperativeKernel((const void*)fwd_megakernel, dim3(grid), dim3(512), args, LDS_BYTES, stream);
      if (e != hipSuccess) fprintf(stderr, "cooperative launch failed: %s (grid %d)\n", hipGetErrorString(e), grid); }
#else
    for (int ph = 0; ph < N_PHASES; ++ph) {
        p.ph_lo = ph; p.ph_hi = ph + 1;
        void* args[] = {&p}; hipError_t e = hipLaunchCooperativeKernel((const void*)fwd_megakernel, dim3(grid), dim3(512), args, LDS_BYTES, stream);
        if (e != hipSuccess) { fprintf(stderr, "cooperative launch %d failed: %s (grid %d)\n", ph, hipGetErrorString(e), grid); break; }
    }
#endif
}
```

```cpp
#include <hip/hip_runtime.h>
#include <hip/hip_cooperative_groups.h>
#include <cstdio>
#include <cstdint>
namespace cg = cooperative_groups;

#ifndef PHMASK
#define PHMASK 255
#endif
#ifndef PROBE_SET
#define PROBE_SET 0
#endif
#ifndef ONE_LAUNCH
#define ONE_LAUNCH 1
#endif

#define LAS __attribute__((address_space(3)))
typedef unsigned short bf16_t;
typedef short bf16x8 __attribute__((ext_vector_type(8)));
typedef float f32x4 __attribute__((ext_vector_type(4)));
typedef float f32x16 __attribute__((ext_vector_type(16)));
typedef unsigned u32x4 __attribute__((ext_vector_type(4)));
typedef unsigned u32x2 __attribute__((ext_vector_type(2)));

constexpr int BATCH = 32, SEQ = 2048, T = BATCH * SEQ, D = 1024, DEPTH = 2, PLE = 256;
constexpr int ZW = 4352;
constexpr int ZC_QA = 0, ZC_KA = 512, ZC_VA = 640, ZC_GA = 768, ZC_BQD = 1280, ZC_BKVD = 1536, ZC_KR = 1664, ZC_GB = 1792, ZC_MA = 2304, ZC_MB = 3328;
constexpr int ZC_X1B = ZC_MA, ZC_T2 = 0;
constexpr int IN_WIDTH = 4256;
constexpr float EPS = 1e-6f;
constexpr float LOG2E = 1.4426950408889634f;

constexpr size_t WO_IN = 0, WO_UQ = WO_IN + (size_t)ZW * 1024, WO_UKV = WO_UQ + 768 * 256, WO_A = WO_UKV + 1024 * 128, WO_B = WO_A + 1024 * 512,
                 WO_OUT = WO_B + 1024 * 512, WO_PG = WO_OUT + 1024 * 1024, WO_PP = WO_PG + 1024 * 1024, WO_END = WO_PP + 1024 * 256;
constexpr size_t MiB = 1u << 20;
constexpr size_t WS_W = 0, WS_SSXA = 32 * MiB, WS_SSXB = 36 * MiB, WS_SSQ = 40 * MiB, WS_SSKV = 41 * MiB, WS_PB = 42 * MiB, WS_XB = 106 * MiB,
                 WS_QB = 234 * MiB, WS_KVB = 330 * MiB, WS_Z = 458 * MiB, WS_END = 1002 * MiB;
static_assert(2 * WO_END * 2 <= 32 * MiB, "weights fit");
static_assert((size_t)T * ZW * 2 == 544 * MiB, "Z size");

struct Params {
    const float* x; const float* p; const int* pos;
    const float *g_mix, *w_in, *sink, *g_q, *w_uq, *g_kv, *w_ukv, *w_br_a, *w_br_b, *w_out, *g_ple, *w_ple_gate, *w_ple_proj, *g_final;
    float* out; unsigned char* ws;
    int ph_lo, ph_hi;
};

__device__ __forceinline__ unsigned cvt_pk_bf16(float lo, float hi) { unsigned r; asm volatile("v_cvt_pk_bf16_f32 %0, %1, %2" : "=v"(r) : "v"(lo), "v"(hi)); return r; }
__device__ __forceinline__ float bflo(unsigned w) { return __uint_as_float(w << 16); }
__device__ __forceinline__ float bfhi(unsigned w) { return __uint_as_float(w & 0xffff0000u); }
__device__ __forceinline__ float fsigmoid(float x) { return __builtin_amdgcn_rcpf(1.f + __expf(-x)); }
__device__ __forceinline__ float fsilu(float x) { return x * fsigmoid(x); }
__device__ __forceinline__ u32x4 pack8(const float* v) { u32x4 w; w.x = cvt_pk_bf16(v[0], v[1]); w.y = cvt_pk_bf16(v[2], v[3]); w.z = cvt_pk_bf16(v[4], v[5]); w.w = cvt_pk_bf16(v[6], v[7]); return w; }
__device__ __forceinline__ void unpack8(u32x4 w, float* v) { v[0] = bflo(w.x); v[1] = bfhi(w.x); v[2] = bflo(w.y); v[3] = bfhi(w.y); v[4] = bflo(w.z); v[5] = bfhi(w.z); v[6] = bflo(w.w); v[7] = bfhi(w.w); }
__device__ __forceinline__ float sum16(const float* s) { const f32x4 a = *(const f32x4*)s, b = *(const f32x4*)(s + 4), c = *(const f32x4*)(s + 8), d = *(const f32x4*)(s + 12);
    return ((a.x + a.y) + (a.z + a.w)) + ((b.x + b.y) + (b.z + b.w)) + ((c.x + c.y) + (c.z + c.w)) + ((d.x + d.y) + (d.z + d.w)); }
__device__ __forceinline__ float sum4(const float* s) { const f32x4 a = *(const f32x4*)s; return (a.x + a.y) + (a.z + a.w); }
__device__ __forceinline__ void rope8(float* v, int i0, float posf) {
#pragma unroll
    for (int j = 0; j < 4; ++j) {
        const float ci = __builtin_amdgcn_exp2f(-(float)(i0 + j) * 0.83048202372184059f) * 0.15915494309189535f;
        float r = posf * ci; r = r - rintf(r);
        const float sn = __builtin_amdgcn_sinf(r), cs = __builtin_amdgcn_cosf(r);
        const float x1 = v[2 * j], x2 = v[2 * j + 1];
        v[2 * j] = x1 * cs - x2 * sn; v[2 * j + 1] = x2 * cs + x1 * sn;
    }
}

namespace pg8 {
constexpr int BM = 256, BK = 64, HALF = 128, HTB = HALF * BK * 2, STAGE_BYTES = 8 * HTB, NXCD = 8, WGM = 8;
__host__ __device__ __forceinline__ int lds_byte(int r, int c) { const int st = (r >> 4) * 2 + (c >> 5), rr = r & 15, cc = c & 31, ob = rr * 64 + cc * 2; return st * 1024 + (ob ^ (((ob >> 9) & 1) << 5)); }
__host__ __device__ __forceinline__ void stage_rc(int b, int& R, int& C) { const int st = b / 1024, sb = b % 1024, swz = sb ^ (((sb >> 9) & 1) << 5); R = (st >> 1) * 16 + swz / 64; C = (st & 1) * 32 + (swz % 64) / 2; }
__host__ __device__ __forceinline__ int perm32(int rho) { const int n = rho >> 4, i = rho & 15; return 8 * (i >> 2) + 4 * n + (i & 3); }

struct Unit { int pm, pn; };
struct Gemm { const bf16_t* A; const bf16_t* Bt; int M, N, K, lda; };

struct StaticOrder {
    int nM, nN, nwg, G, c;
    __host__ __device__ void init(int M, int N, int G_, int c_) { nM = M / BM; nN = N / BM; nwg = nM * nN; G = G_; c = c_; }
    __host__ __device__ bool next(int i, Unit& u) const {
        const long L = (long)i * G + c; if (L >= nwg) return false;
        int wgid = (int)L; { const int q = nwg / NXCD, r = nwg % NXCD, xcd = wgid % NXCD, off = wgid / NXCD; wgid = (xcd < r ? xcd * (q + 1) : r * (q + 1) + (xcd - r) * q) + off; }
        const int nig = WGM * nN, gid = wgid / nig, fm = gid * WGM, gsz = (nM - fm) < WGM ? (nM - fm) : WGM;
        u.pm = fm + ((wgid % nig) % gsz); u.pn = (wgid % nig) / gsz; return true;
    }
};

template <class Epi>
__device__ __forceinline__ void gemm_phase(LAS unsigned char* lds, const Gemm g, const StaticOrder& S, const Epi& E, int stag = 0) {
    if (stag > 0) {
        const unsigned long long t0_ = __builtin_amdgcn_s_memrealtime(); const unsigned long long w_ = (unsigned long long)(((blockIdx.x >> 3) & 3) * stag);
        while (__builtin_amdgcn_s_memrealtime() - t0_ < w_) __builtin_amdgcn_s_sleep(8);
    }
    int tid_ = threadIdx.x; asm volatile("" : "+v"(tid_));
    const int tid = tid_, wid = __builtin_amdgcn_readfirstlane(tid >> 6), lane = tid & 63, wr = wid >> 2, wc = wid & 3, fr = lane & 15, fq = lane >> 4;
    const int K = g.K, nt = K / BK, lda = g.lda;
    unsigned voffA[2], voffB[2];
#pragma unroll
    for (int i = 0; i < 2; ++i) { int R, C; stage_rc(tid * 16 + i * 8192, R, C); const int Rb = (R & ~31) + perm32(R & 31);
        voffA[i] = (unsigned)(R * lda + C) * 2u; voffB[i] = (unsigned)(Rb * K + C) * 2u; }
    const size_t kstep = (size_t)(BK * 2);
    const size_t hstepA = (size_t)HALF * lda * 2, hstepB = (size_t)HALF * K * 2;
    const size_t tstepA = 2 * hstepA, tstepB = 2 * hstepB;
    const unsigned ldsw = (unsigned)wid * 1024u;
    const int aoff = lds_byte(wr * 64 + fr, fq * 8), boff = lds_byte(wc * 32 + fr, fq * 8);
#define PG8_SA(b, h) (((b) * 2 + (h)) * HTB)
#define PG8_SB(b, h) ((4 + (b) * 2 + (h)) * HTB)
#define PG8_STAGE(bufoff, gbase, voff) do { _Pragma("unroll") for (int _i = 0; _i < 2; ++_i) \
        { unsigned vo_ = (voff)[_i]; asm volatile("" : "+v"(vo_)); __builtin_amdgcn_global_load_lds((const unsigned*)((const char*)(gbase) + vo_), (LAS unsigned*)(lds + (bufoff) + ldsw + _i * 8192), 16, 0, 0); } } while (0)
#define PG8_LDA(dst, b, h) do { _Pragma("unroll") for (int m = 0; m < 4; ++m) _Pragma("unroll") for (int k = 0; k < 2; ++k) dst[m][k] = *(const LAS bf16x8*)(lds + PG8_SA(b, h) + aoff + m * 2048 + k * 1024); } while (0)
#define PG8_LDB(dst, b, h) do { _Pragma("unroll") for (int n = 0; n < 2; ++n) _Pragma("unroll") for (int k = 0; k < 2; ++k) dst[n][k] = *(const LAS bf16x8*)(lds + PG8_SB(b, h) + boff + n * 2048 + k * 1024); } while (0)
#define PG8_MMA(ai, bj, At, Bt) do { __builtin_amdgcn_s_setprio(1); _Pragma("unroll") for (int m = 0; m < 4; ++m) _Pragma("unroll") for (int n = 0; n < 2; ++n) _Pragma("unroll") for (int k = 0; k < 2; ++k) \
        acc[ai][bj][m][n] = __builtin_amdgcn_mfma_f32_16x16x32_bf16(Bt[n][k], At[m][k], acc[ai][bj][m][n], 0, 0, 0); __builtin_amdgcn_s_setprio(0); } while (0)
#define PG8_WAIT_V(n) asm volatile("s_waitcnt vmcnt(" #n ")" ::: "memory")
#define PG8_WAIT_L(n) asm volatile("s_waitcnt lgkmcnt(" #n ")" ::: "memory")
#define PG8_BAR __builtin_amdgcn_s_barrier()
#define PG8_SCHED __builtin_amdgcn_sched_barrier(0)
    Unit cur, nxt; int ui = 0;
    if (!S.next(0, cur)) return;
    f32x4 acc[2][2][4][2];
#pragma unroll
    for (int a = 0; a < 2; ++a)
#pragma unroll
        for (int b = 0; b < 2; ++b)
#pragma unroll
            for (int m = 0; m < 4; ++m)
#pragma unroll
                for (int n = 0; n < 2; ++n) acc[a][b][m][n] = (f32x4){0.f, 0.f, 0.f, 0.f};
    bf16x8 At[4][2], B0[2][2], B1[2][2];
    const char* cA = (const char*)g.A + (size_t)cur.pm * tstepA; const char* cB = (const char*)g.Bt + (size_t)cur.pn * tstepB;
    PG8_STAGE(PG8_SB(0, 0), cB, voffB); PG8_STAGE(PG8_SB(0, 1), cB + hstepB, voffB); PG8_STAGE(PG8_SA(0, 0), cA, voffA); PG8_STAGE(PG8_SA(0, 1), cA + hstepA, voffA);
    if (wr == 1) PG8_BAR;
    PG8_WAIT_V(2); PG8_BAR;
    PG8_STAGE(PG8_SB(1, 0), cB + kstep, voffB); PG8_STAGE(PG8_SA(1, 0), cA + kstep, voffA); PG8_STAGE(PG8_SB(1, 1), cB + hstepB + kstep, voffB);
    PG8_WAIT_V(6); PG8_BAR;
    for (;;) {
        const bool has_next = S.next(ui + 1, nxt);
        const char* nA = has_next ? (const char*)g.A + (size_t)nxt.pm * tstepA : cA; const char* nB = has_next ? (const char*)g.Bt + (size_t)nxt.pn * tstepB : cB;
#pragma unroll 1
        for (int t = 0; t < nt; t += 2) {
            const bool last = (t == nt - 2);
            const char* a1 = cA + (size_t)(t + 1) * kstep;
            const char* a2 = last ? nA : cA + (size_t)(t + 2) * kstep; const char* b2 = last ? nB : cB + (size_t)(t + 2) * kstep;
            const char* a3 = a2 + kstep; const char* b3 = b2 + kstep;
            PG8_LDB(B0, 0, 0); PG8_LDB(B1, 0, 1); PG8_SCHED; PG8_LDA(At, 0, 0); PG8_STAGE(PG8_SA(1, 1), a1 + hstepA, voffA);
            PG8_WAIT_V(8); PG8_WAIT_L(0); PG8_BAR; PG8_MMA(0, 0, At, B0); PG8_MMA(0, 1, At, B1); PG8_BAR; PG8_SCHED;
            PG8_LDA(At, 0, 1); PG8_STAGE(PG8_SB(0, 0), b2, voffB); PG8_STAGE(PG8_SB(0, 1), b2 + hstepB, voffB); PG8_STAGE(PG8_SA(0, 0), a2, voffA);
            PG8_WAIT_V(8); PG8_WAIT_L(0); PG8_BAR; PG8_MMA(1, 0, At, B0); PG8_MMA(1, 1, At, B1); PG8_BAR; PG8_SCHED;
            PG8_LDB(B0, 1, 0); PG8_LDB(B1, 1, 1); PG8_SCHED; PG8_LDA(At, 1, 0); PG8_STAGE(PG8_SA(0, 1), a2 + hstepA, voffA);
            PG8_WAIT_V(8); PG8_WAIT_L(0); PG8_BAR; PG8_MMA(0, 0, At, B0); PG8_MMA(0, 1, At, B1); PG8_BAR; PG8_SCHED;
            PG8_LDA(At, 1, 1); PG8_STAGE(PG8_SB(1, 0), b3, voffB); PG8_STAGE(PG8_SB(1, 1), b3 + hstepB, voffB); PG8_STAGE(PG8_SA(1, 0), a3, voffA);
            PG8_WAIT_V(8); PG8_WAIT_L(0); PG8_BAR; PG8_MMA(1, 0, At, B0); PG8_MMA(1, 1, At, B1); PG8_BAR; PG8_SCHED;
        }
        if (wr == 0) PG8_BAR;
        E(acc, cur, wr, wc, fr, fq);
        if (!has_next) break;
#pragma unroll
        for (int a = 0; a < 2; ++a)
#pragma unroll
            for (int b = 0; b < 2; ++b)
#pragma unroll
                for (int m = 0; m < 4; ++m)
#pragma unroll
                    for (int n = 0; n < 2; ++n) acc[a][b][m][n] = (f32x4){0.f, 0.f, 0.f, 0.f};
        cur = nxt; cA = nA; cB = nB; ++ui;
        if (wr == 1) PG8_BAR;
    }
    PG8_WAIT_V(0);
    PG8_BAR;
}
template <class Epi1, class Epi2>
__device__ __forceinline__ void gemm_phase_pair(LAS unsigned char* lds, const Gemm g, const Gemm g2, const StaticOrder& S, const Epi1& E, const Epi2& E2) {
    const int stag = 0;
    if (stag > 0) {
        const unsigned long long t0_ = __builtin_amdgcn_s_memrealtime(); const unsigned long long w_ = (unsigned long long)(((blockIdx.x >> 3) & 3) * stag);
        while (__builtin_amdgcn_s_memrealtime() - t0_ < w_) __builtin_amdgcn_s_sleep(8);
    }
    int tid_ = threadIdx.x; asm volatile("" : "+v"(tid_));
    const int tid = tid_, wid = __builtin_amdgcn_readfirstlane(tid >> 6), lane = tid & 63, wr = wid >> 2, wc = wid & 3, fr = lane & 15, fq = lane >> 4;
    const int K = g.K, nt = K / BK, lda = g.lda;
    unsigned voffA[2], voffB[2];
#pragma unroll
    for (int i = 0; i < 2; ++i) { int R, C; stage_rc(tid * 16 + i * 8192, R, C); const int Rb = (R & ~31) + perm32(R & 31);
        voffA[i] = (unsigned)(R * lda + C) * 2u; voffB[i] = (unsigned)(Rb * K + C) * 2u; }
    const size_t kstep = (size_t)(BK * 2);
    const size_t hstepA = (size_t)HALF * lda * 2, hstepB = (size_t)HALF * K * 2;
    const size_t tstepA = 2 * hstepA, tstepB = 2 * hstepB;
    const unsigned ldsw = (unsigned)wid * 1024u;
    const int aoff = lds_byte(wr * 64 + fr, fq * 8), boff = lds_byte(wc * 32 + fr, fq * 8);
#define PG8_SA(b, h) (((b) * 2 + (h)) * HTB)
#define PG8_SB(b, h) ((4 + (b) * 2 + (h)) * HTB)
#define PG8_STAGE(bufoff, gbase, voff) do { _Pragma("unroll") for (int _i = 0; _i < 2; ++_i) \
        { unsigned vo_ = (voff)[_i]; asm volatile("" : "+v"(vo_)); __builtin_amdgcn_global_load_lds((const unsigned*)((const char*)(gbase) + vo_), (LAS unsigned*)(lds + (bufoff) + ldsw + _i * 8192), 16, 0, 0); } } while (0)
#define PG8_LDA(dst, b, h) do { _Pragma("unroll") for (int m = 0; m < 4; ++m) _Pragma("unroll") for (int k = 0; k < 2; ++k) dst[m][k] = *(const LAS bf16x8*)(lds + PG8_SA(b, h) + aoff + m * 2048 + k * 1024); } while (0)
#define PG8_LDB(dst, b, h) do { _Pragma("unroll") for (int n = 0; n < 2; ++n) _Pragma("unroll") for (int k = 0; k < 2; ++k) dst[n][k] = *(const LAS bf16x8*)(lds + PG8_SB(b, h) + boff + n * 2048 + k * 1024); } while (0)
#define PG8_MMA(ai, bj, At, Bt) do { __builtin_amdgcn_s_setprio(1); _Pragma("unroll") for (int m = 0; m < 4; ++m) _Pragma("unroll") for (int n = 0; n < 2; ++n) _Pragma("unroll") for (int k = 0; k < 2; ++k) \
        acc[ai][bj][m][n] = __builtin_amdgcn_mfma_f32_16x16x32_bf16(Bt[n][k], At[m][k], acc[ai][bj][m][n], 0, 0, 0); __builtin_amdgcn_s_setprio(0); } while (0)
#define PG8_WAIT_V(n) asm volatile("s_waitcnt vmcnt(" #n ")" ::: "memory")
#define PG8_WAIT_L(n) asm volatile("s_waitcnt lgkmcnt(" #n ")" ::: "memory")
#define PG8_BAR __builtin_amdgcn_s_barrier()
#define PG8_SCHED __builtin_amdgcn_sched_barrier(0)
    Unit cur, nxt; int ui = 0;
    if (!S.next(0, cur)) return;
    int which = 0;
    f32x4 acc[2][2][4][2];
#pragma unroll
    for (int a = 0; a < 2; ++a)
#pragma unroll
        for (int b = 0; b < 2; ++b)
#pragma unroll
            for (int m = 0; m < 4; ++m)
#pragma unroll
                for (int n = 0; n < 2; ++n) acc[a][b][m][n] = (f32x4){0.f, 0.f, 0.f, 0.f};
    bf16x8 At[4][2], B0[2][2], B1[2][2];
    const char* cA = (const char*)g.A + (size_t)cur.pm * tstepA; const char* cB = (const char*)g.Bt + (size_t)cur.pn * tstepB;
    PG8_STAGE(PG8_SB(0, 0), cB, voffB); PG8_STAGE(PG8_SB(0, 1), cB + hstepB, voffB); PG8_STAGE(PG8_SA(0, 0), cA, voffA); PG8_STAGE(PG8_SA(0, 1), cA + hstepA, voffA);
    if (wr == 1) PG8_BAR;
    PG8_WAIT_V(2); PG8_BAR;
    PG8_STAGE(PG8_SB(1, 0), cB + kstep, voffB); PG8_STAGE(PG8_SA(1, 0), cA + kstep, voffA); PG8_STAGE(PG8_SB(1, 1), cB + hstepB + kstep, voffB);
    PG8_WAIT_V(6); PG8_BAR;
    for (;;) {
        const int nwhich = which ^ 1;
        bool has_next = true; if (which == 0) nxt = cur; else has_next = S.next((ui >> 1) + 1, nxt);
        const char* nA = has_next ? (const char*)(nwhich ? g2.A : g.A) + (size_t)nxt.pm * tstepA : cA; const char* nB = has_next ? (const char*)(nwhich ? g2.Bt : g.Bt) + (size_t)nxt.pn * tstepB : cB;
#pragma unroll 1
        for (int t = 0; t < nt; t += 2) {
            const bool last = (t == nt - 2);
            const char* a1 = cA + (size_t)(t + 1) * kstep;
            const char* a2 = last ? nA : cA + (size_t)(t + 2) * kstep; const char* b2 = last ? nB : cB + (size_t)(t + 2) * kstep;
            const char* a3 = a2 + kstep; const char* b3 = b2 + kstep;
            PG8_LDB(B0, 0, 0); PG8_LDB(B1, 0, 1); PG8_SCHED; PG8_LDA(At, 0, 0); PG8_STAGE(PG8_SA(1, 1), a1 + hstepA, voffA);
            PG8_WAIT_V(8); PG8_WAIT_L(0); PG8_BAR; PG8_MMA(0, 0, At, B0); PG8_MMA(0, 1, At, B1); PG8_BAR; PG8_SCHED;
            PG8_LDA(At, 0, 1); PG8_STAGE(PG8_SB(0, 0), b2, voffB); PG8_STAGE(PG8_SB(0, 1), b2 + hstepB, voffB); PG8_STAGE(PG8_SA(0, 0), a2, voffA);
            PG8_WAIT_V(8); PG8_WAIT_L(0); PG8_BAR; PG8_MMA(1, 0, At, B0); PG8_MMA(1, 1, At, B1); PG8_BAR; PG8_SCHED;
            PG8_LDB(B0, 1, 0); PG8_LDB(B1, 1, 1); PG8_SCHED; PG8_LDA(At, 1, 0); PG8_STAGE(PG8_SA(0, 1), a2 + hstepA, voffA);
            PG8_WAIT_V(8); PG8_WAIT_L(0); PG8_BAR; PG8_MMA(0, 0, At, B0); PG8_MMA(0, 1, At, B1); PG8_BAR; PG8_SCHED;
            PG8_LDA(At, 1, 1); PG8_STAGE(PG8_SB(1, 0), b3, voffB); PG8_STAGE(PG8_SB(1, 1), b3 + hstepB, voffB); PG8_STAGE(PG8_SA(1, 0), a3, voffA);
            PG8_WAIT_V(8); PG8_WAIT_L(0); PG8_BAR; PG8_MMA(1, 0, At, B0); PG8_MMA(1, 1, At, B1); PG8_BAR; PG8_SCHED;
        }
        if (wr == 0) PG8_BAR;
        if (which) E2(acc, cur, wr, wc, fr, fq); else E(acc, cur, wr, wc, fr, fq);
        if (!has_next) break;
#pragma unroll
        for (int a = 0; a < 2; ++a)
#pragma unroll
            for (int b = 0; b < 2; ++b)
#pragma unroll
                for (int m = 0; m < 4; ++m)
#pragma unroll
                    for (int n = 0; n < 2; ++n) acc[a][b][m][n] = (f32x4){0.f, 0.f, 0.f, 0.f};
        cur = nxt; cA = nA; cB = nB; ++ui; which = nwhich;
        if (wr == 1) PG8_BAR;
    }
    PG8_WAIT_V(0);
    PG8_BAR;
#undef PG8_SA
#undef PG8_SB
#undef PG8_STAGE
#undef PG8_LDA
#undef PG8_LDB
#undef PG8_MMA
#undef PG8_WAIT_V
#undef PG8_WAIT_L
#undef PG8_BAR
#undef PG8_SCHED
}
}

typedef f32x4 Acc[2][2][4][2];
__device__ __forceinline__ bool epi_fence() { asm volatile("" ::: "memory"); return true; }
#define EPI_ROWS(u, wr, fr) const int row0_ = (u).pm * 256 + (wr) * 64 + (fr);
#define EPI_LOADV(v) float v[8]; { const f32x4 a0_ = acc[ai][bj][m][0], a1_ = acc[ai][bj][m][1]; v[0] = a0_[0]; v[1] = a0_[1]; v[2] = a0_[2]; v[3] = a0_[3]; v[4] = a1_[0]; v[5] = a1_[1]; v[6] = a1_[2]; v[7] = a1_[3]; }
constexpr int RTAB_OFF = 131072;
template <int NSLOT>
__device__ __forceinline__ void fill_rtab(LAS unsigned char* lds, const float* ss, int pm, float inv_n, float mul) {
    int tid_ = threadIdx.x; asm volatile("" : "+v"(tid_));
    if (tid_ < 256) { const float* s = ss + ((size_t)pm * 256 + tid_) * NSLOT; const float t = NSLOT == 16 ? sum16(s) : sum4(s);
        ((LAS float*)(lds + RTAB_OFF))[tid_] = rsqrtf(t * inv_n + EPS) * mul; }
    asm volatile("s_waitcnt lgkmcnt(0)" ::: "memory"); __builtin_amdgcn_s_barrier(); asm volatile("" ::: "memory");
}
#define RTAB(ai, m) (((const LAS float*)(lds + RTAB_OFF))[(ai) * 128 + wr * 64 + (m) * 16 + fr])

struct EpiZ {
    bf16_t* Z; const float* ssx; float* ssq; float* sskv; const int* pos; LAS unsigned char* lds;
    __device__ __forceinline__ void operator()(const Acc& acc, const pg8::Unit& u, int wr, int wc, int fr, int fq) const {
        EPI_ROWS(u, wr, fr)
        fill_rtab<16>(lds, ssx, u.pm, 1.f / 1024.f, 1.f);
        const int pn = u.pn;
        const int cbase = pn * 256 + wc * 32 + 8 * fq;
#pragma unroll
        for (int ai = 0; ai < 2; ++ai)
#pragma unroll
        for (int m = 0; m < 4; ++m) {
            const int row = row0_ + ai * 128 + m * 16;
            const float rstd = RTAB(ai, m);
            bf16_t* zr = Z + (size_t)row * ZW + cbase;
            float st = 0.f; u32x4 gq8 = (u32x4){0u, 0u, 0u, 0u};
#pragma unroll
            for (int bj = 0; bj < 2; ++bj) {
                EPI_LOADV(v)
#pragma unroll
                for (int j = 0; j < 8; ++j) v[j] *= rstd;
                bool store = true;
                if (pn <= 1) {
#pragma unroll
                    for (int j = 0; j < 8; ++j) v[j] *= (0.125f * LOG2E);
                } else if (pn == 3 || pn == 4 || pn == 7 || pn == 8) {
#pragma unroll
                    for (int j = 0; j < 8; ++j) v[j] = fsilu(v[j]);
                } else if (pn >= 9) {
#pragma unroll
                    for (int j = 0; j < 8; ++j) v[j] = fsigmoid(v[j]);
                } else if (pn == 5) {
#pragma unroll
                    for (int j = 0; j < 8; ++j) st += v[j] * v[j];
                } else if (pn == 6) {
                    if (bj == 0) {
#pragma unroll
                        for (int j = 0; j < 8; ++j) st += v[j] * v[j];
                    } else {
                        if (wc == 0) rope8(v, 4 * fq, (float)pos[row]); else store = false;
                    }
                }
                if (pn >= 9) {
                    u32x2 q8;
                    q8.x = (unsigned)(v[0] * 255.f + 0.5f) | ((unsigned)(v[1] * 255.f + 0.5f) << 8) | ((unsigned)(v[2] * 255.f + 0.5f) << 16) | ((unsigned)(v[3] * 255.f + 0.5f) << 24);
                    q8.y = (unsigned)(v[4] * 255.f + 0.5f) | ((unsigned)(v[5] * 255.f + 0.5f) << 8) | ((unsigned)(v[6] * 255.f + 0.5f) << 16) | ((unsigned)(v[7] * 255.f + 0.5f) << 24);
                    if (bj == 0) { gq8.x = q8.x; gq8.y = q8.y; } else { gq8.z = q8.x; gq8.w = q8.y; }
                } else if (store) *(u32x4*)(zr + bj * 128) = pack8(v);
            }
            if (pn >= 9) *(u32x4*)((unsigned char*)(Z + (size_t)row * ZW + ZC_MA) + (pn - 9) * 256 + (wc * 32 + 8 * fq) * 2) = gq8;
            if (pn == 5 || pn == 6) {
                st += __shfl_xor(st, 16); st += __shfl_xor(st, 32);
                if (fq == 0) { if (pn == 5) ssq[(size_t)row * 4 + wc] = st; else sskv[(size_t)row * 4 + wc] = st; }
            }
        }
    }
};
struct EpiQB {
    bf16_t* QB; const float* ssq; const int* pos; LAS unsigned char* lds;
    __device__ __forceinline__ void operator()(const Acc& acc, const pg8::Unit& u, int wr, int wc, int fr, int fq) const {
        EPI_ROWS(u, wr, fr)
        fill_rtab<4>(lds, ssq, u.pm, 1.f / 256.f, 0.10206207261596577f * LOG2E);
        const int cbase = u.pn * 256 + wc * 32 + 8 * fq;
        const int c0 = cbase, c1 = cbase + 128, cc0 = c0 % 96, cc1 = c1 % 96;
        const bool anyrope = (cc0 >= 64) || (cc1 >= 64);
#pragma unroll
        for (int ai = 0; ai < 2; ++ai)
#pragma unroll
        for (int m = 0; m < 4; ++m) {
            const int row = row0_ + ai * 128 + m * 16;
            epi_fence();
            const float rstd = RTAB(ai, m);
            float posf = 0.f; if (anyrope) posf = (float)pos[row];
#pragma unroll
            for (int bj = 0; bj < 2; ++bj) {
                EPI_LOADV(v)
#pragma unroll
                for (int j = 0; j < 8; ++j) v[j] *= rstd;
                const int cc = bj ? cc1 : cc0;
                if (cc >= 64) rope8(v, (cc - 64) >> 1, posf);
                *(u32x4*)(QB + (size_t)row * 768 + cbase + bj * 128) = pack8(v);
            }
        }
    }
};
struct EpiKVB {
    bf16_t* KVB; const float* sskv; LAS unsigned char* lds;
    __device__ __forceinline__ void operator()(const Acc& acc, const pg8::Unit& u, int wr, int wc, int fr, int fq) const {
        EPI_ROWS(u, wr, fr)
        fill_rtab<4>(lds, sskv, u.pm, 1.f / 128.f, 1.f);
        const int cbase = u.pn * 256 + wc * 32 + 8 * fq;
#pragma unroll
        for (int ai = 0; ai < 2; ++ai)
#pragma unroll
        for (int m = 0; m < 4; ++m) {
            const int row = row0_ + ai * 128 + m * 16;
            const float rstd = RTAB(ai, m);
#pragma unroll
            for (int bj = 0; bj < 2; ++bj) {
                EPI_LOADV(v)
#pragma unroll
                for (int j = 0; j < 8; ++j) v[j] *= rstd;
                *(u32x4*)(KVB + (size_t)row * 1024 + cbase + bj * 128) = pack8(v);
            }
        }
    }
};
template <int SECOND> struct EpiMerge {
    bf16_t* Z; bf16_t* Y;
    __device__ __forceinline__ void operator()(const Acc& acc, const pg8::Unit& u, int wr, int wc, int fr, int fq) const {
        EPI_ROWS(u, wr, fr)
        const int cbase = u.pn * 256 + wc * 32 + 8 * fq;
#pragma unroll
        for (int ai = 0; ai < 2; ++ai) {
            epi_fence();
            u32x4 sgq[4]; u32x4 tg[4][2];
#pragma unroll
            for (int m = 0; m < 4; ++m) { const bf16_t* zr = Z + (size_t)(row0_ + ai * 128 + m * 16) * ZW;
                sgq[m] = *(const u32x4*)((const unsigned char*)(zr + ZC_MA) + (SECOND ? 1024 : 0) + u.pn * 256 + (wc * 32 + 8 * fq) * 2);
#pragma unroll
                for (int bj = 0; bj < 2; ++bj) { if (SECOND) tg[m][bj] = *(const u32x4*)(zr + ZC_MB + cbase + bj * 128); } }
#pragma unroll
            for (int m = 0; m < 4; ++m)
#pragma unroll
                for (int bj = 0; bj < 2; ++bj) {
                    EPI_LOADV(v)
                    const unsigned g0 = bj ? sgq[m].z : sgq[m].x, g1 = bj ? sgq[m].w : sgq[m].y;
                    const float s[8] = {(float)(g0 & 255u), (float)((g0 >> 8) & 255u), (float)((g0 >> 16) & 255u), (float)(g0 >> 24), (float)(g1 & 255u), (float)((g1 >> 8) & 255u), (float)((g1 >> 16) & 255u), (float)(g1 >> 24)};
#pragma unroll
                    for (int j = 0; j < 8; ++j) v[j] *= s[j] * (1.f / 255.f);
                    if (SECOND) { float t[8]; unpack8(tg[m][bj], t);
#pragma unroll
                        for (int j = 0; j < 8; ++j) v[j] += t[j];
                        *(u32x4*)(Y + (size_t)(row0_ + ai * 128 + m * 16) * 1024 + cbase + bj * 128) = pack8(v); }
                    else *(u32x4*)(Z + (size_t)(row0_ + ai * 128 + m * 16) * ZW + ZC_MB + cbase + bj * 128) = pack8(v);
                }
        }
    }
};
template <int BF> struct EpiX1 {
    const float* xin; const bf16_t* xinb; bf16_t* Z; float* ssb;
    __device__ __forceinline__ void operator()(const Acc& acc, const pg8::Unit& u, int wr, int wc, int fr, int fq) const {
        EPI_ROWS(u, wr, fr)
        const int cbase = u.pn * 256 + wc * 32 + 8 * fq;
#pragma unroll
        for (int ai = 0; ai < 2; ++ai) {
            epi_fence();
            f32x4 xa[4][2][2]; u32x4 xh[4][2];
#pragma unroll
            for (int m = 0; m < 4; ++m)
#pragma unroll
                for (int bj = 0; bj < 2; ++bj) { const size_t o_ = (size_t)(row0_ + ai * 128 + m * 16) * D + cbase + bj * 128;
                    if (BF) xh[m][bj] = *(const u32x4*)(xinb + o_); else { xa[m][bj][0] = *(const f32x4*)(xin + o_); xa[m][bj][1] = *(const f32x4*)(xin + o_ + 4); } }
#pragma unroll
            for (int m = 0; m < 4; ++m) {
                const int row = row0_ + ai * 128 + m * 16;
                float st = 0.f;
#pragma unroll
                for (int bj = 0; bj < 2; ++bj) {
                    EPI_LOADV(v)
                    if (BF) { float xv[8]; unpack8(xh[m][bj], xv);
#pragma unroll
                        for (int j = 0; j < 8; ++j) v[j] += xv[j]; }
                    else { const f32x4 x0 = xa[m][bj][0], x1 = xa[m][bj][1];
                        v[0] += x0[0]; v[1] += x0[1]; v[2] += x0[2]; v[3] += x0[3]; v[4] += x1[0]; v[5] += x1[1]; v[6] += x1[2]; v[7] += x1[3]; }
#pragma unroll
                    for (int j = 0; j < 8; ++j) st += v[j] * v[j];
                    *(u32x4*)(Z + (size_t)row * ZW + ZC_X1B + cbase + bj * 128) = pack8(v);
                }
                st += __shfl_xor(st, 16); st += __shfl_xor(st, 32);
                if (fq == 0) ssb[(size_t)row * 16 + u.pn * 4 + wc] = st;
            }
        }
    }
};
struct EpiPP {
    bf16_t* Z;
    __device__ __forceinline__ void operator()(const Acc& acc, const pg8::Unit& u, int wr, int wc, int fr, int fq) const {
        EPI_ROWS(u, wr, fr)
        const int cbase = u.pn * 256 + wc * 32 + 8 * fq;
#pragma unroll
        for (int ai = 0; ai < 2; ++ai)
#pragma unroll
        for (int m = 0; m < 4; ++m) {
            const int row = row0_ + ai * 128 + m * 16;
#pragma unroll
            for (int bj = 0; bj < 2; ++bj) { EPI_LOADV(v) *(u32x4*)(Z + (size_t)row * ZW + ZC_T2 + cbase + bj * 128) = pack8(v); }
        }
    }
};
struct EpiX2 {
    float* xio; const bf16_t* Z; bf16_t* xb; const float* ssb; float* ssa; LAS unsigned char* lds; bool write_xb;
    __device__ __forceinline__ void operator()(const Acc& acc, const pg8::Unit& u, int wr, int wc, int fr, int fq) const {
        EPI_ROWS(u, wr, fr)
        fill_rtab<16>(lds, ssb, u.pm, 1.f / 1024.f, 1.f);
        const int cbase = u.pn * 256 + wc * 32 + 8 * fq;
#pragma unroll
        for (int ai = 0; ai < 2; ++ai)
#pragma unroll
        for (int mp = 0; mp < 2; ++mp) {
            epi_fence();
            u32x4 xa[2][2], tg[2][2];
#pragma unroll
            for (int mm = 0; mm < 2; ++mm)
#pragma unroll
                for (int bj = 0; bj < 2; ++bj) { const int row = row0_ + ai * 128 + (mp * 2 + mm) * 16; const bf16_t* zp = Z + (size_t)row * ZW + cbase + bj * 128;
                    xa[mm][bj] = *(const u32x4*)(zp + ZC_X1B); tg[mm][bj] = *(const u32x4*)(zp + ZC_T2); }
#pragma unroll
            for (int mm = 0; mm < 2; ++mm) {
                const int m = mp * 2 + mm;
                const int row = row0_ + ai * 128 + m * 16;
                const float rstd = RTAB(ai, m);
                float st = 0.f;
#pragma unroll
                for (int bj = 0; bj < 2; ++bj) {
                    EPI_LOADV(v)
                    const size_t off = (size_t)row * D + cbase + bj * 128;
                    float t[8]; unpack8(tg[mm][bj], t);
                    float xv[8]; unpack8(xa[mm][bj], xv);
#pragma unroll
                    for (int j = 0; j < 8; ++j) { v[j] = xv[j] + fsigmoid(v[j] * rstd) * t[j]; st += v[j] * v[j]; }
                    *(u32x4*)(xb + off) = pack8(v);
                }
                st += __shfl_xor(st, 16); st += __shfl_xor(st, 32);
                if (fq == 0) ssa[(size_t)row * 16 + u.pn * 4 + wc] = st;
            }
        }
    }
};


struct EpiX2F {
    float* out; const bf16_t* Z; const float* ssb; float* ssa; const float* gfin; unsigned* cnt; LAS unsigned char* lds;
    __device__ __forceinline__ void operator()(Acc& acc, const pg8::Unit& u, int wr, int wc, int fr, int fq) const {
        EPI_ROWS(u, wr, fr)
        fill_rtab<16>(lds, ssb, u.pm, 1.f / 1024.f, 1.f);
        const int cbase = u.pn * 256 + wc * 32 + 8 * fq;
#pragma unroll
        for (int ai = 0; ai < 2; ++ai)
#pragma unroll
        for (int mp = 0; mp < 2; ++mp) {
            epi_fence();
            u32x4 xa[2][2], tg[2][2];
#pragma unroll
            for (int mm = 0; mm < 2; ++mm)
#pragma unroll
                for (int bj = 0; bj < 2; ++bj) { const int row = row0_ + ai * 128 + (mp * 2 + mm) * 16; const bf16_t* zp = Z + (size_t)row * ZW + cbase + bj * 128;
                    xa[mm][bj] = *(const u32x4*)(zp + ZC_X1B); tg[mm][bj] = *(const u32x4*)(zp + ZC_T2); }
#pragma unroll
            for (int mm = 0; mm < 2; ++mm) {
                const int m = mp * 2 + mm;
                const int row = row0_ + ai * 128 + m * 16;
                const float rstd = RTAB(ai, m);
                float st = 0.f;
#pragma unroll
                for (int bj = 0; bj < 2; ++bj) {
                    EPI_LOADV(v)
                    float t[8]; unpack8(tg[mm][bj], t);
                    float xv[8]; unpack8(xa[mm][bj], xv);
#pragma unroll
                    for (int j = 0; j < 8; ++j) { v[j] = xv[j] + fsigmoid(v[j] * rstd) * t[j]; st += v[j] * v[j]; }
                    acc[ai][bj][m][0] = (f32x4){v[0], v[1], v[2], v[3]}; acc[ai][bj][m][1] = (f32x4){v[4], v[5], v[6], v[7]};
                }
                st += __shfl_xor(st, 16); st += __shfl_xor(st, 32);
                if (fq == 0) __hip_atomic_store(ssa + (size_t)row * 16 + u.pn * 4 + wc, st, __ATOMIC_RELAXED, __HIP_MEMORY_SCOPE_AGENT);
            }
        }
        asm volatile("s_waitcnt vmcnt(0)" ::: "memory"); __builtin_amdgcn_s_barrier(); asm volatile("" ::: "memory");
        int tid_ = threadIdx.x; asm volatile("" : "+v"(tid_));
        if (tid_ == 0) {
            __hip_atomic_fetch_add(cnt + u.pm, 1u, __ATOMIC_RELAXED, __HIP_MEMORY_SCOPE_AGENT);
            unsigned sp = 0; while (__hip_atomic_load(cnt + u.pm, __ATOMIC_RELAXED, __HIP_MEMORY_SCOPE_AGENT) < 4u && ++sp < (1u << 22)) __builtin_amdgcn_s_sleep(1);
            __builtin_amdgcn_fence(__ATOMIC_ACQUIRE, "agent"); asm volatile("s_waitcnt vmcnt(0)" ::: "memory");
        }
        asm volatile("s_waitcnt vmcnt(0) lgkmcnt(0)" ::: "memory"); __builtin_amdgcn_s_barrier(); asm volatile("" ::: "memory");
        if (tid_ < 256) { const float* sp_ = ssa + ((size_t)u.pm * 256 + tid_) * 16; float t = 0.f;
#pragma unroll
            for (int k = 0; k < 16; ++k) t += __hip_atomic_load(sp_ + k, __ATOMIC_RELAXED, __HIP_MEMORY_SCOPE_AGENT);
            ((LAS float*)(lds + RTAB_OFF))[tid_] = rsqrtf(t * (1.f / 1024.f) + EPS); }
        asm volatile("s_waitcnt lgkmcnt(0)" ::: "memory"); __builtin_amdgcn_s_barrier(); asm volatile("" ::: "memory");
        f32x4 gq[2][2];
#pragma unroll
        for (int bj = 0; bj < 2; ++bj) { gq[bj][0] = *(const f32x4*)(gfin + cbase + bj * 128); gq[bj][1] = *(const f32x4*)(gfin + cbase + bj * 128 + 4); }
#pragma unroll
        for (int ai = 0; ai < 2; ++ai)
#pragma unroll
        for (int m = 0; m < 4; ++m) {
            const int row = row0_ + ai * 128 + m * 16;
            const float r2 = RTAB(ai, m);
#pragma unroll
            for (int bj = 0; bj < 2; ++bj) { const size_t off = (size_t)row * D + cbase + bj * 128;
                *(f32x4*)(out + off) = acc[ai][bj][m][0] * r2 * gq[bj][0]; *(f32x4*)(out + off + 4) = acc[ai][bj][m][1] * r2 * gq[bj][1]; }
        }
    }
};

namespace att {
typedef short v4i16_t __attribute__((ext_vector_type(4)));
template <int MODE> struct Cfg { static constexpr int DQK = MODE == 0 ? 96 : 64, KROW = DQK + 8, KBUF = 64 * KROW * 2, VBUF = 8192, PBUF = 256, BUF = KBUF + VBUF + PBUF; };
#define MX3(a, b, c) __builtin_fmaxf(__builtin_fmaxf((a), (b)), (c))
__device__ __forceinline__ float rowmax32(const f32x16& p0, const f32x16& p1) {
    float a = MX3(p0[0], p0[1], p1[0]), b = MX3(p0[2], p0[3], p1[1]); a = MX3(a, p1[2], p1[3]);
#pragma unroll
    for (int r = 4; r < 16; r += 4) { a = MX3(a, p0[r], p0[r + 1]); b = MX3(b, p0[r + 2], p0[r + 3]); a = MX3(a, p1[r], p1[r + 1]); b = MX3(b, p1[r + 2], p1[r + 3]); }
    const float m = __builtin_fmaxf(a, b); auto rr = __builtin_amdgcn_permlane32_swap(__float_as_uint(m), __float_as_uint(m), false, false);
    return __builtin_fmaxf(__uint_as_float(rr[0]), __uint_as_float(rr[1])); }
__device__ __forceinline__ bf16x8 vfrag(const LAS unsigned char* p) {
    const v4i16_t lo = __builtin_amdgcn_ds_read_tr16_b64_v4i16((LAS v4i16_t*)p), hi = __builtin_amdgcn_ds_read_tr16_b64_v4i16((LAS v4i16_t*)(p + 512));
    return (bf16x8){lo[0], lo[1], lo[2], lo[3], hi[0], hi[1], hi[2], hi[3]}; }

template <int MODE>
__device__ __forceinline__ void attn_mode(LAS unsigned char* lds, const bf16_t* QB, const bf16_t* KVB, bf16_t* Z, const int* pos, const float* sink, int u_begin, int u_end, int u_step) {
    typedef Cfg<MODE> C;
    constexpr int DQK = C::DQK, KROW = C::KROW, NKS = DQK / 16;
    asm volatile("" : "+s"(u_begin));
    if (u_begin >= u_end) return;
    int tid_ = threadIdx.x; asm volatile("" : "+v"(tid_));
    const int tid = tid_, w = __builtin_amdgcn_readfirstlane(tid >> 6), lane = tid & 63, lq = lane & 31, hh = lane >> 5;
#define ATT_DECODE(u_, b_, hk_, qblk_) do { if (MODE == 0) { const int bh_ = (u_) & 255; qblk_ = 7 - ((u_) >> 8); b_ = bh_ >> 3; hk_ = bh_ & 7; } else { const int v_ = (u_) - 2048; b_ = v_ >> 6; hk_ = (v_ >> 5) & 1; qblk_ = v_ & 31; } } while (0)
#define ATT_GEOM(qblk_, hk_, wq0_, hq_, j0_) do { if (MODE == 0) { wq0_ = (qblk_) * 256 + 32 * w; hq_ = (hk_); j0_ = 0; } else { wq0_ = (qblk_) * 64 + 32 * (w >> 2); hq_ = (hk_) * 4 + (w & 3); j0_ = (qblk_) - 2; if (j0_ < 0) j0_ = 0; } } while (0)
#define ATT_QLOAD(tq_, hq_) do { _Pragma("unroll") for (int ks = 0; ks < NKS; ++ks) { \
        if (MODE == 0) qf[ks] = *(const bf16x8*)(QB + (tq_) * 768 + (hq_) * 96 + ks * 16 + hh * 8); \
        else qf[ks] = *(const bf16x8*)(Z + (tq_) * ZW + ZC_QA + (hq_) * 64 + ks * 16 + hh * 8); } } while (0)
    bf16x8 qf[NKS];
    u32x4 sk0, sk1, sv; int sp = 0;
    sk1 = (u32x4){0u, 0u, 0u, 0u};
    u32x4 nk0, nk1, nv; int np = 0;
    nk0 = nk1 = nv = (u32x4){0u, 0u, 0u, 0u};
    const int vkey = tid >> 3, vpart = tid & 7;
    const int vwr = (vpart >> 2) * 4096 + vkey * 64 + (vpart & 3) * 16;
    const int vrd = (4 * hh + ((lane & 15) >> 2)) * 64 + ((lane >> 4) & 1) * 32 + (lane & 3) * 8;
    const char *pk0 = nullptr, *pk1 = nullptr, *pvv = nullptr, *ppp = nullptr; unsigned inc0 = 0, inc1 = 0;
    int kst0, kst1;
    if (MODE == 0) { kst0 = ((tid / 12) * KROW + (tid % 12) * 8) * 2; kst1 = (((tid + 512) / 12) * KROW + ((tid + 512) % 12) * 8) * 2; }
    else { kst0 = (vkey * KROW + vpart * 8) * 2; kst1 = 0; }
#define ATT_SETUP(tok0, hk, j) do { const size_t kt = (tok0) + (size_t)(j) * 64; \
        if (MODE == 0) { { const int key = tid / 12, part = tid % 12; pk0 = (const char*)(part < 8 ? KVB + (kt + key) * 1024 + (hk) * 128 + part * 8 : Z + (kt + key) * ZW + ZC_KR + (part - 8) * 8); inc0 = part < 8 ? 64u * 1024u * 2u : 64u * ZW * 2u; } \
            { const int c2 = tid + 512, key = c2 / 12, part = c2 % 12; pk1 = (const char*)(part < 8 ? KVB + (kt + key) * 1024 + (hk) * 128 + part * 8 : Z + (kt + key) * ZW + ZC_KR + (part - 8) * 8); inc1 = part < 8 ? 64u * 1024u * 2u : 64u * ZW * 2u; } \
            pvv = (const char*)(KVB + (kt + vkey) * 1024 + (hk) * 128 + 64 + vpart * 8); } \
        else { pk0 = (const char*)(Z + (kt + vkey) * ZW + ZC_KA + (hk) * 64 + vpart * 8); pvv = (const char*)(Z + (kt + vkey) * ZW + ZC_VA + (hk) * 64 + vpart * 8); ppp = (const char*)(pos + kt + (tid & 63)); } } while (0)
#define ATT_LOADP(K0, K1, VV, PP) do { \
        if (MODE == 0) { K0 = *(const u32x4*)pk0; pk0 += inc0; if (tid < 256) { K1 = *(const u32x4*)pk1; pk1 += inc1; } VV = *(const u32x4*)pvv; pvv += 64 * 1024 * 2; } \
        else { K0 = *(const u32x4*)pk0; pk0 += 64 * ZW * 2; VV = *(const u32x4*)pvv; pvv += 64 * ZW * 2; if (tid < 64) PP = *(const int*)ppp; ppp += 256; } } while (0)
    { int b_, hk_, qblk_, wq0_, hq_, j0_; ATT_DECODE(u_begin, b_, hk_, qblk_); ATT_GEOM(qblk_, hk_, wq0_, hq_, j0_);
      const size_t tok0_ = (size_t)b_ * SEQ; ATT_QLOAD(tok0_ + wq0_ + lq, hq_); ATT_SETUP(tok0_, hk_, j0_); ATT_LOADP(sk0, sk1, sv, sp); }
    for (int u = u_begin; u < u_end; u += u_step) {
    int b, hk, qblk; ATT_DECODE(u, b, hk, qblk);
    const size_t tok0 = (size_t)b * SEQ;
    int wq0, hq, j0; ATT_GEOM(qblk, hk, wq0, hq, j0);
    const int q0 = MODE == 0 ? qblk * 256 : qblk * 64;
    const int qq = wq0 + lq;
    const size_t tq = tok0 + qq;
    const int j1 = MODE == 0 ? (q0 + 256) / 64 - 1 : q0 / 64;
    float slope_l2 = 0.f, pqf = 0.f, mrun, lrun;
    if (MODE == 1) { slope_l2 = exp2f(-(float)(hq + 1)) * LOG2E; pqf = (float)pos[tq]; mrun = sink[hq] * LOG2E; lrun = hh == 0 ? 1.f : 0.f; }
    else { mrun = 0.f; lrun = 0.f; }
    f32x16 O0, O1, negm;
#pragma unroll
    for (int i = 0; i < 16; ++i) { O0[i] = 0.f; O1[i] = 0.f; negm[i] = 0.f; }
    bool first = true;
    if (MODE == 1) {
#pragma unroll
        for (int i = 0; i < 16; ++i) negm[i] = -slope_l2 * pqf; }

#define ATT_STORE(bufi) do { LAS unsigned char* bb = lds + (bufi) * C::BUF; \
        *(LAS u32x4*)(bb + kst0) = sk0; \
        if (MODE == 0) { if (tid < 256) *(LAS u32x4*)(bb + kst1) = sk1; } \
        else { if (tid < 64) ((LAS float*)(bb + C::KBUF + C::VBUF))[tid] = (float)sp; } \
        *(LAS u32x4*)(bb + C::KBUF + vwr) = sv; } while (0)
#define ATT_BAR() do { asm volatile("s_waitcnt lgkmcnt(0)" ::: "memory"); __builtin_amdgcn_s_barrier(); asm volatile("" ::: "memory"); } while (0)

    ATT_STORE(0);
    ATT_BAR();
    if (j0 < j1) ATT_LOADP(sk0, sk1, sv, sp);
    for (int j = j0; j <= j1; ++j) {
        const int bufi = (j - j0) & 1;
        if (j + 2 <= j1) ATT_LOADP(nk0, nk1, nv, np);
        const int k0 = j * 64;
        const bool active = (MODE == 1) || (k0 <= wq0 + 31);
        if (active) {
            const LAS unsigned char* bb = lds + bufi * C::BUF; const LAS bf16_t* Kb = (const LAS bf16_t*)bb; const LAS unsigned char* Vb = bb + C::KBUF + vrd;
            f32x16 S0, S1;
            S0 = negm; S1 = negm;
            bf16x8 kf[2 * NKS];
#pragma unroll
            for (int ks = 0; ks < NKS; ++ks) {
                kf[2 * ks] = *(const LAS bf16x8*)(Kb + lq * KROW + ks * 16 + hh * 8);
                kf[2 * ks + 1] = *(const LAS bf16x8*)(Kb + (32 + lq) * KROW + ks * 16 + hh * 8);
            }
            __builtin_amdgcn_sched_barrier(0);
#pragma unroll
            for (int ks = 0; ks < NKS; ++ks) {
                S0 = __builtin_amdgcn_mfma_f32_32x32x16_bf16(kf[2 * ks], qf[ks], S0, 0, 0, 0);
                S1 = __builtin_amdgcn_mfma_f32_32x32x16_bf16(kf[2 * ks + 1], qf[ks], S1, 0, 0, 0);
            }
            if (MODE == 1) {
                const LAS float* pk = (const LAS float*)(bb + C::KBUF + C::VBUF) + 4 * hh;
                const bool allv = (k0 + 63 <= wq0) && (wq0 + 31 - k0 < 128);
                const int d0 = qq - k0 - 4 * hh;
                if (allv) {
#pragma unroll
                    for (int i4 = 0; i4 < 4; ++i4) {
                        const f32x4 pa = *(const LAS f32x4*)(pk + 8 * i4), pb = *(const LAS f32x4*)(pk + 32 + 8 * i4);
#pragma unroll
                        for (int ii = 0; ii < 4; ++ii) { S0[4 * i4 + ii] = __builtin_fmaf(slope_l2, pa[ii], S0[4 * i4 + ii]); S1[4 * i4 + ii] = __builtin_fmaf(slope_l2, pb[ii], S1[4 * i4 + ii]); }
                    }
                } else {
#pragma unroll
                    for (int i4 = 0; i4 < 4; ++i4) {
                        const f32x4 pa = *(const LAS f32x4*)(pk + 8 * i4), pb = *(const LAS f32x4*)(pk + 32 + 8 * i4);
#pragma unroll
                        for (int ii = 0; ii < 4; ++ii) {
                            const float sa = __builtin_fmaf(slope_l2, pa[ii], S0[4 * i4 + ii]), sb = __builtin_fmaf(slope_l2, pb[ii], S1[4 * i4 + ii]);
                            S0[4 * i4 + ii] = ((unsigned)(d0 - (8 * i4 + ii)) < 128u) ? sa : -1e30f; S1[4 * i4 + ii] = ((unsigned)(d0 - (32 + 8 * i4 + ii)) < 128u) ? sb : -1e30f;
                        }
                    }
                }
            } else if (k0 + 63 > wq0) {
#pragma unroll
                for (int i = 0; i < 16; ++i) {
                    const int ka_i = k0 + 8 * (i >> 2) + 4 * hh + (i & 3);
                    if (ka_i > qq) S0[i] = -1e30f;
                    if (ka_i + 32 > qq) S1[i] = -1e30f;
                }
            }
            const float mx = rowmax32(S0, S1);
            if (MODE == 0) {
                if (first || __builtin_amdgcn_ballot_w64(mx > 8.f) != 0ull) {
                    const float delta = first ? mx : fmaxf(mx, 0.f);
                    const float alpha = first ? 1.f : __builtin_amdgcn_exp2f(-delta);
                    mrun += delta; lrun *= alpha;
#pragma unroll
                    for (int i = 0; i < 16; ++i) { S0[i] -= delta; S1[i] -= delta; O0[i] *= alpha; O1[i] *= alpha; negm[i] = -mrun; }
                    first = false;
                }
            } else {
                const float mnew = fmaxf(mrun, mx);
                const float alpha = __builtin_amdgcn_exp2f(mrun - mnew);
                mrun = mnew; lrun *= alpha;
#pragma unroll
                for (int i = 0; i < 16; ++i) { S0[i] -= mnew; S1[i] -= mnew; O0[i] *= alpha; O1[i] *= alpha; }
            }
            bf16x8 va0[4], va1[4];
#pragma unroll
            for (int t4 = 0; t4 < 4; ++t4) { va0[t4] = vfrag(Vb + t4 * 1024); va1[t4] = vfrag(Vb + 4096 + t4 * 1024); }
            float ps = 0.f;
#pragma unroll
            for (int g = 0; g < 4; ++g) {
                float e[8];
#pragma unroll
                for (int i = 0; i < 8; ++i) { e[i] = __builtin_amdgcn_exp2f(g < 2 ? S0[8 * (g & 1) + i] : S1[8 * (g & 1) + i]); }
                ps += ((e[0] + e[1]) + (e[2] + e[3])) + ((e[4] + e[5]) + (e[6] + e[7]));
                u32x4 a; a.x = cvt_pk_bf16(e[0], e[1]); a.y = cvt_pk_bf16(e[2], e[3]); a.z = cvt_pk_bf16(e[4], e[5]); a.w = cvt_pk_bf16(e[6], e[7]);
                const bf16x8 pfg = __builtin_bit_cast(bf16x8, a);
                O0 = __builtin_amdgcn_mfma_f32_32x32x16_bf16(va0[g], pfg, O0, 0, 0, 0);
                O1 = __builtin_amdgcn_mfma_f32_32x32x16_bf16(va1[g], pfg, O1, 0, 0, 0);
                __builtin_amdgcn_sched_barrier(0);
            }
            lrun += ps;
        }
        if (j < j1) ATT_STORE(bufi ^ 1);
        sk0 = nk0; sk1 = nk1; sv = nv; sp = np;
        ATT_BAR();
    }
    const float ltot = lrun + __shfl_xor(lrun, 32);
    const float inv = 1.f / ltot;
    if (u + u_step < u_end) {
        int b_, hk_, qblk_, wq0_, hq_, j0_; ATT_DECODE(u + u_step, b_, hk_, qblk_); ATT_GEOM(qblk_, hk_, wq0_, hq_, j0_);
        const size_t tok0_ = (size_t)b_ * SEQ; ATT_QLOAD(tok0_ + wq0_ + lq, hq_); ATT_SETUP(tok0_, hk_, j0_); ATT_LOADP(sk0, sk1, sv, sp); }
    LAS unsigned char* ost = lds + 65536 + w * 4608;
#pragma unroll
    for (int i4 = 0; i4 < 4; ++i4) {
        const int dv0 = 8 * i4 + 4 * hh;
        u32x2 o;
        o.x = cvt_pk_bf16(O0[4 * i4 + 0] * inv, O0[4 * i4 + 1] * inv); o.y = cvt_pk_bf16(O0[4 * i4 + 2] * inv, O0[4 * i4 + 3] * inv);
        *(LAS u32x2*)(ost + lq * 144 + dv0 * 2) = o;
        o.x = cvt_pk_bf16(O1[4 * i4 + 0] * inv, O1[4 * i4 + 1] * inv); o.y = cvt_pk_bf16(O1[4 * i4 + 2] * inv, O1[4 * i4 + 3] * inv);
        *(LAS u32x2*)(ost + lq * 144 + 64 + dv0 * 2) = o;
    }
    asm volatile("s_waitcnt lgkmcnt(0)" ::: "memory");
    {
        const int chunk = lane & 7;
        bf16_t* obase = Z + (tok0 + wq0) * ZW + (MODE == 0 ? ZC_GB : ZC_GA) + hq * 64 + chunk * 8;
        u32x4 gv[4], ov[4];
#pragma unroll
        for (int k = 0; k < 4; ++k) { const int row = (lane >> 3) + 8 * k; gv[k] = *(const u32x4*)(obase + (size_t)row * ZW); ov[k] = *(const LAS u32x4*)(ost + row * 144 + chunk * 16); }
#pragma unroll
        for (int k = 0; k < 4; ++k) { const int row = (lane >> 3) + 8 * k; float a[8], g[8]; unpack8(ov[k], a); unpack8(gv[k], g);
#pragma unroll
            for (int e = 0; e < 8; ++e) a[e] *= g[e];
            *(u32x4*)(obase + (size_t)row * ZW) = pack8(a); }
    }
    }
#undef ATT_SETUP
#undef ATT_LOADP
#undef ATT_STORE
#undef ATT_BAR
#undef ATT_DECODE
#undef ATT_GEOM
#undef ATT_QLOAD
}
#undef MX3
}

#define XB_TMO      128
#define XB_XCNT(j)  (256  + 64 * (j))
#define XB_XSUB(j)  (1280 + 64 * (j))
#define XB_XGEN(j)  (2304 + 64 * (j))
#define XB_TOP      3328
#define XB_TOPGEN   3392
#define XCD_BAR_WORDS 3456
#define XB_SPIN_CAP (1u << 18)

__device__ __forceinline__ unsigned xb_ld(unsigned* p)              { return __hip_atomic_load(p, __ATOMIC_RELAXED, __HIP_MEMORY_SCOPE_AGENT); }
__device__ __forceinline__ unsigned xb_add(unsigned* p, unsigned v) { return __hip_atomic_fetch_add(p, v, __ATOMIC_RELAXED, __HIP_MEMORY_SCOPE_AGENT); }
__device__ __forceinline__ unsigned xb_xcc_id() { return (unsigned)__builtin_amdgcn_s_getreg((3 << 11) | 20) & 0xFu; }
#define XB_SPIN(cond, bar) do { unsigned _sp = 0; while (cond) { __builtin_amdgcn_s_sleep(1); \
    if ((++_sp & 255u) == 0u) { if (xb_ld(&(bar)[XB_TMO])) break; if (_sp > XB_SPIN_CAP) { atomicAdd(&(bar)[XB_TMO], 1u); break; } } } } while (0)

struct XcdBarrier {
    unsigned* bar; unsigned x;
    volatile LAS unsigned* st;
};

__device__ __forceinline__ XcdBarrier xcd_barrier_post(unsigned* bar, volatile LAS unsigned* st) {
    XcdBarrier b; b.bar = bar; b.x = xb_xcc_id(); b.st = st;
    if (threadIdx.x == 0) (void)xb_add(&bar[XB_XCNT(b.x)], 1u);
    return b;
}
__device__ __forceinline__ void xcd_barrier_complete(unsigned* bar, unsigned x, unsigned& nloc, unsigned& nx) {
    const unsigned G = gridDim.x * gridDim.y * gridDim.z;
    unsigned sum, cnt, mine, sp = 0u;
    for (;;) {
        sum = 0u; cnt = 0u; mine = 0u;
#pragma unroll
        for (unsigned j = 0; j < 16; ++j) { const unsigned c = xb_ld(&bar[XB_XCNT(j)]); sum += c; cnt += (c > 0u) ? 1u : 0u; mine = (j == x) ? c : mine; }
        if (sum == G) break;
        __builtin_amdgcn_s_sleep(1);
        if ((++sp & 255u) == 0u) { if (xb_ld(&bar[XB_TMO])) break; if (sp > XB_SPIN_CAP) { atomicAdd(&bar[XB_TMO], 1u); break; } }
    }
    nloc = mine > 0u ? mine : 1u; nx = cnt > 0u ? cnt : 1u;
}

__device__ __forceinline__ void xcd_barrier(const XcdBarrier& b) {
    asm volatile("s_waitcnt vmcnt(0)" ::: "memory");
    __syncthreads();
    if (threadIdx.x == 0) {
        unsigned* bar = b.bar;
        __builtin_amdgcn_s_waitcnt(0);
        unsigned nloc = b.st[0], nx = b.st[1];
        if (nloc == 0u) { xcd_barrier_complete(bar, b.x, nloc, nx); b.st[0] = nloc; b.st[1] = nx; }
        const unsigned old = xb_add(&bar[XB_XSUB(b.x)], 1u);
        const unsigned gen = old / nloc;
        if (old + 1u == (gen + 1u) * nloc) {
            __builtin_amdgcn_fence(__ATOMIC_RELEASE, "agent");
            asm volatile("s_waitcnt vmcnt(0)" ::: "memory");
            const unsigned og = xb_add(&bar[XB_TOP], 1u);
            const unsigned tg = og / nx;
            if (og + 1u == (tg + 1u) * nx) xb_add(&bar[XB_TOPGEN], 1u);
            else XB_SPIN(xb_ld(&bar[XB_TOPGEN]) == tg, bar);
            __builtin_amdgcn_fence(__ATOMIC_ACQUIRE, "agent");
            xb_add(&bar[XB_XGEN(b.x)], 1u);
            asm volatile("s_waitcnt vmcnt(0)" ::: "memory");
        } else {
            XB_SPIN(xb_ld(&bar[XB_XGEN(b.x)]) == gen, bar);
            __builtin_amdgcn_fence(__ATOMIC_ACQUIRE, "agent");
            asm volatile("s_waitcnt vmcnt(0)" ::: "memory");
        }
    }
    __syncthreads();
}


__device__ __forceinline__ int colmap(int type, int n) {
    if (type == 1) {
        if (n < 1664) return n;
        if (n < 1696) { const int j = n - 1664; return 1664 + (j >> 1) + 16 * (j & 1); }
        if (n < 1792) return -1;
        return n - 96;
    }
    if (type == 2) {
        const int h = n / 96, c = n % 96; if (c < 64) return n; const int j = c - 64; return h * 96 + 64 + (j >> 1) + 16 * (j & 1);
    }
    return n;
}
__device__ __forceinline__ void wprep(const float* W, int K, int Nsrc, const float* g, bf16_t* dst, int Ndst, int type, size_t gtid, size_t gthreads) {
    const size_t total = (size_t)Ndst * (K / 8);
    for (size_t idx = gtid; idx < total; idx += gthreads) {
        const int n = (int)(idx % Ndst), kc = (int)(idx / Ndst);
        const int src = colmap(type, n);
        float v[8];
#pragma unroll
        for (int j = 0; j < 8; ++j) { const int k = kc * 8 + j; v[j] = src < 0 ? 0.f : W[(size_t)k * Nsrc + src] * (g ? g[k] : 1.f); }
        *(u32x4*)(dst + (size_t)n * K + kc * 8) = pack8(v);
    }
}

__device__ __forceinline__ void wprep_item(const float* W, int K, int Nsrc, const float* g, bf16_t* dst, int Ndst, int type, LAS float* scr, int item, int lane) {
    const int nblk = Ndst / 32, kb = item / nblk, nb = item % nblk, k0 = 64 * kb, n0 = 32 * nb;
    const int src = colmap(type, n0 + (lane & 31));
#pragma unroll 8
    for (int i = 0; i < 32; ++i) { const int kk = 2 * i + (lane >> 5); scr[kk * 33 + (lane & 31)] = src < 0 ? 0.f : W[(size_t)(k0 + kk) * Nsrc + src] * (g ? g[k0 + kk] : 1.f); }
    asm volatile("s_waitcnt lgkmcnt(0)" ::: "memory");
    const int c = lane & 7;
#pragma unroll
    for (int j = 0; j < 4; ++j) { const int n = (lane >> 3) + 8 * j; const LAS float* sp = scr + (8 * c) * 33 + n;
        u32x4 o; o.x = cvt_pk_bf16(sp[0 * 33], sp[1 * 33]); o.y = cvt_pk_bf16(sp[2 * 33], sp[3 * 33]); o.z = cvt_pk_bf16(sp[4 * 33], sp[5 * 33]); o.w = cvt_pk_bf16(sp[6 * 33], sp[7 * 33]);
        *(u32x4*)(dst + (size_t)(n0 + n) * K + k0 + 8 * c) = o; }
    asm volatile("s_waitcnt lgkmcnt(0)" ::: "memory");
}
constexpr int LDS_BYTES = 131072 + 1024 + 64;
constexpr int BARST_OFF = 131072 + 1024;
constexpr size_t WS_BAR = WS_W + 31 * MiB + 768 * 1024;
constexpr int STAG_P1 = 0, STAG_P4 = 0, STAG_P5 = 0, STAG_P6 = 0;
constexpr int N_PHASES = 1 + 6 * DEPTH + 1;

__global__ void __launch_bounds__(512, 2) fwd_megakernel(Params P) {
    extern __shared__ __attribute__((aligned(16))) unsigned char lds_raw[];
    LAS unsigned char* lds = (LAS unsigned char*)lds_raw;
    cg::grid_group grid = cg::this_grid();
    const int G = gridDim.x, bid = blockIdx.x;
    if (threadIdx.x < 2) ((LAS unsigned*)(lds + BARST_OFF))[threadIdx.x] = 0u;
    __syncthreads();
    XcdBarrier xbar; xbar.bar = (unsigned*)(P.ws + WS_BAR); xbar.x = 0; xbar.st = (volatile LAS unsigned*)(lds + BARST_OFF);
    unsigned char* ws = P.ws;
    bf16_t* Wb = (bf16_t*)(ws + WS_W);
    float* SSXA = (float*)(ws + WS_SSXA); float* SSXB = (float*)(ws + WS_SSXB); float* SSQ = (float*)(ws + WS_SSQ); float* SSKV = (float*)(ws + WS_SSKV);
    bf16_t* PB = (bf16_t*)(ws + WS_PB); bf16_t* XB = (bf16_t*)(ws + WS_XB); bf16_t* QB = (bf16_t*)(ws + WS_QB); bf16_t* KVB = (bf16_t*)(ws + WS_KVB); bf16_t* Z = (bf16_t*)(ws + WS_Z);
    const int lo = P.ph_lo, hi = P.ph_hi;
    int ph = 0;
    if (bid == 0) { unsigned* bw = (unsigned*)(P.ws + WS_BAR); for (int i = threadIdx.x; i < 4096 + 256; i += 512) bw[i] = 0u; }
#define PHASE_BEGIN if (ph >= lo && ph < hi) {
#if PROBE_SET
    unsigned long long* TS = (unsigned long long*)(ws + WS_W + 31 * MiB + 512 * 1024);
    if (bid == 0 && threadIdx.x == 0) TS[15] = __builtin_amdgcn_s_memrealtime();
#define PHASE_END   if (ph == 12 && bid == 0 && threadIdx.x == 0) TS[ph] = __builtin_amdgcn_s_memrealtime(); if (ph + 1 < hi) { if (ph == lo) { grid.sync(); xbar = xcd_barrier_post((unsigned*)(P.ws + WS_BAR), (volatile LAS unsigned*)(lds + BARST_OFF)); } else xcd_barrier(xbar); } if (ph < 12 && bid == 0 && threadIdx.x == 0) TS[ph] = __builtin_amdgcn_s_memrealtime(); } ++ph;
#else
#define PHASE_END   if (ph + 1 < hi && !(ph + 2 == N_PHASES && G == 256)) { if (ph == lo) { grid.sync(); xbar = xcd_barrier_post((unsigned*)(P.ws + WS_BAR), (volatile LAS unsigned*)(lds + BARST_OFF)); } else xcd_barrier(xbar); } } ++ph;
#endif

    PHASE_BEGIN
#if (PHMASK >> 0) & 1
    {
        int tid_ = threadIdx.x; asm volatile("" : "+v"(tid_)); const int tid = tid_, lane = tid & 63, wave = tid >> 6;
        const size_t gtid = (size_t)bid * 512 + tid, gthreads = (size_t)G * 512;
        {
            LAS float* scr = (LAS float*)(lds + wave * 16384);
            const int gwv = bid * 8 + wave, ngw = G * 8;
            constexpr int I_IN = 16 * 136, I_UQ = 4 * 24, I_UKV = 2 * 32, I_A = 8 * 32, I_OUT = 16 * 32, I_PP = 4 * 32, I_L = I_IN + I_UQ + I_UKV + 2 * I_A + 2 * I_OUT + I_PP;
            for (int it = gwv; it < DEPTH * I_L; it += ngw) {
                const int L = it / I_L; int r = it % I_L;
                bf16_t* wl = Wb + (size_t)L * WO_END;
                if (r < I_IN) { wprep_item(P.w_in + (size_t)L * 1024 * IN_WIDTH, 1024, IN_WIDTH, P.g_mix + L * 1024, wl + WO_IN, ZW, 1, scr, r, lane); continue; } r -= I_IN;
                if (r < I_UQ) { wprep_item(P.w_uq + (size_t)L * 256 * 768, 256, 768, P.g_q + L * 256, wl + WO_UQ, 768, 2, scr, r, lane); continue; } r -= I_UQ;
                if (r < I_UKV) { wprep_item(P.w_ukv + (size_t)L * 128 * 1024, 128, 1024, P.g_kv + L * 128, wl + WO_UKV, 1024, 0, scr, r, lane); continue; } r -= I_UKV;
                if (r < I_A) { wprep_item(P.w_br_a + (size_t)L * 512 * 1024, 512, 1024, nullptr, wl + WO_A, 1024, 0, scr, r, lane); continue; } r -= I_A;
                if (r < I_A) { wprep_item(P.w_br_b + (size_t)L * 512 * 1024, 512, 1024, nullptr, wl + WO_B, 1024, 0, scr, r, lane); continue; } r -= I_A;
                if (r < I_OUT) { wprep_item(P.w_out + (size_t)L * 1024 * 1024, 1024, 1024, nullptr, wl + WO_OUT, 1024, 0, scr, r, lane); continue; } r -= I_OUT;
                if (r < I_OUT) { wprep_item(P.w_ple_gate + (size_t)L * 1024 * 1024, 1024, 1024, P.g_ple + L * 1024, wl + WO_PG, 1024, 0, scr, r, lane); continue; } r -= I_OUT;
                wprep_item(P.w_ple_proj + (size_t)L * 256 * 1024, 256, 1024, nullptr, wl + WO_PP, 1024, 0, scr, r, lane);
            }
        }
        const int gw = bid * 8 + wave, NGW = G * 8;
        for (int r = gw; r < T; r += NGW) {
            const f32x4* xr = (const f32x4*)(P.x + (size_t)r * D) + lane;
            float s = 0.f;
#pragma unroll
            for (int j = 0; j < 4; ++j) { const f32x4 v = xr[64 * j]; s += (v.x * v.x + v.y * v.y) + (v.z * v.z + v.w * v.w);
                u32x2 o; o.x = cvt_pk_bf16(v.x, v.y); o.y = cvt_pk_bf16(v.z, v.w); *((u32x2*)(XB + (size_t)r * D) + lane + 64 * j) = o; }
#pragma unroll
            for (int o = 1; o < 64; o <<= 1) s += __shfl_xor(s, o);
            if (lane < 16) SSXA[(size_t)r * 16 + lane] = lane == 0 ? s : 0.f;
        }
        const size_t np8 = (size_t)DEPTH * T * PLE / 8;
        for (size_t i = gtid; i < np8; i += gthreads) { const f32x4 a = *(const f32x4*)(P.p + i * 8), c = *(const f32x4*)(P.p + i * 8 + 4);
            u32x4 o; o.x = cvt_pk_bf16(a.x, a.y); o.y = cvt_pk_bf16(a.z, a.w); o.z = cvt_pk_bf16(c.x, c.y); o.w = cvt_pk_bf16(c.z, c.w); *(u32x4*)(PB + i * 8) = o; }
    }
#endif
    PHASE_END

#pragma unroll 1
    for (int L = 0; L < DEPTH; ++L) {
        const bf16_t* wl = Wb + (size_t)L * WO_END;
        PHASE_BEGIN
#if (PHMASK >> 1) & 1
        { pg8::Gemm g{XB, wl + WO_IN, T, ZW, 1024, 1024}; pg8::StaticOrder S; S.init(T, ZW, G, bid);
          EpiZ E{Z, SSXA, SSQ, SSKV, P.pos, lds}; pg8::gemm_phase(lds, g, S, E, STAG_P1); }
    #endif
    PHASE_END
        PHASE_BEGIN
#if (PHMASK >> 2) & 1
        { pg8::Gemm g{Z + ZC_BQD, wl + WO_UQ, T, 768, 256, ZW}; pg8::StaticOrder S; S.init(T, 768, G, bid);
          EpiQB E{QB, SSQ, P.pos, lds}; pg8::gemm_phase(lds, g, S, E); }
        { pg8::Gemm g{Z + ZC_BKVD, wl + WO_UKV, T, 1024, 128, ZW}; pg8::StaticOrder S; S.init(T, 1024, G, bid);
          EpiKVB E{KVB, SSKV, lds}; pg8::gemm_phase(lds, g, S, E); }
    #endif
    PHASE_END
        PHASE_BEGIN
#if (PHMASK >> 3) & 1
        {
            __syncthreads();
            att::attn_mode<0>(lds, QB, KVB, Z, P.pos, nullptr, bid, 2048, G);
            { const int u1 = bid + ((2048 - bid + G - 1) / G) * G; att::attn_mode<1>(lds, QB, KVB, Z, P.pos, P.sink + L * 8, u1, 4096, G); }
        }
    #endif
    PHASE_END
        PHASE_BEGIN
#if (PHMASK >> 4) & 1
        { pg8::Gemm g{Z + ZC_GA, wl + WO_A, T, 1024, 512, ZW}; pg8::Gemm g2{Z + ZC_GB, wl + WO_B, T, 1024, 512, ZW}; pg8::StaticOrder S; S.init(T, 1024, G, bid);
          EpiMerge<0> E{Z, KVB}; EpiMerge<1> E2{Z, KVB}; pg8::gemm_phase_pair(lds, g, g2, S, E, E2); }
    #endif
    PHASE_END
        PHASE_BEGIN
#if (PHMASK >> 5) & 1
        { pg8::Gemm g{KVB, wl + WO_OUT, T, 1024, 1024, 1024}; pg8::StaticOrder S; S.init(T, 1024, G, bid);
          EpiX1<1> E{P.x, XB, Z, SSXB}; pg8::gemm_phase(lds, g, S, E, STAG_P5); }
        { pg8::Gemm g{PB + (size_t)L * T * PLE, wl + WO_PP, T, 1024, 256, 256}; pg8::StaticOrder S; S.init(T, 1024, G, bid);
          EpiPP E{Z}; pg8::gemm_phase(lds, g, S, E); }
    #endif
    PHASE_END
        PHASE_BEGIN
#if (PHMASK >> 6) & 1
        { pg8::Gemm g{Z + ZC_X1B, wl + WO_PG, T, 1024, 1024, ZW}; pg8::StaticOrder S; S.init(T, 1024, G, bid);
          if (L + 1 == DEPTH && G == 256) { EpiX2F E{P.out, Z, SSXB, SSXA, P.g_final, (unsigned*)(P.ws + WS_BAR) + 4096, lds}; pg8::gemm_phase(lds, g, S, E, STAG_P6); }
          else { EpiX2 E{P.out, Z, XB, SSXB, SSXA, lds, L + 1 < DEPTH}; pg8::gemm_phase(lds, g, S, E, STAG_P6); } }
    #endif
    PHASE_END
    }
    PHASE_BEGIN
#if (PHMASK >> 7) & 1
    {
        int tid_ = threadIdx.x; asm volatile("" : "+v"(tid_)); const int tid = tid_, lane = tid & 63, wave = tid >> 6;
        const int gw = G == 256 ? T : bid * 8 + wave, NGW = G * 8;
#if PROBE_SET
        int krows = 0;
        { unsigned long long prev = TS[15], sel = 0; const unsigned long long t0 = prev;
          for (int k = 0; k <= 12; ++k) { const unsigned long long tk = TS[k]; if ((PROBE_SET >> k) & 1) sel += tk - prev; prev = tk; }
          krows = (int)((float)sel / (float)(prev - t0) * 4096.f + 0.5f); }
#endif
        for (int r = gw; r < T; r += NGW) {
            const float rstd = rsqrtf(sum16(SSXA + (size_t)r * 16) * (1.f / 1024.f) + EPS);
            f32x4* xr = (f32x4*)(P.out + (size_t)r * D) + lane; const f32x4* gr = (const f32x4*)P.g_final + lane; const u32x2* xbr = (const u32x2*)(XB + (size_t)r * D) + lane;
#pragma unroll
            for (int j = 0; j < 4; ++j) { const u32x2 xw = xbr[64 * j]; f32x4 v = (f32x4){bflo(xw.x), bfhi(xw.x), bflo(xw.y), bfhi(xw.y)}; const f32x4 gg = gr[64 * j]; v.x *= rstd * gg.x; v.y *= rstd * gg.y; v.z *= rstd * gg.z; v.w *= rstd * gg.w;
#if PROBE_SET
                if (r < krows) { v.x += 0.015f; v.y += 0.015f; v.z += 0.015f; v.w += 0.015f; }
#endif
                xr[64 * j] = v; }
        }
    }
#endif
    PHASE_END
#undef PHASE_BEGIN
#undef PHASE_END
}

extern "C" void kernel_launch(void* const* d_in, const int* in_sizes, int n_in, void* d_out, int out_size, void* d_ws, size_t ws_size, hipStream_t stream) {
    static int grid = 0;
    if (grid == 0) {
        if (n_in != 17 || in_sizes[0] != T * D || out_size != T * D || ws_size < WS_END) {
            fprintf(stderr, "kernel_launch: unexpected shapes/workspace: n_in %d in0 %d out %d ws %zu (need %zu)\n", n_in, n_in > 0 ? in_sizes[0] : -1, out_size, ws_size, (size_t)WS_END); grid = -1; return; }
        int dev = 0, cus = 0, per_cu = 0;
        hipGetDevice(&dev); hipDeviceGetAttribute(&cus, hipDeviceAttributeMultiprocessorCount, dev);
        if (hipFuncSetAttribute((const void*)fwd_megakernel, hipFuncAttributeMaxDynamicSharedMemorySize, LDS_BYTES) != hipSuccess) { fprintf(stderr, "kernel_launch: hipFuncSetAttribute failed\n"); grid = -1; return; }
        if (hipOccupancyMaxActiveBlocksPerMultiprocessor(&per_cu, (const void*)fwd_megakernel, 512, LDS_BYTES) != hipSuccess || per_cu < 1) { fprintf(stderr, "kernel_launch: occupancy query gave %d\n", per_cu); per_cu = 1; }
        (void)hipGetLastError();
        grid = cus * 1;
        fprintf(stderr, "kernel_launch: grid %d (cus %d, per_cu %d)\n", grid, cus, per_cu);
    }
    if (grid < 0) return;
    Params p{};
    p.x = (const float*)d_in[0]; p.p = (const float*)d_in[1]; p.pos = (const int*)d_in[2];
    p.g_mix = (const float*)d_in[3]; p.w_in = (const float*)d_in[4]; p.sink = (const float*)d_in[5]; p.g_q = (const float*)d_in[6]; p.w_uq = (const float*)d_in[7];
    p.g_kv = (const float*)d_in[8]; p.w_ukv = (const float*)d_in[9]; p.w_br_a = (const float*)d_in[10]; p.w_br_b = (const float*)d_in[11]; p.w_out = (const float*)d_in[12];
    p.g_ple = (const float*)d_in[13]; p.w_ple_gate = (const float*)d_in[14]; p.w_ple_proj = (const float*)d_in[15]; p.g_final = (const float*)d_in[16];
    p.out = (float*)d_out; p.ws = (unsigned char*)d_ws;
#if ONE_LAUNCH
    p.ph_lo = 0; p.ph_hi = N_PHASES;
    { void* args[] = {&p}; hipError_t e = hipLaunchCooperativeKernel((const void*)fwd_megakernel, dim3(grid), dim3(512), args, LDS_BYTES, stream);
      if (e != hipSuccess) fprintf(stderr, "cooperative launch failed: %s (grid %d)\n", hipGetErrorString(e), grid); }
#else
    for (int ph = 0; ph < N_PHASES; ++ph) {
        p.ph_lo = ph; p.ph_hi = ph + 1;
        void* args[] = {&p}; hipError_t e = hipLaunchCooperativeKernel((const void*)fwd_megakernel, dim3(grid), dim3(512), args, LDS_BYTES, stream);
        if (e != hipSuccess) { fprintf(stderr, "cooperative launch %d failed: %s (grid %d)\n", ph, hipGetErrorString(e), grid); break; }
    }
#endif
}
```

```cpp
#include <hip/hip_runtime.h>
#include <hip/hip_cooperative_groups.h>
#include <cstdio>
#include <cstdint>
namespace cg = cooperative_groups;

#ifndef PHMASK
#define PHMASK 255
#endif
#ifndef PROBE_SET
#define PROBE_SET 0
#endif
#ifndef ONE_LAUNCH
#define ONE_LAUNCH 1
#endif

#define LAS __attribute__((address_space(3)))
typedef unsigned short bf16_t;
typedef short bf16x8 __attribute__((ext_vector_type(8)));
typedef float f32x4 __attribute__((ext_vector_type(4)));
typedef float f32x16 __attribute__((ext_vector_type(16)));
typedef unsigned u32x4 __attribute__((ext_vector_type(4)));
typedef unsigned u32x2 __attribute__((ext_vector_type(2)));

constexpr int BATCH = 32, SEQ = 2048, T = BATCH * SEQ, D = 1024, DEPTH = 2, PLE = 256;
constexpr int ZW = 4352;
constexpr int ZC_QA = 0, ZC_KA = 512, ZC_VA = 640, ZC_GA = 768, ZC_BQD = 1280, ZC_BKVD = 1536, ZC_KR = 1664, ZC_GB = 1792, ZC_MA = 2304, ZC_MB = 3328;
constexpr int ZC_X1B = ZC_MA, ZC_T2 = 0;
constexpr int IN_WIDTH = 4256;
constexpr float EPS = 1e-6f;
constexpr float LOG2E = 1.4426950408889634f;

constexpr size_t WO_IN = 0, WO_UQ = WO_IN + (size_t)ZW * 1024, WO_UKV = WO_UQ + 768 * 256, WO_A = WO_UKV + 1024 * 128, WO_B = WO_A + 1024 * 512,
                 WO_OUT = WO_B + 1024 * 512, WO_PG = WO_OUT + 1024 * 1024, WO_PP = WO_PG + 1024 * 1024, WO_END = WO_PP + 1024 * 256;
constexpr size_t MiB = 1u << 20;
constexpr size_t WS_W = 0, WS_SSXA = 32 * MiB, WS_SSXB = 36 * MiB, WS_SSQ = 40 * MiB, WS_SSKV = 41 * MiB, WS_PB = 42 * MiB, WS_XB = 106 * MiB,
                 WS_QB = 234 * MiB, WS_KVB = 330 * MiB, WS_Z = 458 * MiB, WS_END = 1002 * MiB;
static_assert(2 * WO_END * 2 <= 32 * MiB, "weights fit");
static_assert((size_t)T * ZW * 2 == 544 * MiB, "Z size");

struct Params {
    const float* x; const float* p; const int* pos;
    const float *g_mix, *w_in, *sink, *g_q, *w_uq, *g_kv, *w_ukv, *w_br_a, *w_br_b, *w_out, *g_ple, *w_ple_gate, *w_ple_proj, *g_final;
    float* out; unsigned char* ws;
    int ph_lo, ph_hi;
};

__device__ __forceinline__ unsigned cvt_pk_bf16(float lo, float hi) { unsigned r; asm volatile("v_cvt_pk_bf16_f32 %0, %1, %2" : "=v"(r) : "v"(lo), "v"(hi)); return r; }
__device__ __forceinline__ float bflo(unsigned w) { return __uint_as_float(w << 16); }
__device__ __forceinline__ float bfhi(unsigned w) { return __uint_as_float(w & 0xffff0000u); }
__device__ __forceinline__ float fsigmoid(float x) { return __builtin_amdgcn_rcpf(1.f + __expf(-x)); }
__device__ __forceinline__ float fsilu(float x) { return x * fsigmoid(x); }
__device__ __forceinline__ u32x4 pack8(const float* v) { u32x4 w; w.x = cvt_pk_bf16(v[0], v[1]); w.y = cvt_pk_bf16(v[2], v[3]); w.z = cvt_pk_bf16(v[4], v[5]); w.w = cvt_pk_bf16(v[6], v[7]); return w; }
__device__ __forceinline__ void unpack8(u32x4 w, float* v) { v[0] = bflo(w.x); v[1] = bfhi(w.x); v[2] = bflo(w.y); v[3] = bfhi(w.y); v[4] = bflo(w.z); v[5] = bfhi(w.z); v[6] = bflo(w.w); v[7] = bfhi(w.w); }
__device__ __forceinline__ float sum16(const float* s) { const f32x4 a = *(const f32x4*)s, b = *(const f32x4*)(s + 4), c = *(const f32x4*)(s + 8), d = *(const f32x4*)(s + 12);
    return ((a.x + a.y) + (a.z + a.w)) + ((b.x + b.y) + (b.z + b.w)) + ((c.x + c.y) + (c.z + c.w)) + ((d.x + d.y) + (d.z + d.w)); }
__device__ __forceinline__ float sum4(const float* s) { const f32x4 a = *(const f32x4*)s; return (a.x + a.y) + (a.z + a.w); }
__device__ __forceinline__ void rope8(float* v, int i0, float posf) {
#pragma unroll
    for (int j = 0; j < 4; ++j) {
        const float ci = __builtin_amdgcn_exp2f(-(float)(i0 + j) * 0.83048202372184059f) * 0.15915494309189535f;
        float r = posf * ci; r = r - rintf(r);
        const float sn = __builtin_amdgcn_sinf(r), cs = __builtin_amdgcn_cosf(r);
        const float x1 = v[2 * j], x2 = v[2 * j + 1];
        v[2 * j] = x1 * cs - x2 * sn; v[2 * j + 1] = x2 * cs + x1 * sn;
    }
}

namespace pg8 {
constexpr int BM = 256, BK = 64, HALF = 128, HTB = HALF * BK * 2, STAGE_BYTES = 8 * HTB, NXCD = 8, WGM = 8;
__host__ __device__ __forceinline__ int lds_byte(int r, int c) { const int st = (r >> 4) * 2 + (c >> 5), rr = r & 15, cc = c & 31, ob = rr * 64 + cc * 2; return st * 1024 + (ob ^ (((ob >> 9) & 1) << 5)); }
__host__ __device__ __forceinline__ void stage_rc(int b, int& R, int& C) { const int st = b / 1024, sb = b % 1024, swz = sb ^ (((sb >> 9) & 1) << 5); R = (st >> 1) * 16 + swz / 64; C = (st & 1) * 32 + (swz % 64) / 2; }
__host__ __device__ __forceinline__ int perm32(int rho) { const int n = rho >> 4, i = rho & 15; return 8 * (i >> 2) + 4 * n + (i & 3); }

struct Unit { int pm, pn; };
struct Gemm { const bf16_t* A; const bf16_t* Bt; int M, N, K, lda; };

struct StaticOrder {
    int nM, nN, nwg, G, c;
    __host__ __device__ void init(int M, int N, int G_, int c_) { nM = M / BM; nN = N / BM; nwg = nM * nN; G = G_; c = c_; }
    __host__ __device__ bool next(int i, Unit& u) const {
        const long L = (long)i * G + c; if (L >= nwg) return false;
        int wgid = (int)L; { const int q = nwg / NXCD, r = nwg % NXCD, xcd = wgid % NXCD, off = wgid / NXCD; wgid = (xcd < r ? xcd * (q + 1) : r * (q + 1) + (xcd - r) * q) + off; }
        const int nig = WGM * nN, gid = wgid / nig, fm = gid * WGM, gsz = (nM - fm) < WGM ? (nM - fm) : WGM;
        u.pm = fm + ((wgid % nig) % gsz); u.pn = (wgid % nig) / gsz; return true;
    }
};

template <class Epi>
__device__ __forceinline__ void gemm_phase(LAS unsigned char* lds, const Gemm g, const StaticOrder& S, const Epi& E, int stag = 0) {
    if (stag > 0) {
        const unsigned long long t0_ = __builtin_amdgcn_s_memrealtime(); const unsigned long long w_ = (unsigned long long)(((blockIdx.x >> 3) & 3) * stag);
        while (__builtin_amdgcn_s_memrealtime() - t0_ < w_) __builtin_amdgcn_s_sleep(8);
    }
    int tid_ = threadIdx.x; asm volatile("" : "+v"(tid_));
    const int tid = tid_, wid = __builtin_amdgcn_readfirstlane(tid >> 6), lane = tid & 63, wr = wid >> 2, wc = wid & 3, fr = lane & 15, fq = lane >> 4;
    const int K = g.K, nt = K / BK, lda = g.lda;
    unsigned voffA[2], voffB[2];
#pragma unroll
    for (int i = 0; i < 2; ++i) { int R, C; stage_rc(tid * 16 + i * 8192, R, C); const int Rb = (R & ~31) + perm32(R & 31);
        voffA[i] = (unsigned)(R * lda + C) * 2u; voffB[i] = (unsigned)(Rb * K + C) * 2u; }
    const size_t kstep = (size_t)(BK * 2);
    const size_t hstepA = (size_t)HALF * lda * 2, hstepB = (size_t)HALF * K * 2;
    const size_t tstepA = 2 * hstepA, tstepB = 2 * hstepB;
    const unsigned ldsw = (unsigned)wid * 1024u;
    const int aoff = lds_byte(wr * 64 + fr, fq * 8), boff = lds_byte(wc * 32 + fr, fq * 8);
#define PG8_SA(b, h) (((b) * 2 + (h)) * HTB)
#define PG8_SB(b, h) ((4 + (b) * 2 + (h)) * HTB)
#define PG8_STAGE(bufoff, gbase, voff) do { _Pragma("unroll") for (int _i = 0; _i < 2; ++_i) \
        { unsigned vo_ = (voff)[_i]; asm volatile("" : "+v"(vo_)); __builtin_amdgcn_global_load_lds((const unsigned*)((const char*)(gbase) + vo_), (LAS unsigned*)(lds + (bufoff) + ldsw + _i * 8192), 16, 0, 0); } } while (0)
#define PG8_LDA(dst, b, h) do { _Pragma("unroll") for (int m = 0; m < 4; ++m) _Pragma("unroll") for (int k = 0; k < 2; ++k) dst[m][k] = *(const LAS bf16x8*)(lds + PG8_SA(b, h) + aoff + m * 2048 + k * 1024); } while (0)
#define PG8_LDB(dst, b, h) do { _Pragma("unroll") for (int n = 0; n < 2; ++n) _Pragma("unroll") for (int k = 0; k < 2; ++k) dst[n][k] = *(const LAS bf16x8*)(lds + PG8_SB(b, h) + boff + n * 2048 + k * 1024); } while (0)
#define PG8_MMA(ai, bj, At, Bt) do { __builtin_amdgcn_s_setprio(1); _Pragma("unroll") for (int m = 0; m < 4; ++m) _Pragma("unroll") for (int n = 0; n < 2; ++n) _Pragma("unroll") for (int k = 0; k < 2; ++k) \
        acc[ai][bj][m][n] = __builtin_amdgcn_mfma_f32_16x16x32_bf16(Bt[n][k], At[m][k], acc[ai][bj][m][n], 0, 0, 0); __builtin_amdgcn_s_setprio(0); } while (0)
#define PG8_WAIT_V(n) asm volatile("s_waitcnt vmcnt(" #n ")" ::: "memory")
#define PG8_WAIT_L(n) asm volatile("s_waitcnt lgkmcnt(" #n ")" ::: "memory")
#define PG8_BAR __builtin_amdgcn_s_barrier()
#define PG8_SCHED __builtin_amdgcn_sched_barrier(0)
    Unit cur, nxt; int ui = 0;
    if (!S.next(0, cur)) return;
    f32x4 acc[2][2][4][2];
#pragma unroll
    for (int a = 0; a < 2; ++a)
#pragma unroll
        for (int b = 0; b < 2; ++b)
#pragma unroll
            for (int m = 0; m < 4; ++m)
#pragma unroll
                for (int n = 0; n < 2; ++n) acc[a][b][m][n] = (f32x4){0.f, 0.f, 0.f, 0.f};
    bf16x8 At[4][2], B0[2][2], B1[2][2];
    const char* cA = (const char*)g.A + (size_t)cur.pm * tstepA; const char* cB = (const char*)g.Bt + (size_t)cur.pn * tstepB;
    PG8_STAGE(PG8_SB(0, 0), cB, voffB); PG8_STAGE(PG8_SB(0, 1), cB + hstepB, voffB); PG8_STAGE(PG8_SA(0, 0), cA, voffA); PG8_STAGE(PG8_SA(0, 1), cA + hstepA, voffA);
    if (wr == 1) PG8_BAR;
    PG8_WAIT_V(2); PG8_BAR;
    PG8_STAGE(PG8_SB(1, 0), cB + kstep, voffB); PG8_STAGE(PG8_SA(1, 0), cA + kstep, voffA); PG8_STAGE(PG8_SB(1, 1), cB + hstepB + kstep, voffB);
    PG8_WAIT_V(6); PG8_BAR;
    for (;;) {
        const bool has_next = S.next(ui + 1, nxt);
        const char* nA = has_next ? (const char*)g.A + (size_t)nxt.pm * tstepA : cA; const char* nB = has_next ? (const char*)g.Bt + (size_t)nxt.pn * tstepB : cB;
#pragma unroll 1
        for (int t = 0; t < nt; t += 2) {
            const bool last = (t == nt - 2);
            const char* a1 = cA + (size_t)(t + 1) * kstep;
            const char* a2 = last ? nA : cA + (size_t)(t + 2) * kstep; const char* b2 = last ? nB : cB + (size_t)(t + 2) * kstep;
            const char* a3 = a2 + kstep; const char* b3 = b2 + kstep;
            PG8_LDB(B0, 0, 0); PG8_LDB(B1, 0, 1); PG8_SCHED; PG8_LDA(At, 0, 0); PG8_STAGE(PG8_SA(1, 1), a1 + hstepA, voffA);
            PG8_WAIT_V(8); PG8_WAIT_L(0); PG8_BAR; PG8_MMA(0, 0, At, B0); PG8_MMA(0, 1, At, B1); PG8_BAR; PG8_SCHED;
            PG8_LDA(At, 0, 1); PG8_STAGE(PG8_SB(0, 0), b2, voffB); PG8_STAGE(PG8_SB(0, 1), b2 + hstepB, voffB); PG8_STAGE(PG8_SA(0, 0), a2, voffA);
            PG8_WAIT_V(8); PG8_WAIT_L(0); PG8_BAR; PG8_MMA(1, 0, At, B0); PG8_MMA(1, 1, At, B1); PG8_BAR; PG8_SCHED;
            PG8_LDB(B0, 1, 0); PG8_LDB(B1, 1, 1); PG8_SCHED; PG8_LDA(At, 1, 0); PG8_STAGE(PG8_SA(0, 1), a2 + hstepA, voffA);
            PG8_WAIT_V(8); PG8_WAIT_L(0); PG8_BAR; PG8_MMA(0, 0, At, B0); PG8_MMA(0, 1, At, B1); PG8_BAR; PG8_SCHED;
            PG8_LDA(At, 1, 1); PG8_STAGE(PG8_SB(1, 0), b3, voffB); PG8_STAGE(PG8_SB(1, 1), b3 + hstepB, voffB); PG8_STAGE(PG8_SA(1, 0), a3, voffA);
            PG8_WAIT_V(8); PG8_WAIT_L(0); PG8_BAR; PG8_MMA(1, 0, At, B0); PG8_MMA(1, 1, At, B1); PG8_BAR; PG8_SCHED;
        }
        if (wr == 0) PG8_BAR;
        E(acc, cur, wr, wc, fr, fq);
        if (!has_next) break;
#pragma unroll
        for (int a = 0; a < 2; ++a)
#pragma unroll
            for (int b = 0; b < 2; ++b)
#pragma unroll
                for (int m = 0; m < 4; ++m)
#pragma unroll
                    for (int n = 0; n < 2; ++n) acc[a][b][m][n] = (f32x4){0.f, 0.f, 0.f, 0.f};
        cur = nxt; cA = nA; cB = nB; ++ui;
        if (wr == 1) PG8_BAR;
    }
    PG8_WAIT_V(0);
    PG8_BAR;
}
template <class Epi1, class Epi2>
__device__ __forceinline__ void gemm_phase_pair(LAS unsigned char* lds, const Gemm g, const Gemm g2, const StaticOrder& S, const Epi1& E, const Epi2& E2) {
    const int stag = 0;
    if (stag > 0) {
        const unsigned long long t0_ = __builtin_amdgcn_s_memrealtime(); const unsigned long long w_ = (unsigned long long)(((blockIdx.x >> 3) & 3) * stag);
        while (__builtin_amdgcn_s_memrealtime() - t0_ < w_) __builtin_amdgcn_s_sleep(8);
    }
    int tid_ = threadIdx.x; asm volatile("" : "+v"(tid_));
    const int tid = tid_, wid = __builtin_amdgcn_readfirstlane(tid >> 6), lane = tid & 63, wr = wid >> 2, wc = wid & 3, fr = lane & 15, fq = lane >> 4;
    const int K = g.K, nt = K / BK, lda = g.lda;
    unsigned voffA[2], voffB[2];
#pragma unroll
    for (int i = 0; i < 2; ++i) { int R, C; stage_rc(tid * 16 + i * 8192, R, C); const int Rb = (R & ~31) + perm32(R & 31);
        voffA[i] = (unsigned)(R * lda + C) * 2u; voffB[i] = (unsigned)(Rb * K + C) * 2u; }
    const size_t kstep = (size_t)(BK * 2);
    const size_t hstepA = (size_t)HALF * lda * 2, hstepB = (size_t)HALF * K * 2;
    const size_t tstepA = 2 * hstepA, tstepB = 2 * hstepB;
    const unsigned ldsw = (unsigned)wid * 1024u;
    const int aoff = lds_byte(wr * 64 + fr, fq * 8), boff = lds_byte(wc * 32 + fr, fq * 8);
#define PG8_SA(b, h) (((b) * 2 + (h)) * HTB)
#define PG8_SB(b, h) ((4 + (b) * 2 + (h)) * HTB)
#define PG8_STAGE(bufoff, gbase, voff) do { _Pragma("unroll") for (int _i = 0; _i < 2; ++_i) \
        { unsigned vo_ = (voff)[_i]; asm volatile("" : "+v"(vo_)); __builtin_amdgcn_global_load_lds((const unsigned*)((const char*)(gbase) + vo_), (LAS unsigned*)(lds + (bufoff) + ldsw + _i * 8192), 16, 0, 0); } } while (0)
#define PG8_LDA(dst, b, h) do { _Pragma("unroll") for (int m = 0; m < 4; ++m) _Pragma("unroll") for (int k = 0; k < 2; ++k) dst[m][k] = *(const LAS bf16x8*)(lds + PG8_SA(b, h) + aoff + m * 2048 + k * 1024); } while (0)
#define PG8_LDB(dst, b, h) do { _Pragma("unroll") for (int n = 0; n < 2; ++n) _Pragma("unroll") for (int k = 0; k < 2; ++k) dst[n][k] = *(const LAS bf16x8*)(lds + PG8_SB(b, h) + boff + n * 2048 + k * 1024); } while (0)
#define PG8_MMA(ai, bj, At, Bt) do { __builtin_amdgcn_s_setprio(1); _Pragma("unroll") for (int m = 0; m < 4; ++m) _Pragma("unroll") for (int n = 0; n < 2; ++n) _Pragma("unroll") for (int k = 0; k < 2; ++k) \
        acc[ai][bj][m][n] = __builtin_amdgcn_mfma_f32_16x16x32_bf16(Bt[n][k], At[m][k], acc[ai][bj][m][n], 0, 0, 0); __builtin_amdgcn_s_setprio(0); } while (0)
#define PG8_WAIT_V(n) asm volatile("s_waitcnt vmcnt(" #n ")" ::: "memory")
#define PG8_WAIT_L(n) asm volatile("s_waitcnt lgkmcnt(" #n ")" ::: "memory")
#define PG8_BAR __builtin_amdgcn_s_barrier()
#define PG8_SCHED __builtin_amdgcn_sched_barrier(0)
    Unit cur, nxt; int ui = 0;
    if (!S.next(0, cur)) return;
    int which = 0;
    f32x4 acc[2][2][4][2];
#pragma unroll
    for (int a = 0; a < 2; ++a)
#pragma unroll
        for (int b = 0; b < 2; ++b)
#pragma unroll
            for (int m = 0; m < 4; ++m)
#pragma unroll
                for (int n = 0; n < 2; ++n) acc[a][b][m][n] = (f32x4){0.f, 0.f, 0.f, 0.f};
    bf16x8 At[4][2], B0[2][2], B1[2][2];
    const char* cA = (const char*)g.A + (size_t)cur.pm * tstepA; const char* cB = (const char*)g.Bt + (size_t)cur.pn * tstepB;
    PG8_STAGE(PG8_SB(0, 0), cB, voffB); PG8_STAGE(PG8_SB(0, 1), cB + hstepB, voffB); PG8_STAGE(PG8_SA(0, 0), cA, voffA); PG8_STAGE(PG8_SA(0, 1), cA + hstepA, voffA);
    if (wr == 1) PG8_BAR;
    PG8_WAIT_V(2); PG8_BAR;
    PG8_STAGE(PG8_SB(1, 0), cB + kstep, voffB); PG8_STAGE(PG8_SA(1, 0), cA + kstep, voffA); PG8_STAGE(PG8_SB(1, 1), cB + hstepB + kstep, voffB);
    PG8_WAIT_V(6); PG8_BAR;
    for (;;) {
        const int nwhich = which ^ 1;
        bool has_next = true; if (which == 0) nxt = cur; else has_next = S.next((ui >> 1) + 1, nxt);
        const char* nA = has_next ? (const char*)(nwhich ? g2.A : g.A) + (size_t)nxt.pm * tstepA : cA; const char* nB = has_next ? (const char*)(nwhich ? g2.Bt : g.Bt) + (size_t)nxt.pn * tstepB : cB;
#pragma unroll 1
        for (int t = 0; t < nt; t += 2) {
            const bool last = (t == nt - 2);
            const char* a1 = cA + (size_t)(t + 1) * kstep;
            const char* a2 = last ? nA : cA + (size_t)(t + 2) * kstep; const char* b2 = last ? nB : cB + (size_t)(t + 2) * kstep;
            const char* a3 = a2 + kstep; const char* b3 = b2 + kstep;
            PG8_LDB(B0, 0, 0); PG8_LDB(B1, 0, 1); PG8_SCHED; PG8_LDA(At, 0, 0); PG8_STAGE(PG8_SA(1, 1), a1 + hstepA, voffA);
            PG8_WAIT_V(8); PG8_WAIT_L(0); PG8_BAR; PG8_MMA(0, 0, At, B0); PG8_MMA(0, 1, At, B1); PG8_BAR; PG8_SCHED;
            PG8_LDA(At, 0, 1); PG8_STAGE(PG8_SB(0, 0), b2, voffB); PG8_STAGE(PG8_SB(0, 1), b2 + hstepB, voffB); PG8_STAGE(PG8_SA(0, 0), a2, voffA);
            PG8_WAIT_V(8); PG8_WAIT_L(0); PG8_BAR; PG8_MMA(1, 0, At, B0); PG8_MMA(1, 1, At, B1); PG8_BAR; PG8_SCHED;
            PG8_LDB(B0, 1, 0); PG8_LDB(B1, 1, 1); PG8_SCHED; PG8_LDA(At, 1, 0); PG8_STAGE(PG8_SA(0, 1), a2 + hstepA, voffA);
            PG8_WAIT_V(8); PG8_WAIT_L(0); PG8_BAR; PG8_MMA(0, 0, At, B0); PG8_MMA(0, 1, At, B1); PG8_BAR; PG8_SCHED;
            PG8_LDA(At, 1, 1); PG8_STAGE(PG8_SB(1, 0), b3, voffB); PG8_STAGE(PG8_SB(1, 1), b3 + hstepB, voffB); PG8_STAGE(PG8_SA(1, 0), a3, voffA);
            PG8_WAIT_V(8); PG8_WAIT_L(0); PG8_BAR; PG8_MMA(1, 0, At, B0); PG8_MMA(1, 1, At, B1); PG8_BAR; PG8_SCHED;
        }
        if (wr == 0) PG8_BAR;
        if (which) E2(acc, cur, wr, wc, fr, fq); else E(acc, cur, wr, wc, fr, fq);
        if (!has_next) break;
#pragma unroll
        for (int a = 0; a < 2; ++a)
#pragma unroll
            for (int b = 0; b < 2; ++b)
#pragma unroll
                for (int m = 0; m < 4; ++m)
#pragma unroll
                    for (int n = 0; n < 2; ++n) acc[a][b][m][n] = (f32x4){0.f, 0.f, 0.f, 0.f};
        cur = nxt; cA = nA; cB = nB; ++ui; which = nwhich;
        if (wr == 1) PG8_BAR;
    }
    PG8_WAIT_V(0);
    PG8_BAR;
#undef PG8_SA
#undef PG8_SB
#undef PG8_STAGE
#undef PG8_LDA
#undef PG8_LDB
#undef PG8_MMA
#undef PG8_WAIT_V
#undef PG8_WAIT_L
#undef PG8_BAR
#undef PG8_SCHED
}
}

typedef f32x4 Acc[2][2][4][2];
__device__ __forceinline__ bool epi_fence() { asm volatile("" ::: "memory"); return true; }
#define EPI_ROWS(u, wr, fr) const int row0_ = (u).pm * 256 + (wr) * 64 + (fr);
#define EPI_LOADV(v) float v[8]; { const f32x4 a0_ = acc[ai][bj][m][0], a1_ = acc[ai][bj][m][1]; v[0] = a0_[0]; v[1] = a0_[1]; v[2] = a0_[2]; v[3] = a0_[3]; v[4] = a1_[0]; v[5] = a1_[1]; v[6] = a1_[2]; v[7] = a1_[3]; }
constexpr int RTAB_OFF = 131072;
template <int NSLOT>
__device__ __forceinline__ void fill_rtab(LAS unsigned char* lds, const float* ss, int pm, float inv_n, float mul) {
    int tid_ = threadIdx.x; asm volatile("" : "+v"(tid_));
    if (tid_ < 256) { const float* s = ss + ((size_t)pm * 256 + tid_) * NSLOT; const float t = NSLOT == 16 ? sum16(s) : sum4(s);
        ((LAS float*)(lds + RTAB_OFF))[tid_] = rsqrtf(t * inv_n + EPS) * mul; }
    asm volatile("s_waitcnt lgkmcnt(0)" ::: "memory"); __builtin_amdgcn_s_barrier(); asm volatile("" ::: "memory");
}
#define RTAB(ai, m) (((const LAS float*)(lds + RTAB_OFF))[(ai) * 128 + wr * 64 + (m) * 16 + fr])

struct EpiZ {
    bf16_t* Z; const float* ssx; float* ssq; float* sskv; const int* pos; LAS unsigned char* lds;
    __device__ __forceinline__ void operator()(const Acc& acc, const pg8::Unit& u, int wr, int wc, int fr, int fq) const {
        EPI_ROWS(u, wr, fr)
        fill_rtab<16>(lds, ssx, u.pm, 1.f / 1024.f, 1.f);
        const int pn = u.pn;
        const int cbase = pn * 256 + wc * 32 + 8 * fq;
#pragma unroll
        for (int ai = 0; ai < 2; ++ai)
#pragma unroll
        for (int m = 0; m < 4; ++m) {
            const int row = row0_ + ai * 128 + m * 16;
            const float rstd = RTAB(ai, m);
            bf16_t* zr = Z + (size_t)row * ZW + cbase;
            float st = 0.f; u32x4 gq8 = (u32x4){0u, 0u, 0u, 0u};
#pragma unroll
            for (int bj = 0; bj < 2; ++bj) {
                EPI_LOADV(v)
#pragma unroll
                for (int j = 0; j < 8; ++j) v[j] *= rstd;
                bool store = true;
                if (pn <= 1) {
#pragma unroll
                    for (int j = 0; j < 8; ++j) v[j] *= (0.125f * LOG2E);
                } else if (pn == 3 || pn == 4 || pn == 7 || pn == 8) {
#pragma unroll
                    for (int j = 0; j < 8; ++j) v[j] = fsilu(v[j]);
                } else if (pn >= 9) {
#pragma unroll
                    for (int j = 0; j < 8; ++j) v[j] = fsigmoid(v[j]);
                } else if (pn == 5) {
#pragma unroll
                    for (int j = 0; j < 8; ++j) st += v[j] * v[j];
                } else if (pn == 6) {
                    if (bj == 0) {
#pragma unroll
                        for (int j = 0; j < 8; ++j) st += v[j] * v[j];
                    } else {
                        if (wc == 0) rope8(v, 4 * fq, (float)pos[row]); else store = false;
                    }
                }
                if (pn >= 9) {
                    u32x2 q8;
                    q8.x = (unsigned)(v[0] * 255.f + 0.5f) | ((unsigned)(v[1] * 255.f + 0.5f) << 8) | ((unsigned)(v[2] * 255.f + 0.5f) << 16) | ((unsigned)(v[3] * 255.f + 0.5f) << 24);
                    q8.y = (unsigned)(v[4] * 255.f + 0.5f) | ((unsigned)(v[5] * 255.f + 0.5f) << 8) | ((unsigned)(v[6] * 255.f + 0.5f) << 16) | ((unsigned)(v[7] * 255.f + 0.5f) << 24);
                    if (bj == 0) { gq8.x = q8.x; gq8.y = q8.y; } else { gq8.z = q8.x; gq8.w = q8.y; }
                } else if (store) *(u32x4*)(zr + bj * 128) = pack8(v);
            }
            if (pn >= 9) *(u32x4*)((unsigned char*)(Z + (size_t)row * ZW + ZC_MA) + (pn - 9) * 256 + (wc * 32 + 8 * fq) * 2) = gq8;
            if (pn == 5 || pn == 6) {
                st += __shfl_xor(st, 16); st += __shfl_xor(st, 32);
                if (fq == 0) { if (pn == 5) ssq[(size_t)row * 4 + wc] = st; else sskv[(size_t)row * 4 + wc] = st; }
            }
        }
    }
};
struct EpiQB {
    bf16_t* QB; const float* ssq; const int* pos; LAS unsigned char* lds;
    __device__ __forceinline__ void operator()(const Acc& acc, const pg8::Unit& u, int wr, int wc, int fr, int fq) const {
        EPI_ROWS(u, wr, fr)
        fill_rtab<4>(lds, ssq, u.pm, 1.f / 256.f, 0.10206207261596577f * LOG2E);
        const int cbase = u.pn * 256 + wc * 32 + 8 * fq;
        const int c0 = cbase, c1 = cbase + 128, cc0 = c0 % 96, cc1 = c1 % 96;
        const bool anyrope = (cc0 >= 64) || (cc1 >= 64);
#pragma unroll
        for (int ai = 0; ai < 2; ++ai)
#pragma unroll
        for (int m = 0; m < 4; ++m) {
            const int row = row0_ + ai * 128 + m * 16;
            epi_fence();
            const float rstd = RTAB(ai, m);
            float posf = 0.f; if (anyrope) posf = (float)pos[row];
#pragma unroll
            for (int bj = 0; bj < 2; ++bj) {
                EPI_LOADV(v)
#pragma unroll
                for (int j = 0; j < 8; ++j) v[j] *= rstd;
                const int cc = bj ? cc1 : cc0;
                if (cc >= 64) rope8(v, (cc - 64) >> 1, posf);
                *(u32x4*)(QB + (size_t)row * 768 + cbase + bj * 128) = pack8(v);
            }
        }
    }
};
struct EpiKVB {
    bf16_t* KVB; const float* sskv; LAS unsigned char* lds;
    __device__ __forceinline__ void operator()(const Acc& acc, const pg8::Unit& u, int wr, int wc, int fr, int fq) const {
        EPI_ROWS(u, wr, fr)
        fill_rtab<4>(lds, sskv, u.pm, 1.f / 128.f, 1.f);
        const int cbase = u.pn * 256 + wc * 32 + 8 * fq;
#pragma unroll
        for (int ai = 0; ai < 2; ++ai)
#pragma unroll
        for (int m = 0; m < 4; ++m) {
            const int row = row0_ + ai * 128 + m * 16;
            const float rstd = RTAB(ai, m);
#pragma unroll
            for (int bj = 0; bj < 2; ++bj) {
                EPI_LOADV(v)
#pragma unroll
                for (int j = 0; j < 8; ++j) v[j] *= rstd;
                *(u32x4*)(KVB + (size_t)row * 1024 + cbase + bj * 128) = pack8(v);
            }
        }
    }
};
template <int SECOND> struct EpiMerge {
    bf16_t* Z; bf16_t* Y;
    __device__ __forceinline__ void operator()(const Acc& acc, const pg8::Unit& u, int wr, int wc, int fr, int fq) const {
        EPI_ROWS(u, wr, fr)
        const int cbase = u.pn * 256 + wc * 32 + 8 * fq;
#pragma unroll
        for (int ai = 0; ai < 2; ++ai) {
            epi_fence();
            u32x4 sgq[4]; u32x4 tg[4][2];
#pragma unroll
            for (int m = 0; m < 4; ++m) { const bf16_t* zr = Z + (size_t)(row0_ + ai * 128 + m * 16) * ZW;
                sgq[m] = *(const u32x4*)((const unsigned char*)(zr + ZC_MA) + (SECOND ? 1024 : 0) + u.pn * 256 + (wc * 32 + 8 * fq) * 2);
#pragma unroll
                for (int bj = 0; bj < 2; ++bj) { if (SECOND) tg[m][bj] = *(const u32x4*)(zr + ZC_MB + cbase + bj * 128); } }
#pragma unroll
            for (int m = 0; m < 4; ++m)
#pragma unroll
                for (int bj = 0; bj < 2; ++bj) {
                    EPI_LOADV(v)
                    const unsigned g0 = bj ? sgq[m].z : sgq[m].x, g1 = bj ? sgq[m].w : sgq[m].y;
                    const float s[8] = {(float)(g0 & 255u), (float)((g0 >> 8) & 255u), (float)((g0 >> 16) & 255u), (float)(g0 >> 24), (float)(g1 & 255u), (float)((g1 >> 8) & 255u), (float)((g1 >> 16) & 255u), (float)(g1 >> 24)};
#pragma unroll
                    for (int j = 0; j < 8; ++j) v[j] *= s[j] * (1.f / 255.f);
                    if (SECOND) { float t[8]; unpack8(tg[m][bj], t);
#pragma unroll
                        for (int j = 0; j < 8; ++j) v[j] += t[j];
                        *(u32x4*)(Y + (size_t)(row0_ + ai * 128 + m * 16) * 1024 + cbase + bj * 128) = pack8(v); }
                    else *(u32x4*)(Z + (size_t)(row0_ + ai * 128 + m * 16) * ZW + ZC_MB + cbase + bj * 128) = pack8(v);
                }
        }
    }
};
template <int BF> struct EpiX1 {
    const float* xin; const bf16_t* xinb; bf16_t* Z; float* ssb;
    __device__ __forceinline__ void operator()(const Acc& acc, const pg8::Unit& u, int wr, int wc, int fr, int fq) const {
        EPI_ROWS(u, wr, fr)
        const int cbase = u.pn * 256 + wc * 32 + 8 * fq;
#pragma unroll
        for (int ai = 0; ai < 2; ++ai) {
            epi_fence();
            float stv[4];
            f32x4 xa[4][2][2]; u32x4 xh[4][2];
#pragma unroll
            for (int m = 0; m < 4; ++m)
#pragma unroll
                for (int bj = 0; bj < 2; ++bj) { const size_t o_ = (size_t)(row0_ + ai * 128 + m * 16) * D + cbase + bj * 128;
                    if (BF) xh[m][bj] = *(const u32x4*)(xinb + o_); else { xa[m][bj][0] = *(const f32x4*)(xin + o_); xa[m][bj][1] = *(const f32x4*)(xin + o_ + 4); } }
#pragma unroll
            for (int m = 0; m < 4; ++m) {
                const int row = row0_ + ai * 128 + m * 16;
                float st = 0.f;
#pragma unroll
                for (int bj = 0; bj < 2; ++bj) {
                    EPI_LOADV(v)
                    if (BF) { float xv[8]; unpack8(xh[m][bj], xv);
#pragma unroll
                        for (int j = 0; j < 8; ++j) v[j] += xv[j]; }
                    else { const f32x4 x0 = xa[m][bj][0], x1 = xa[m][bj][1];
                        v[0] += x0[0]; v[1] += x0[1]; v[2] += x0[2]; v[3] += x0[3]; v[4] += x1[0]; v[5] += x1[1]; v[6] += x1[2]; v[7] += x1[3]; }
#pragma unroll
                    for (int j = 0; j < 8; ++j) st += v[j] * v[j];
                    *(u32x4*)(Z + (size_t)row * ZW + ZC_X1B + cbase + bj * 128) = pack8(v);
                }
                st += __shfl_xor(st, 16); st += __shfl_xor(st, 32);
                stv[m] = st;
            }
            ssb[(size_t)(row0_ + ai * 128 + fq * 16) * 16 + u.pn * 4 + wc] = (fq == 0 ? stv[0] : fq == 1 ? stv[1] : fq == 2 ? stv[2] : stv[3]);
        }
    }
};
struct EpiPP {
    bf16_t* Z;
    __device__ __forceinline__ void operator()(const Acc& acc, const pg8::Unit& u, int wr, int wc, int fr, int fq) const {
        EPI_ROWS(u, wr, fr)
        const int cbase = u.pn * 256 + wc * 32 + 8 * fq;
#pragma unroll
        for (int ai = 0; ai < 2; ++ai)
#pragma unroll
        for (int m = 0; m < 4; ++m) {
            const int row = row0_ + ai * 128 + m * 16;
#pragma unroll
            for (int bj = 0; bj < 2; ++bj) { EPI_LOADV(v) *(u32x4*)(Z + (size_t)row * ZW + ZC_T2 + cbase + bj * 128) = pack8(v); }
        }
    }
};
struct EpiX2 {
    float* xio; const bf16_t* Z; bf16_t* xb; const float* ssb; float* ssa; LAS unsigned char* lds; bool write_xb;
    __device__ __forceinline__ void operator()(const Acc& acc, const pg8::Unit& u, int wr, int wc, int fr, int fq) const {
        EPI_ROWS(u, wr, fr)
        fill_rtab<16>(lds, ssb, u.pm, 1.f / 1024.f, 1.f);
        const int cbase = u.pn * 256 + wc * 32 + 8 * fq;
#pragma unroll
        for (int ai = 0; ai < 2; ++ai) {
        float stv[4];
#pragma unroll
        for (int mp = 0; mp < 2; ++mp) {
            epi_fence();
            u32x4 xa[2][2], tg[2][2];
#pragma unroll
            for (int mm = 0; mm < 2; ++mm)
#pragma unroll
                for (int bj = 0; bj < 2; ++bj) { const int row = row0_ + ai * 128 + (mp * 2 + mm) * 16; const bf16_t* zp = Z + (size_t)row * ZW + cbase + bj * 128;
                    xa[mm][bj] = *(const u32x4*)(zp + ZC_X1B); tg[mm][bj] = *(const u32x4*)(zp + ZC_T2); }
#pragma unroll
            for (int mm = 0; mm < 2; ++mm) {
                const int m = mp * 2 + mm;
                const int row = row0_ + ai * 128 + m * 16;
                const float rstd = RTAB(ai, m);
                float st = 0.f;
#pragma unroll
                for (int bj = 0; bj < 2; ++bj) {
                    EPI_LOADV(v)
                    const size_t off = (size_t)row * D + cbase + bj * 128;
                    float t[8]; unpack8(tg[mm][bj], t);
                    float xv[8]; unpack8(xa[mm][bj], xv);
#pragma unroll
                    for (int j = 0; j < 8; ++j) { v[j] = xv[j] + fsigmoid(v[j] * rstd) * t[j]; st += v[j] * v[j]; }
                    *(u32x4*)(xb + off) = pack8(v);
                }
                st += __shfl_xor(st, 16); st += __shfl_xor(st, 32);
                stv[m] = st;
            }
        }
        ssa[(size_t)(row0_ + ai * 128 + fq * 16) * 16 + u.pn * 4 + wc] = (fq == 0 ? stv[0] : fq == 1 ? stv[1] : fq == 2 ? stv[2] : stv[3]);
        }
    }
};


struct EpiX2F {
    float* out; const bf16_t* Z; const float* ssb; float* ssa; const float* gfin; unsigned* cnt; LAS unsigned char* lds;
    __device__ __forceinline__ void operator()(Acc& acc, const pg8::Unit& u, int wr, int wc, int fr, int fq) const {
        EPI_ROWS(u, wr, fr)
        fill_rtab<16>(lds, ssb, u.pm, 1.f / 1024.f, 1.f);
        const int cbase = u.pn * 256 + wc * 32 + 8 * fq;
#pragma unroll
        for (int ai = 0; ai < 2; ++ai) {
        float stv[4];
#pragma unroll
        for (int mp = 0; mp < 2; ++mp) {
            epi_fence();
            u32x4 xa[2][2], tg[2][2];
#pragma unroll
            for (int mm = 0; mm < 2; ++mm)
#pragma unroll
                for (int bj = 0; bj < 2; ++bj) { const int row = row0_ + ai * 128 + (mp * 2 + mm) * 16; const bf16_t* zp = Z + (size_t)row * ZW + cbase + bj * 128;
                    xa[mm][bj] = *(const u32x4*)(zp + ZC_X1B); tg[mm][bj] = *(const u32x4*)(zp + ZC_T2); }
#pragma unroll
            for (int mm = 0; mm < 2; ++mm) {
                const int m = mp * 2 + mm;
                const int row = row0_ + ai * 128 + m * 16;
                const float rstd = RTAB(ai, m);
                float st = 0.f;
#pragma unroll
                for (int bj = 0; bj < 2; ++bj) {
                    EPI_LOADV(v)
                    float t[8]; unpack8(tg[mm][bj], t);
                    float xv[8]; unpack8(xa[mm][bj], xv);
#pragma unroll
                    for (int j = 0; j < 8; ++j) { v[j] = xv[j] + fsigmoid(v[j] * rstd) * t[j]; st += v[j] * v[j]; }
                    acc[ai][bj][m][0] = (f32x4){v[0], v[1], v[2], v[3]}; acc[ai][bj][m][1] = (f32x4){v[4], v[5], v[6], v[7]};
                }
                st += __shfl_xor(st, 16); st += __shfl_xor(st, 32);
                stv[m] = st;
            }
        }
        __hip_atomic_store(ssa + (size_t)(row0_ + ai * 128 + fq * 16) * 16 + u.pn * 4 + wc, (fq == 0 ? stv[0] : fq == 1 ? stv[1] : fq == 2 ? stv[2] : stv[3]), __ATOMIC_RELAXED, __HIP_MEMORY_SCOPE_AGENT);
        }
        asm volatile("s_waitcnt vmcnt(0)" ::: "memory"); __builtin_amdgcn_s_barrier(); asm volatile("" ::: "memory");
        int tid_ = threadIdx.x; asm volatile("" : "+v"(tid_));
        if (tid_ == 0) {
            __hip_atomic_fetch_add(cnt + u.pm, 1u, __ATOMIC_RELAXED, __HIP_MEMORY_SCOPE_AGENT);
            unsigned sp = 0; while (__hip_atomic_load(cnt + u.pm, __ATOMIC_RELAXED, __HIP_MEMORY_SCOPE_AGENT) < 4u && ++sp < (1u << 22)) __builtin_amdgcn_s_sleep(1);
            __builtin_amdgcn_fence(__ATOMIC_ACQUIRE, "agent"); asm volatile("s_waitcnt vmcnt(0)" ::: "memory");
        }
        asm volatile("s_waitcnt vmcnt(0) lgkmcnt(0)" ::: "memory"); __builtin_amdgcn_s_barrier(); asm volatile("" ::: "memory");
        if (tid_ < 256) { const float* sp_ = ssa + ((size_t)u.pm * 256 + tid_) * 16; float t = 0.f;
#pragma unroll
            for (int k = 0; k < 16; ++k) t += __hip_atomic_load(sp_ + k, __ATOMIC_RELAXED, __HIP_MEMORY_SCOPE_AGENT);
            ((LAS float*)(lds + RTAB_OFF))[tid_] = rsqrtf(t * (1.f / 1024.f) + EPS); }
        asm volatile("s_waitcnt lgkmcnt(0)" ::: "memory"); __builtin_amdgcn_s_barrier(); asm volatile("" ::: "memory");
        f32x4 gq[2][2];
#pragma unroll
        for (int bj = 0; bj < 2; ++bj) { gq[bj][0] = *(const f32x4*)(gfin + cbase + bj * 128); gq[bj][1] = *(const f32x4*)(gfin + cbase + bj * 128 + 4); }
#pragma unroll
        for (int ai = 0; ai < 2; ++ai)
#pragma unroll
        for (int m = 0; m < 4; ++m) {
            const int row = row0_ + ai * 128 + m * 16;
            const float r2 = RTAB(ai, m);
#pragma unroll
            for (int bj = 0; bj < 2; ++bj) { const size_t off = (size_t)row * D + cbase + bj * 128;
                *(f32x4*)(out + off) = acc[ai][bj][m][0] * r2 * gq[bj][0]; *(f32x4*)(out + off + 4) = acc[ai][bj][m][1] * r2 * gq[bj][1]; }
        }
    }
};

namespace att {
typedef short v4i16_t __attribute__((ext_vector_type(4)));
template <int MODE> struct Cfg { static constexpr int DQK = MODE == 0 ? 96 : 64, KROW = DQK + 8, KBUF = 64 * KROW * 2, VBUF = 8192, PBUF = 256, BUF = KBUF + VBUF + PBUF; };
#define MX3(a, b, c) __builtin_fmaxf(__builtin_fmaxf((a), (b)), (c))
__device__ __forceinline__ float rowmax32(const f32x16& p0, const f32x16& p1) {
    float a = MX3(p0[0], p0[1], p1[0]), b = MX3(p0[2], p0[3], p1[1]); a = MX3(a, p1[2], p1[3]);
#pragma unroll
    for (int r = 4; r < 16; r += 4) { a = MX3(a, p0[r], p0[r + 1]); b = MX3(b, p0[r + 2], p0[r + 3]); a = MX3(a, p1[r], p1[r + 1]); b = MX3(b, p1[r + 2], p1[r + 3]); }
    const float m = __builtin_fmaxf(a, b); auto rr = __builtin_amdgcn_permlane32_swap(__float_as_uint(m), __float_as_uint(m), false, false);
    return __builtin_fmaxf(__uint_as_float(rr[0]), __uint_as_float(rr[1])); }
__device__ __forceinline__ bf16x8 vfrag(const LAS unsigned char* p) {
    const v4i16_t lo = __builtin_amdgcn_ds_read_tr16_b64_v4i16((LAS v4i16_t*)p), hi = __builtin_amdgcn_ds_read_tr16_b64_v4i16((LAS v4i16_t*)(p + 512));
    return (bf16x8){lo[0], lo[1], lo[2], lo[3], hi[0], hi[1], hi[2], hi[3]}; }

template <int MODE>
__device__ __forceinline__ void attn_mode(LAS unsigned char* lds, const bf16_t* QB, const bf16_t* KVB, bf16_t* Z, const int* pos, const float* sink, int u_begin, int u_end, int u_step) {
    typedef Cfg<MODE> C;
    constexpr int DQK = C::DQK, KROW = C::KROW, NKS = DQK / 16;
    asm volatile("" : "+s"(u_begin));
    if (u_begin >= u_end) return;
    int tid_ = threadIdx.x; asm volatile("" : "+v"(tid_));
    const int tid = tid_, w = __builtin_amdgcn_readfirstlane(tid >> 6), lane = tid & 63, lq = lane & 31, hh = lane >> 5;
#define ATT_DECODE(u_, b_, hk_, qblk_) do { if (MODE == 0) { const int bh_ = (u_) & 255; qblk_ = 7 - ((u_) >> 8); b_ = bh_ >> 3; hk_ = bh_ & 7; } else { const int v_ = (u_) - 2048; b_ = v_ >> 6; hk_ = (v_ >> 5) & 1; qblk_ = v_ & 31; } } while (0)
#define ATT_GEOM(qblk_, hk_, wq0_, hq_, j0_) do { if (MODE == 0) { wq0_ = (qblk_) * 256 + 32 * w; hq_ = (hk_); j0_ = 0; } else { wq0_ = (qblk_) * 64 + 32 * (w >> 2); hq_ = (hk_) * 4 + (w & 3); j0_ = (qblk_) - 2; if (j0_ < 0) j0_ = 0; } } while (0)
#define ATT_QLOAD(tq_, hq_) do { _Pragma("unroll") for (int ks = 0; ks < NKS; ++ks) { \
        if (MODE == 0) qf[ks] = *(const bf16x8*)(QB + (tq_) * 768 + (hq_) * 96 + ks * 16 + hh * 8); \
        else qf[ks] = *(const bf16x8*)(Z + (tq_) * ZW + ZC_QA + (hq_) * 64 + ks * 16 + hh * 8); } } while (0)
    bf16x8 qf[NKS];
    u32x4 sk0, sk1, sv; int sp = 0;
    sk1 = (u32x4){0u, 0u, 0u, 0u};
    u32x4 nk0, nk1, nv; int np = 0;
    nk0 = nk1 = nv = (u32x4){0u, 0u, 0u, 0u};
    const int vkey = tid >> 3, vpart = tid & 7;
    const int vwr = (vpart >> 2) * 4096 + vkey * 64 + (vpart & 3) * 16;
    const int vrd = (4 * hh + ((lane & 15) >> 2)) * 64 + ((lane >> 4) & 1) * 32 + (lane & 3) * 8;
    const char *pk0 = nullptr, *pk1 = nullptr, *pvv = nullptr, *ppp = nullptr; unsigned inc0 = 0, inc1 = 0;
    int kst0, kst1;
    if (MODE == 0) { kst0 = ((tid / 12) * KROW + (tid % 12) * 8) * 2; kst1 = (((tid + 512) / 12) * KROW + ((tid + 512) % 12) * 8) * 2; }
    else { kst0 = (vkey * KROW + vpart * 8) * 2; kst1 = 0; }
#define ATT_SETUP(tok0, hk, j) do { const size_t kt = (tok0) + (size_t)(j) * 64; \
        if (MODE == 0) { { const int key = tid / 12, part = tid % 12; pk0 = (const char*)(part < 8 ? KVB + (kt + key) * 1024 + (hk) * 128 + part * 8 : Z + (kt + key) * ZW + ZC_KR + (part - 8) * 8); inc0 = part < 8 ? 64u * 1024u * 2u : 64u * ZW * 2u; } \
            { const int c2 = tid + 512, key = c2 / 12, part = c2 % 12; pk1 = (const char*)(part < 8 ? KVB + (kt + key) * 1024 + (hk) * 128 + part * 8 : Z + (kt + key) * ZW + ZC_KR + (part - 8) * 8); inc1 = part < 8 ? 64u * 1024u * 2u : 64u * ZW * 2u; } \
            pvv = (const char*)(KVB + (kt + vkey) * 1024 + (hk) * 128 + 64 + vpart * 8); } \
        else { pk0 = (const char*)(Z + (kt + vkey) * ZW + ZC_KA + (hk) * 64 + vpart * 8); pvv = (const char*)(Z + (kt + vkey) * ZW + ZC_VA + (hk) * 64 + vpart * 8); ppp = (const char*)(pos + kt + (tid & 63)); } } while (0)
#define ATT_LOADP(K0, K1, VV, PP) do { \
        if (MODE == 0) { K0 = *(const u32x4*)pk0; pk0 += inc0; if (tid < 256) { K1 = *(const u32x4*)pk1; pk1 += inc1; } VV = *(const u32x4*)pvv; pvv += 64 * 1024 * 2; } \
        else { K0 = *(const u32x4*)pk0; pk0 += 64 * ZW * 2; VV = *(const u32x4*)pvv; pvv += 64 * ZW * 2; if (tid < 64) PP = *(const int*)ppp; ppp += 256; } } while (0)
    { int b_, hk_, qblk_, wq0_, hq_, j0_; ATT_DECODE(u_begin, b_, hk_, qblk_); ATT_GEOM(qblk_, hk_, wq0_, hq_, j0_);
      const size_t tok0_ = (size_t)b_ * SEQ; ATT_QLOAD(tok0_ + wq0_ + lq, hq_); ATT_SETUP(tok0_, hk_, j0_); ATT_LOADP(sk0, sk1, sv, sp); }
    for (int u = u_begin; u < u_end; u += u_step) {
    int b, hk, qblk; ATT_DECODE(u, b, hk, qblk);
    const size_t tok0 = (size_t)b * SEQ;
    int wq0, hq, j0; ATT_GEOM(qblk, hk, wq0, hq, j0);
    const int q0 = MODE == 0 ? qblk * 256 : qblk * 64;
    const int qq = wq0 + lq;
    const size_t tq = tok0 + qq;
    const int j1 = MODE == 0 ? (q0 + 256) / 64 - 1 : q0 / 64;
    float slope_l2 = 0.f, pqf = 0.f, mrun, lrun;
    if (MODE == 1) { slope_l2 = exp2f(-(float)(hq + 1)) * LOG2E; pqf = (float)pos[tq]; mrun = sink[hq] * LOG2E; lrun = hh == 0 ? 1.f : 0.f; }
    else { mrun = 0.f; lrun = 0.f; }
    f32x16 O0, O1, negm;
#pragma unroll
    for (int i = 0; i < 16; ++i) { O0[i] = 0.f; O1[i] = 0.f; negm[i] = 0.f; }
    bool first = true;
    if (MODE == 1) {
#pragma unroll
        for (int i = 0; i < 16; ++i) negm[i] = -slope_l2 * pqf; }

#define ATT_STORE(bufi) do { LAS unsigned char* bb = lds + (bufi) * C::BUF; \
        *(LAS u32x4*)(bb + kst0) = sk0; \
        if (MODE == 0) { if (tid < 256) *(LAS u32x4*)(bb + kst1) = sk1; } \
        else { if (tid < 64) ((LAS float*)(bb + C::KBUF + C::VBUF))[tid] = (float)sp; } \
        *(LAS u32x4*)(bb + C::KBUF + vwr) = sv; } while (0)
#define ATT_BAR() do { asm volatile("s_waitcnt lgkmcnt(0)" ::: "memory"); __builtin_amdgcn_s_barrier(); asm volatile("" ::: "memory"); } while (0)

    ATT_STORE(0);
    ATT_BAR();
    if (j0 < j1) ATT_LOADP(sk0, sk1, sv, sp);
    for (int j = j0; j <= j1; ++j) {
        const int bufi = (j - j0) & 1;
        if (j + 2 <= j1) ATT_LOADP(nk0, nk1, nv, np);
        const int k0 = j * 64;
        const bool active = (MODE == 1) || (k0 <= wq0 + 31);
        if (active) {
            const LAS unsigned char* bb = lds + bufi * C::BUF; const LAS bf16_t* Kb = (const LAS bf16_t*)bb; const LAS unsigned char* Vb = bb + C::KBUF + vrd;
            f32x16 S0, S1;
            S0 = negm; S1 = negm;
            bf16x8 kf[2 * NKS];
#pragma unroll
            for (int ks = 0; ks < NKS; ++ks) {
                kf[2 * ks] = *(const LAS bf16x8*)(Kb + lq * KROW + ks * 16 + hh * 8);
                kf[2 * ks + 1] = *(const LAS bf16x8*)(Kb + (32 + lq) * KROW + ks * 16 + hh * 8);
            }
            __builtin_amdgcn_sched_barrier(0);
#pragma unroll
            for (int ks = 0; ks < NKS; ++ks) {
                S0 = __builtin_amdgcn_mfma_f32_32x32x16_bf16(kf[2 * ks], qf[ks], S0, 0, 0, 0);
                S1 = __builtin_amdgcn_mfma_f32_32x32x16_bf16(kf[2 * ks + 1], qf[ks], S1, 0, 0, 0);
            }
            if (MODE == 1) {
                const LAS float* pk = (const LAS float*)(bb + C::KBUF + C::VBUF) + 4 * hh;
                const bool allv = (k0 + 63 <= wq0) && (wq0 + 31 - k0 < 128);
                const int d0 = qq - k0 - 4 * hh;
                if (allv) {
#pragma unroll
                    for (int i4 = 0; i4 < 4; ++i4) {
                        const f32x4 pa = *(const LAS f32x4*)(pk + 8 * i4), pb = *(const LAS f32x4*)(pk + 32 + 8 * i4);
#pragma unroll
                        for (int ii = 0; ii < 4; ++ii) { S0[4 * i4 + ii] = __builtin_fmaf(slope_l2, pa[ii], S0[4 * i4 + ii]); S1[4 * i4 + ii] = __builtin_fmaf(slope_l2, pb[ii], S1[4 * i4 + ii]); }
                    }
                } else {
#pragma unroll
                    for (int i4 = 0; i4 < 4; ++i4) {
                        const f32x4 pa = *(const LAS f32x4*)(pk + 8 * i4), pb = *(const LAS f32x4*)(pk + 32 + 8 * i4);
#pragma unroll
                        for (int ii = 0; ii < 4; ++ii) {
                            const float sa = __builtin_fmaf(slope_l2, pa[ii], S0[4 * i4 + ii]), sb = __builtin_fmaf(slope_l2, pb[ii], S1[4 * i4 + ii]);
                            S0[4 * i4 + ii] = ((unsigned)(d0 - (8 * i4 + ii)) < 128u) ? sa : -1e30f; S1[4 * i4 + ii] = ((unsigned)(d0 - (32 + 8 * i4 + ii)) < 128u) ? sb : -1e30f;
                        }
                    }
                }
            } else if (k0 + 63 > wq0) {
#pragma unroll
                for (int i = 0; i < 16; ++i) {
                    const int ka_i = k0 + 8 * (i >> 2) + 4 * hh + (i & 3);
                    if (ka_i > qq) S0[i] = -1e30f;
                    if (ka_i + 32 > qq) S1[i] = -1e30f;
                }
            }
            const float mx = rowmax32(S0, S1);
            if (MODE == 0) {
                if (first || __builtin_amdgcn_ballot_w64(mx > 8.f) != 0ull) {
                    const float delta = first ? mx : fmaxf(mx, 0.f);
                    const float alpha = first ? 1.f : __builtin_amdgcn_exp2f(-delta);
                    mrun += delta; lrun *= alpha;
#pragma unroll
                    for (int i = 0; i < 16; ++i) { S0[i] -= delta; S1[i] -= delta; O0[i] *= alpha; O1[i] *= alpha; negm[i] = -mrun; }
                    first = false;
                }
            } else {
                const float mnew = fmaxf(mrun, mx);
                const float alpha = __builtin_amdgcn_exp2f(mrun - mnew);
                mrun = mnew; lrun *= alpha;
#pragma unroll
                for (int i = 0; i < 16; ++i) { S0[i] -= mnew; S1[i] -= mnew; O0[i] *= alpha; O1[i] *= alpha; }
            }
            bf16x8 va0[4], va1[4];
#pragma unroll
            for (int t4 = 0; t4 < 4; ++t4) { va0[t4] = vfrag(Vb + t4 * 1024); va1[t4] = vfrag(Vb + 4096 + t4 * 1024); }
            float ps = 0.f;
#pragma unroll
            for (int g = 0; g < 4; ++g) {
                float e[8];
#pragma unroll
                for (int i = 0; i < 8; ++i) { e[i] = __builtin_amdgcn_exp2f(g < 2 ? S0[8 * (g & 1) + i] : S1[8 * (g & 1) + i]); }
                ps += ((e[0] + e[1]) + (e[2] + e[3])) + ((e[4] + e[5]) + (e[6] + e[7]));
                u32x4 a; a.x = cvt_pk_bf16(e[0], e[1]); a.y = cvt_pk_bf16(e[2], e[3]); a.z = cvt_pk_bf16(e[4], e[5]); a.w = cvt_pk_bf16(e[6], e[7]);
                const bf16x8 pfg = __builtin_bit_cast(bf16x8, a);
                O0 = __builtin_amdgcn_mfma_f32_32x32x16_bf16(va0[g], pfg, O0, 0, 0, 0);
                O1 = __builtin_amdgcn_mfma_f32_32x32x16_bf16(va1[g], pfg, O1, 0, 0, 0);
                __builtin_amdgcn_sched_barrier(0);
            }
            lrun += ps;
        }
        if (j < j1) ATT_STORE(bufi ^ 1);
        sk0 = nk0; sk1 = nk1; sv = nv; sp = np;
        ATT_BAR();
    }
    const float ltot = lrun + __shfl_xor(lrun, 32);
    const float inv = 1.f / ltot;
    if (u + u_step < u_end) {
        int b_, hk_, qblk_, wq0_, hq_, j0_; ATT_DECODE(u + u_step, b_, hk_, qblk_); ATT_GEOM(qblk_, hk_, wq0_, hq_, j0_);
        const size_t tok0_ = (size_t)b_ * SEQ; ATT_QLOAD(tok0_ + wq0_ + lq, hq_); ATT_SETUP(tok0_, hk_, j0_); ATT_LOADP(sk0, sk1, sv, sp); }
    LAS unsigned char* ost = lds + 65536 + w * 4608;
#pragma unroll
    for (int i4 = 0; i4 < 4; ++i4) {
        const int dv0 = 8 * i4 + 4 * hh;
        u32x2 o;
        o.x = cvt_pk_bf16(O0[4 * i4 + 0] * inv, O0[4 * i4 + 1] * inv); o.y = cvt_pk_bf16(O0[4 * i4 + 2] * inv, O0[4 * i4 + 3] * inv);
        *(LAS u32x2*)(ost + lq * 144 + dv0 * 2) = o;
        o.x = cvt_pk_bf16(O1[4 * i4 + 0] * inv, O1[4 * i4 + 1] * inv); o.y = cvt_pk_bf16(O1[4 * i4 + 2] * inv, O1[4 * i4 + 3] * inv);
        *(LAS u32x2*)(ost + lq * 144 + 64 + dv0 * 2) = o;
    }
    asm volatile("s_waitcnt lgkmcnt(0)" ::: "memory");
    {
        const int chunk = lane & 7;
        bf16_t* obase = Z + (tok0 + wq0) * ZW + (MODE == 0 ? ZC_GB : ZC_GA) + hq * 64 + chunk * 8;
        u32x4 gv[4], ov[4];
#pragma unroll
        for (int k = 0; k < 4; ++k) { const int row = (lane >> 3) + 8 * k; gv[k] = *(const u32x4*)(obase + (size_t)row * ZW); ov[k] = *(const LAS u32x4*)(ost + row * 144 + chunk * 16); }
#pragma unroll
        for (int k = 0; k < 4; ++k) { const int row = (lane >> 3) + 8 * k; float a[8], g[8]; unpack8(ov[k], a); unpack8(gv[k], g);
#pragma unroll
            for (int e = 0; e < 8; ++e) a[e] *= g[e];
            *(u32x4*)(obase + (size_t)row * ZW) = pack8(a); }
    }
    }
#undef ATT_SETUP
#undef ATT_LOADP
#undef ATT_STORE
#undef ATT_BAR
#undef ATT_DECODE
#undef ATT_GEOM
#undef ATT_QLOAD
}
#undef MX3
}

#define XB_TMO      128
#define XB_XCNT(j)  (256  + 64 * (j))
#define XB_XSUB(j)  (1280 + 64 * (j))
#define XB_XGEN(j)  (2304 + 64 * (j))
#define XB_TOP      3328
#define XB_TOPGEN   3392
#define XCD_BAR_WORDS 3456
#define XB_SPIN_CAP (1u << 18)

__device__ __forceinline__ unsigned xb_ld(unsigned* p)              { return __hip_atomic_load(p, __ATOMIC_RELAXED, __HIP_MEMORY_SCOPE_AGENT); }
__device__ __forceinline__ unsigned xb_add(unsigned* p, unsigned v) { return __hip_atomic_fetch_add(p, v, __ATOMIC_RELAXED, __HIP_MEMORY_SCOPE_AGENT); }
__device__ __forceinline__ unsigned xb_xcc_id() { return (unsigned)__builtin_amdgcn_s_getreg((3 << 11) | 20) & 0xFu; }
#define XB_SPIN(cond, bar) do { unsigned _sp = 0; while (cond) { __builtin_amdgcn_s_sleep(1); \
    if ((++_sp & 255u) == 0u) { if (xb_ld(&(bar)[XB_TMO])) break; if (_sp > XB_SPIN_CAP) { atomicAdd(&(bar)[XB_TMO], 1u); break; } } } } while (0)

struct XcdBarrier {
    unsigned* bar; unsigned x;
    volatile LAS unsigned* st;
};

__device__ __forceinline__ XcdBarrier xcd_barrier_post(unsigned* bar, volatile LAS unsigned* st) {
    XcdBarrier b; b.bar = bar; b.x = xb_xcc_id(); b.st = st;
    if (threadIdx.x == 0) (void)xb_add(&bar[XB_XCNT(b.x)], 1u);
    return b;
}
__device__ __forceinline__ void xcd_barrier_complete(unsigned* bar, unsigned x, unsigned& nloc, unsigned& nx) {
    const unsigned G = gridDim.x * gridDim.y * gridDim.z;
    unsigned sum, cnt, mine, sp = 0u;
    for (;;) {
        sum = 0u; cnt = 0u; mine = 0u;
#pragma unroll
        for (unsigned j = 0; j < 16; ++j) { const unsigned c = xb_ld(&bar[XB_XCNT(j)]); sum += c; cnt += (c > 0u) ? 1u : 0u; mine = (j == x) ? c : mine; }
        if (sum == G) break;
        __builtin_amdgcn_s_sleep(1);
        if ((++sp & 255u) == 0u) { if (xb_ld(&bar[XB_TMO])) break; if (sp > XB_SPIN_CAP) { atomicAdd(&bar[XB_TMO], 1u); break; } }
    }
    nloc = mine > 0u ? mine : 1u; nx = cnt > 0u ? cnt : 1u;
}

__device__ __forceinline__ void xcd_barrier(const XcdBarrier& b) {
    asm volatile("s_waitcnt vmcnt(0)" ::: "memory");
    __syncthreads();
    if (threadIdx.x == 0) {
        unsigned* bar = b.bar;
        __builtin_amdgcn_s_waitcnt(0);
        unsigned nloc = b.st[0], nx = b.st[1];
        if (nloc == 0u) { xcd_barrier_complete(bar, b.x, nloc, nx); b.st[0] = nloc; b.st[1] = nx; }
        const unsigned old = xb_add(&bar[XB_XSUB(b.x)], 1u);
        const unsigned gen = old / nloc;
        if (old + 1u == (gen + 1u) * nloc) {
            __builtin_amdgcn_fence(__ATOMIC_RELEASE, "agent");
            asm volatile("s_waitcnt vmcnt(0)" ::: "memory");
            const unsigned og = xb_add(&bar[XB_TOP], 1u);
            const unsigned tg = og / nx;
            if (og + 1u == (tg + 1u) * nx) xb_add(&bar[XB_TOPGEN], 1u);
            else XB_SPIN(xb_ld(&bar[XB_TOPGEN]) == tg, bar);
            __builtin_amdgcn_fence(__ATOMIC_ACQUIRE, "agent");
            xb_add(&bar[XB_XGEN(b.x)], 1u);
            asm volatile("s_waitcnt vmcnt(0)" ::: "memory");
        } else {
            XB_SPIN(xb_ld(&bar[XB_XGEN(b.x)]) == gen, bar);
            __builtin_amdgcn_fence(__ATOMIC_ACQUIRE, "agent");
            asm volatile("s_waitcnt vmcnt(0)" ::: "memory");
        }
    }
    __syncthreads();
}


__device__ __forceinline__ int colmap(int type, int n) {
    if (type == 1) {
        if (n < 1664) return n;
        if (n < 1696) { const int j = n - 1664; return 1664 + (j >> 1) + 16 * (j & 1); }
        if (n < 1792) return -1;
        return n - 96;
    }
    if (type == 2) {
        const int h = n / 96, c = n % 96; if (c < 64) return n; const int j = c - 64; return h * 96 + 64 + (j >> 1) + 16 * (j & 1);
    }
    return n;
}
__device__ __forceinline__ void wprep(const float* W, int K, int Nsrc, const float* g, bf16_t* dst, int Ndst, int type, size_t gtid, size_t gthreads) {
    const size_t total = (size_t)Ndst * (K / 8);
    for (size_t idx = gtid; idx < total; idx += gthreads) {
        const int n = (int)(idx % Ndst), kc = (int)(idx / Ndst);
        const int src = colmap(type, n);
        float v[8];
#pragma unroll
        for (int j = 0; j < 8; ++j) { const int k = kc * 8 + j; v[j] = src < 0 ? 0.f : W[(size_t)k * Nsrc + src] * (g ? g[k] : 1.f); }
        *(u32x4*)(dst + (size_t)n * K + kc * 8) = pack8(v);
    }
}

__device__ __forceinline__ void wprep_item(const float* W, int K, int Nsrc, const float* g, bf16_t* dst, int Ndst, int type, LAS float* scr, int item, int lane) {
    const int nblk = Ndst / 32, kb = item / nblk, nb = item % nblk, k0 = 64 * kb, n0 = 32 * nb;
    const int src = colmap(type, n0 + (lane & 31));
#pragma unroll 8
    for (int i = 0; i < 32; ++i) { const int kk = 2 * i + (lane >> 5); scr[kk * 33 + (lane & 31)] = src < 0 ? 0.f : W[(size_t)(k0 + kk) * Nsrc + src] * (g ? g[k0 + kk] : 1.f); }
    asm volatile("s_waitcnt lgkmcnt(0)" ::: "memory");
    const int c = lane & 7;
#pragma unroll
    for (int j = 0; j < 4; ++j) { const int n = (lane >> 3) + 8 * j; const LAS float* sp = scr + (8 * c) * 33 + n;
        u32x4 o; o.x = cvt_pk_bf16(sp[0 * 33], sp[1 * 33]); o.y = cvt_pk_bf16(sp[2 * 33], sp[3 * 33]); o.z = cvt_pk_bf16(sp[4 * 33], sp[5 * 33]); o.w = cvt_pk_bf16(sp[6 * 33], sp[7 * 33]);
        *(u32x4*)(dst + (size_t)(n0 + n) * K + k0 + 8 * c) = o; }
    asm volatile("s_waitcnt lgkmcnt(0)" ::: "memory");
}
constexpr int LDS_BYTES = 131072 + 1024 + 64;
constexpr int BARST_OFF = 131072 + 1024;
constexpr size_t WS_BAR = WS_W + 31 * MiB + 768 * 1024;
constexpr int STAG_P1 = 0, STAG_P4 = 0, STAG_P5 = 0, STAG_P6 = 0;
constexpr int N_PHASES = 1 + 6 * DEPTH + 1;

__global__ void __launch_bounds__(512, 2) fwd_megakernel(Params P) {
    extern __shared__ __attribute__((aligned(16))) unsigned char lds_raw[];
    LAS unsigned char* lds = (LAS unsigned char*)lds_raw;
    cg::grid_group grid = cg::this_grid();
    const int G = gridDim.x, bid = blockIdx.x;
    if (threadIdx.x < 2) ((LAS unsigned*)(lds + BARST_OFF))[threadIdx.x] = 0u;
    __syncthreads();
    XcdBarrier xbar; xbar.bar = (unsigned*)(P.ws + WS_BAR); xbar.x = 0; xbar.st = (volatile LAS unsigned*)(lds + BARST_OFF);
    unsigned char* ws = P.ws;
    bf16_t* Wb = (bf16_t*)(ws + WS_W);
    float* SSXA = (float*)(ws + WS_SSXA); float* SSXB = (float*)(ws + WS_SSXB); float* SSQ = (float*)(ws + WS_SSQ); float* SSKV = (float*)(ws + WS_SSKV);
    bf16_t* PB = (bf16_t*)(ws + WS_PB); bf16_t* XB = (bf16_t*)(ws + WS_XB); bf16_t* QB = (bf16_t*)(ws + WS_QB); bf16_t* KVB = (bf16_t*)(ws + WS_KVB); bf16_t* Z = (bf16_t*)(ws + WS_Z);
    const int lo = P.ph_lo, hi = P.ph_hi;
    int ph = 0;
    if (bid == 0) { unsigned* bw = (unsigned*)(P.ws + WS_BAR); for (int i = threadIdx.x; i < 4096 + 256; i += 512) bw[i] = 0u; }
#define PHASE_BEGIN if (ph >= lo && ph < hi) {
#if PROBE_SET
    unsigned long long* TS = (unsigned long long*)(ws + WS_W + 31 * MiB + 512 * 1024);
    if (bid == 0 && threadIdx.x == 0) TS[15] = __builtin_amdgcn_s_memrealtime();
#define PHASE_END   if (ph == 12 && bid == 0 && threadIdx.x == 0) TS[ph] = __builtin_amdgcn_s_memrealtime(); if (ph + 1 < hi) { if (ph == lo) { grid.sync(); xbar = xcd_barrier_post((unsigned*)(P.ws + WS_BAR), (volatile LAS unsigned*)(lds + BARST_OFF)); } else xcd_barrier(xbar); } if (ph < 12 && bid == 0 && threadIdx.x == 0) TS[ph] = __builtin_amdgcn_s_memrealtime(); } ++ph;
#else
#define PHASE_END   if (ph + 1 < hi && !(ph + 2 == N_PHASES && G == 256)) { if (ph == lo) { grid.sync(); xbar = xcd_barrier_post((unsigned*)(P.ws + WS_BAR), (volatile LAS unsigned*)(lds + BARST_OFF)); } else xcd_barrier(xbar); } } ++ph;
#endif

    PHASE_BEGIN
#if (PHMASK >> 0) & 1
    {
        int tid_ = threadIdx.x; asm volatile("" : "+v"(tid_)); const int tid = tid_, lane = tid & 63, wave = tid >> 6;
        const size_t gtid = (size_t)bid * 512 + tid, gthreads = (size_t)G * 512;
        {
            LAS float* scr = (LAS float*)(lds + wave * 16384);
            const int gwv = bid * 8 + wave, ngw = G * 8;
            constexpr int I_IN = 16 * 136, I_UQ = 4 * 24, I_UKV = 2 * 32, I_A = 8 * 32, I_OUT = 16 * 32, I_PP = 4 * 32, I_L = I_IN + I_UQ + I_UKV + 2 * I_A + 2 * I_OUT + I_PP;
            for (int it = gwv; it < DEPTH * I_L; it += ngw) {
                const int L = it / I_L; int r = it % I_L;
                bf16_t* wl = Wb + (size_t)L * WO_END;
                if (r < I_IN) { wprep_item(P.w_in + (size_t)L * 1024 * IN_WIDTH, 1024, IN_WIDTH, P.g_mix + L * 1024, wl + WO_IN, ZW, 1, scr, r, lane); continue; } r -= I_IN;
                if (r < I_UQ) { wprep_item(P.w_uq + (size_t)L * 256 * 768, 256, 768, P.g_q + L * 256, wl + WO_UQ, 768, 2, scr, r, lane); continue; } r -= I_UQ;
                if (r < I_UKV) { wprep_item(P.w_ukv + (size_t)L * 128 * 1024, 128, 1024, P.g_kv + L * 128, wl + WO_UKV, 1024, 0, scr, r, lane); continue; } r -= I_UKV;
                if (r < I_A) { wprep_item(P.w_br_a + (size_t)L * 512 * 1024, 512, 1024, nullptr, wl + WO_A, 1024, 0, scr, r, lane); continue; } r -= I_A;
                if (r < I_A) { wprep_item(P.w_br_b + (size_t)L * 512 * 1024, 512, 1024, nullptr, wl + WO_B, 1024, 0, scr, r, lane); continue; } r -= I_A;
                if (r < I_OUT) { wprep_item(P.w_out + (size_t)L * 1024 * 1024, 1024, 1024, nullptr, wl + WO_OUT, 1024, 0, scr, r, lane); continue; } r -= I_OUT;
                if (r < I_OUT) { wprep_item(P.w_ple_gate + (size_t)L * 1024 * 1024, 1024, 1024, P.g_ple + L * 1024, wl + WO_PG, 1024, 0, scr, r, lane); continue; } r -= I_OUT;
                wprep_item(P.w_ple_proj + (size_t)L * 256 * 1024, 256, 1024, nullptr, wl + WO_PP, 1024, 0, scr, r, lane);
            }
        }
        const int gw = bid * 8 + wave, NGW = G * 8;
        for (int r = gw; r < T; r += NGW) {
            const f32x4* xr = (const f32x4*)(P.x + (size_t)r * D) + lane;
            float s = 0.f;
#pragma unroll
            for (int j = 0; j < 4; ++j) { const f32x4 v = xr[64 * j]; s += (v.x * v.x + v.y * v.y) + (v.z * v.z + v.w * v.w);
                u32x2 o; o.x = cvt_pk_bf16(v.x, v.y); o.y = cvt_pk_bf16(v.z, v.w); *((u32x2*)(XB + (size_t)r * D) + lane + 64 * j) = o; }
#pragma unroll
            for (int o = 1; o < 64; o <<= 1) s += __shfl_xor(s, o);
            if (lane < 16) SSXA[(size_t)r * 16 + lane] = lane == 0 ? s : 0.f;
        }
        const size_t np8 = (size_t)DEPTH * T * PLE / 8;
        for (size_t i = gtid; i < np8; i += gthreads) { const f32x4 a = *(const f32x4*)(P.p + i * 8), c = *(const f32x4*)(P.p + i * 8 + 4);
            u32x4 o; o.x = cvt_pk_bf16(a.x, a.y); o.y = cvt_pk_bf16(a.z, a.w); o.z = cvt_pk_bf16(c.x, c.y); o.w = cvt_pk_bf16(c.z, c.w); *(u32x4*)(PB + i * 8) = o; }
    }
#endif
    PHASE_END

#pragma unroll 1
    for (int L = 0; L < DEPTH; ++L) {
        const bf16_t* wl = Wb + (size_t)L * WO_END;
        PHASE_BEGIN
#if (PHMASK >> 1) & 1
        { pg8::Gemm g{XB, wl + WO_IN, T, ZW, 1024, 1024}; pg8::StaticOrder S; S.init(T, ZW, G, bid);
          EpiZ E{Z, SSXA, SSQ, SSKV, P.pos, lds}; pg8::gemm_phase(lds, g, S, E, STAG_P1); }
    #endif
    PHASE_END
        PHASE_BEGIN
#if (PHMASK >> 2) & 1
        { pg8::Gemm g{Z + ZC_BQD, wl + WO_UQ, T, 768, 256, ZW}; pg8::StaticOrder S; S.init(T, 768, G, bid);
          EpiQB E{QB, SSQ, P.pos, lds}; pg8::gemm_phase(lds, g, S, E); }
        { pg8::Gemm g{Z + ZC_BKVD, wl + WO_UKV, T, 1024, 128, ZW}; pg8::StaticOrder S; S.init(T, 1024, G, bid);
          EpiKVB E{KVB, SSKV, lds}; pg8::gemm_phase(lds, g, S, E); }
    #endif
    PHASE_END
        PHASE_BEGIN
#if (PHMASK >> 3) & 1
        {
            __syncthreads();
            att::attn_mode<0>(lds, QB, KVB, Z, P.pos, nullptr, bid, 2048, G);
            { const int u1 = bid + ((2048 - bid + G - 1) / G) * G; att::attn_mode<1>(lds, QB, KVB, Z, P.pos, P.sink + L * 8, u1, 4096, G); }
        }
    #endif
    PHASE_END
        PHASE_BEGIN
#if (PHMASK >> 4) & 1
        { pg8::Gemm g{Z + ZC_GA, wl + WO_A, T, 1024, 512, ZW}; pg8::Gemm g2{Z + ZC_GB, wl + WO_B, T, 1024, 512, ZW}; pg8::StaticOrder S; S.init(T, 1024, G, bid);
          EpiMerge<0> E{Z, KVB}; EpiMerge<1> E2{Z, KVB}; pg8::gemm_phase_pair(lds, g, g2, S, E, E2); }
    #endif
    PHASE_END
        PHASE_BEGIN
#if (PHMASK >> 5) & 1
        { pg8::Gemm g{KVB, wl + WO_OUT, T, 1024, 1024, 1024}; pg8::StaticOrder S; S.init(T, 1024, G, bid);
          EpiX1<1> E{P.x, XB, Z, SSXB}; pg8::gemm_phase(lds, g, S, E, STAG_P5); }
        { pg8::Gemm g{PB + (size_t)L * T * PLE, wl + WO_PP, T, 1024, 256, 256}; pg8::StaticOrder S; S.init(T, 1024, G, bid);
          EpiPP E{Z}; pg8::gemm_phase(lds, g, S, E); }
    #endif
    PHASE_END
        PHASE_BEGIN
#if (PHMASK >> 6) & 1
        { pg8::Gemm g{Z + ZC_X1B, wl + WO_PG, T, 1024, 1024, ZW}; pg8::StaticOrder S; S.init(T, 1024, G, bid);
          if (L + 1 == DEPTH && G == 256) { EpiX2F E{P.out, Z, SSXB, SSXA, P.g_final, (unsigned*)(P.ws + WS_BAR) + 4096, lds}; pg8::gemm_phase(lds, g, S, E, STAG_P6); }
          else { EpiX2 E{P.out, Z, XB, SSXB, SSXA, lds, L + 1 < DEPTH}; pg8::gemm_phase(lds, g, S, E, STAG_P6); } }
    #endif
    PHASE_END
    }
    PHASE_BEGIN
#if (PHMASK >> 7) & 1
    {
        int tid_ = threadIdx.x; asm volatile("" : "+v"(tid_)); const int tid = tid_, lane = tid & 63, wave = tid >> 6;
        const int gw = G == 256 ? T : bid * 8 + wave, NGW = G * 8;
#if PROBE_SET
        int krows = 0;
        { unsigned long long prev = TS[15], sel = 0; const unsigned long long t0 = prev;
          for (int k = 0; k <= 12; ++k) { const unsigned long long tk = TS[k]; if ((PROBE_SET >> k) & 1) sel += tk - prev; prev = tk; }
          krows = (int)((float)sel / (float)(prev - t0) * 4096.f + 0.5f); }
#endif
        for (int r = gw; r < T; r += NGW) {
            const float rstd = rsqrtf(sum16(SSXA + (size_t)r * 16) * (1.f / 1024.f) + EPS);
            f32x4* xr = (f32x4*)(P.out + (size_t)r * D) + lane; const f32x4* gr = (const f32x4*)P.g_final + lane; const u32x2* xbr = (const u32x2*)(XB + (size_t)r * D) + lane;
#pragma unroll
            for (int j = 0; j < 4; ++j) { const u32x2 xw = xbr[64 * j]; f32x4 v = (f32x4){bflo(xw.x), bfhi(xw.x), bflo(xw.y), bfhi(xw.y)}; const f32x4 gg = gr[64 * j]; v.x *= rstd * gg.x; v.y *= rstd * gg.y; v.z *= rstd * gg.z; v.w *= rstd * gg.w;
#if PROBE_SET
                if (r < krows) { v.x += 0.015f; v.y += 0.015f; v.z += 0.015f; v.w += 0.015f; }
#endif
                xr[64 * j] = v; }
        }
    }
#endif
    PHASE_END
#undef PHASE_BEGIN
#undef PHASE_END
}

extern "C" void kernel_launch(void* const* d_in, const int* in_sizes, int n_in, void* d_out, int out_size, void* d_ws, size_t ws_size, hipStream_t stream) {
    static int grid = 0;
    if (grid == 0) {
        if (n_in != 17 || in_sizes[0] != T * D || out_size != T * D || ws_size < WS_END) {
            fprintf(stderr, "kernel_launch: unexpected shapes/workspace: n_in %d in0 %d out %d ws %zu (need %zu)\n", n_in, n_in > 0 ? in_sizes[0] : -1, out_size, ws_size, (size_t)WS_END); grid = -1; return; }
        int dev = 0, cus = 0, per_cu = 0;
        hipGetDevice(&dev); hipDeviceGetAttribute(&cus, hipDeviceAttributeMultiprocessorCount, dev);
        if (hipFuncSetAttribute((const void*)fwd_megakernel, hipFuncAttributeMaxDynamicSharedMemorySize, LDS_BYTES) != hipSuccess) { fprintf(stderr, "kernel_launch: hipFuncSetAttribute failed\n"); grid = -1; return; }
        if (hipOccupancyMaxActiveBlocksPerMultiprocessor(&per_cu, (const void*)fwd_megakernel, 512, LDS_BYTES) != hipSuccess || per_cu < 1) { fprintf(stderr, "kernel_launch: occupancy query gave %d\n", per_cu); per_cu = 1; }
        (void)hipGetLastError();
        grid = cus * 1;
        fprintf(stderr, "kernel_launch: grid %d (cus %d, per_cu %d)\n", grid, cus, per_cu);
    }
    if (grid < 0) return;
    Params p{};
    p.x = (const float*)d_in[0]; p.p = (const float*)d_in[1]; p.pos = (const int*)d_in[2];
    p.g_mix = (const float*)d_in[3]; p.w_in = (const float*)d_in[4]; p.sink = (const float*)d_in[5]; p.g_q = (const float*)d_in[6]; p.w_uq = (const float*)d_in[7];
    p.g_kv = (const float*)d_in[8]; p.w_ukv = (const float*)d_in[9]; p.w_br_a = (const float*)d_in[10]; p.w_br_b = (const float*)d_in[11]; p.w_out = (const float*)d_in[12];
    p.g_ple = (const float*)d_in[13]; p.w_ple_gate = (const float*)d_in[14]; p.w_ple_proj = (const float*)d_in[15]; p.g_final = (const float*)d_in[16];
    p.out = (float*)d_out; p.ws = (unsigned char*)d_ws;
#if ONE_LAUNCH
    p.ph_lo = 0; p.ph_hi = N_PHASES;
    { void* args[] = {&p}; hipError_t e = hipLaunchCooperativeKernel((const void*)fwd_megakernel, dim3(grid), dim3(512), args, LDS_BYTES, stream);
      if (e != hipSuccess) fprintf(stderr, "cooperative launch failed: %s (grid %d)\n", hipGetErrorString(e), grid); }
#else
    for (int ph = 0; ph < N_PHASES; ++ph) {
        p.ph_lo = ph; p.ph_hi = ph + 1;
        void* args[] = {&p}; hipError_t e = hipLaunchCooperativeKernel((const void*)fwd_megakernel, dim3(grid), dim3(512), args, LDS_BYTES, stream);
        if (e != hipSuccess) { fprintf(stderr, "cooperative launch %d failed: %s (grid %d)\n", ph, hipGetErrorString(e), grid); break; }
    }
#endif
}
```

```cpp
#include <hip/hip_runtime.h>
#include <hip/hip_cooperative_groups.h>
#include <cstdio>
#include <cstdint>
namespace cg = cooperative_groups;

#ifndef PHMASK
#define PHMASK 255
#endif
#ifndef PROBE_SET
#define PROBE_SET 0
#endif
#ifndef ONE_LAUNCH
#define ONE_LAUNCH 1
#endif

#define LAS __attribute__((address_space(3)))
typedef unsigned short bf16_t;
typedef short bf16x8 __attribute__((ext_vector_type(8)));
typedef float f32x4 __attribute__((ext_vector_type(4)));
typedef float f32x16 __attribute__((ext_vector_type(16)));
typedef unsigned u32x4 __attribute__((ext_vector_type(4)));
typedef unsigned u32x2 __attribute__((ext_vector_type(2)));

constexpr int BATCH = 32, SEQ = 2048, T = BATCH * SEQ, D = 1024, DEPTH = 2, PLE = 256;
constexpr int ZW = 4352;
constexpr int ZC_QA = 0, ZC_KA = 512, ZC_VA = 640, ZC_GA = 768, ZC_BQD = 1280, ZC_BKVD = 1536, ZC_KR = 1664, ZC_GB = 1792, ZC_MA = 2304, ZC_MB = 3328;
constexpr int ZC_X1B = ZC_MA, ZC_T2 = 0;
constexpr int IN_WIDTH = 4256;
constexpr float EPS = 1e-6f;
constexpr float LOG2E = 1.4426950408889634f;

constexpr size_t WO_IN = 0, WO_UQ = WO_IN + (size_t)ZW * 1024, WO_UKV = WO_UQ + 768 * 256, WO_A = WO_UKV + 1024 * 128, WO_B = WO_A + 1024 * 512,
                 WO_OUT = WO_B + 1024 * 512, WO_PG = WO_OUT + 1024 * 1024, WO_PP = WO_PG + 1024 * 1024, WO_END = WO_PP + 1024 * 256;
constexpr size_t MiB = 1u << 20;
constexpr size_t WS_W = 0, WS_SSXA = 32 * MiB, WS_SSXB = 36 * MiB, WS_SSQ = 40 * MiB, WS_SSKV = 41 * MiB, WS_PB = 42 * MiB, WS_XB = 106 * MiB,
                 WS_QB = 234 * MiB, WS_KVB = 330 * MiB, WS_Z = 458 * MiB, WS_END = 1002 * MiB;
static_assert(2 * WO_END * 2 <= 32 * MiB, "weights fit");
static_assert((size_t)T * ZW * 2 == 544 * MiB, "Z size");

struct Params {
    const float* x; const float* p; const int* pos;
    const float *g_mix, *w_in, *sink, *g_q, *w_uq, *g_kv, *w_ukv, *w_br_a, *w_br_b, *w_out, *g_ple, *w_ple_gate, *w_ple_proj, *g_final;
    float* out; unsigned char* ws;
    int ph_lo, ph_hi;
};

__device__ __forceinline__ unsigned cvt_pk_bf16(float lo, float hi) { unsigned r; asm volatile("v_cvt_pk_bf16_f32 %0, %1, %2" : "=v"(r) : "v"(lo), "v"(hi)); return r; }
__device__ __forceinline__ float bflo(unsigned w) { return __uint_as_float(w << 16); }
__device__ __forceinline__ float bfhi(unsigned w) { return __uint_as_float(w & 0xffff0000u); }
__device__ __forceinline__ float fsigmoid(float x) { return __builtin_amdgcn_rcpf(1.f + __expf(-x)); }
__device__ __forceinline__ float fsilu(float x) { return x * fsigmoid(x); }
__device__ __forceinline__ u32x4 pack8(const float* v) { u32x4 w; w.x = cvt_pk_bf16(v[0], v[1]); w.y = cvt_pk_bf16(v[2], v[3]); w.z = cvt_pk_bf16(v[4], v[5]); w.w = cvt_pk_bf16(v[6], v[7]); return w; }
__device__ __forceinline__ void unpack8(u32x4 w, float* v) { v[0] = bflo(w.x); v[1] = bfhi(w.x); v[2] = bflo(w.y); v[3] = bfhi(w.y); v[4] = bflo(w.z); v[5] = bfhi(w.z); v[6] = bflo(w.w); v[7] = bfhi(w.w); }
__device__ __forceinline__ float sum16(const float* s) { const f32x4 a = *(const f32x4*)s, b = *(const f32x4*)(s + 4), c = *(const f32x4*)(s + 8), d = *(const f32x4*)(s + 12);
    return ((a.x + a.y) + (a.z + a.w)) + ((b.x + b.y) + (b.z + b.w)) + ((c.x + c.y) + (c.z + c.w)) + ((d.x + d.y) + (d.z + d.w)); }
__device__ __forceinline__ float sum4(const float* s) { const f32x4 a = *(const f32x4*)s; return (a.x + a.y) + (a.z + a.w); }
__device__ __forceinline__ void rope8(float* v, int i0, float posf) {
#pragma unroll
    for (int j = 0; j < 4; ++j) {
        const float ci = __builtin_amdgcn_exp2f(-(float)(i0 + j) * 0.83048202372184059f) * 0.15915494309189535f;
        float r = posf * ci; r = r - rintf(r);
        const float sn = __builtin_amdgcn_sinf(r), cs = __builtin_amdgcn_cosf(r);
        const float x1 = v[2 * j], x2 = v[2 * j + 1];
        v[2 * j] = x1 * cs - x2 * sn; v[2 * j + 1] = x2 * cs + x1 * sn;
    }
}

namespace pg8 {
constexpr int BM = 256, BK = 64, HALF = 128, HTB = HALF * BK * 2, STAGE_BYTES = 8 * HTB, NXCD = 8, WGM = 8;
__host__ __device__ __forceinline__ int lds_byte(int r, int c) { const int st = (r >> 4) * 2 + (c >> 5), rr = r & 15, cc = c & 31, ob = rr * 64 + cc * 2; return st * 1024 + (ob ^ (((ob >> 9) & 1) << 5)); }
__host__ __device__ __forceinline__ void stage_rc(int b, int& R, int& C) { const int st = b / 1024, sb = b % 1024, swz = sb ^ (((sb >> 9) & 1) << 5); R = (st >> 1) * 16 + swz / 64; C = (st & 1) * 32 + (swz % 64) / 2; }
__host__ __device__ __forceinline__ int perm32(int rho) { const int n = rho >> 4, i = rho & 15; return 8 * (i >> 2) + 4 * n + (i & 3); }

struct Unit { int pm, pn; };
struct Gemm { const bf16_t* A; const bf16_t* Bt; int M, N, K, lda; };

struct StaticOrder {
    int nM, nN, nwg, G, c;
    __host__ __device__ void init(int M, int N, int G_, int c_) { nM = M / BM; nN = N / BM; nwg = nM * nN; G = G_; c = c_; }
    __host__ __device__ bool next(int i, Unit& u) const {
        const long L = (long)i * G + c; if (L >= nwg) return false;
        int wgid = (int)L; { const int q = nwg / NXCD, r = nwg % NXCD, xcd = wgid % NXCD, off = wgid / NXCD; wgid = (xcd < r ? xcd * (q + 1) : r * (q + 1) + (xcd - r) * q) + off; }
        const int nig = WGM * nN, gid = wgid / nig, fm = gid * WGM, gsz = (nM - fm) < WGM ? (nM - fm) : WGM;
        u.pm = fm + ((wgid % nig) % gsz); u.pn = (wgid % nig) / gsz; return true;
    }
};

template <class Epi>
__device__ __forceinline__ void gemm_phase(LAS unsigned char* lds, const Gemm g, const StaticOrder& S, const Epi& E, int stag = 0) {
    if (stag > 0) {
        const unsigned long long t0_ = __builtin_amdgcn_s_memrealtime(); const unsigned long long w_ = (unsigned long long)(((blockIdx.x >> 3) & 3) * stag);
        while (__builtin_amdgcn_s_memrealtime() - t0_ < w_) __builtin_amdgcn_s_sleep(8);
    }
    int tid_ = threadIdx.x; asm volatile("" : "+v"(tid_));
    const int tid = tid_, wid = __builtin_amdgcn_readfirstlane(tid >> 6), lane = tid & 63, wr = wid >> 2, wc = wid & 3, fr = lane & 15, fq = lane >> 4;
    const int K = g.K, nt = K / BK, lda = g.lda;
    unsigned voffA[2], voffB[2];
#pragma unroll
    for (int i = 0; i < 2; ++i) { int R, C; stage_rc(tid * 16 + i * 8192, R, C); const int Rb = (R & ~31) + perm32(R & 31);
        voffA[i] = (unsigned)(R * lda + C) * 2u; voffB[i] = (unsigned)(Rb * K + C) * 2u; }
    const size_t kstep = (size_t)(BK * 2);
    const size_t hstepA = (size_t)HALF * lda * 2, hstepB = (size_t)HALF * K * 2;
    const size_t tstepA = 2 * hstepA, tstepB = 2 * hstepB;
    const unsigned ldsw = (unsigned)wid * 1024u;
    const int aoff = lds_byte(wr * 64 + fr, fq * 8), boff = lds_byte(wc * 32 + fr, fq * 8);
#define PG8_SA(b, h) (((b) * 2 + (h)) * HTB)
#define PG8_SB(b, h) ((4 + (b) * 2 + (h)) * HTB)
#define PG8_STAGE(bufoff, gbase, voff) do { _Pragma("unroll") for (int _i = 0; _i < 2; ++_i) \
        { unsigned vo_ = (voff)[_i]; asm volatile("" : "+v"(vo_)); __builtin_amdgcn_global_load_lds((const unsigned*)((const char*)(gbase) + vo_), (LAS unsigned*)(lds + (bufoff) + ldsw + _i * 8192), 16, 0, 0); } } while (0)
#define PG8_LDA(dst, b, h) do { _Pragma("unroll") for (int m = 0; m < 4; ++m) _Pragma("unroll") for (int k = 0; k < 2; ++k) dst[m][k] = *(const LAS bf16x8*)(lds + PG8_SA(b, h) + aoff + m * 2048 + k * 1024); } while (0)
#define PG8_LDB(dst, b, h) do { _Pragma("unroll") for (int n = 0; n < 2; ++n) _Pragma("unroll") for (int k = 0; k < 2; ++k) dst[n][k] = *(const LAS bf16x8*)(lds + PG8_SB(b, h) + boff + n * 2048 + k * 1024); } while (0)
#define PG8_MMA(ai, bj, At, Bt) do { __builtin_amdgcn_s_setprio(1); _Pragma("unroll") for (int m = 0; m < 4; ++m) _Pragma("unroll") for (int n = 0; n < 2; ++n) _Pragma("unroll") for (int k = 0; k < 2; ++k) \
        acc[ai][bj][m][n] = __builtin_amdgcn_mfma_f32_16x16x32_bf16(Bt[n][k], At[m][k], acc[ai][bj][m][n], 0, 0, 0); __builtin_amdgcn_s_setprio(0); } while (0)
#define PG8_WAIT_V(n) asm volatile("s_waitcnt vmcnt(" #n ")" ::: "memory")
#define PG8_WAIT_L(n) asm volatile("s_waitcnt lgkmcnt(" #n ")" ::: "memory")
#define PG8_BAR __builtin_amdgcn_s_barrier()
#define PG8_SCHED __builtin_amdgcn_sched_barrier(0)
    Unit cur, nxt; int ui = 0;
    if (!S.next(0, cur)) return;
    f32x4 acc[2][2][4][2];
#pragma unroll
    for (int a = 0; a < 2; ++a)
#pragma unroll
        for (int b = 0; b < 2; ++b)
#pragma unroll
            for (int m = 0; m < 4; ++m)
#pragma unroll
                for (int n = 0; n < 2; ++n) acc[a][b][m][n] = (f32x4){0.f, 0.f, 0.f, 0.f};
    bf16x8 At[4][2], B0[2][2], B1[2][2];
    const char* cA = (const char*)g.A + (size_t)cur.pm * tstepA; const char* cB = (const char*)g.Bt + (size_t)cur.pn * tstepB;
    PG8_STAGE(PG8_SB(0, 0), cB, voffB); PG8_STAGE(PG8_SB(0, 1), cB + hstepB, voffB); PG8_STAGE(PG8_SA(0, 0), cA, voffA); PG8_STAGE(PG8_SA(0, 1), cA + hstepA, voffA);
    if (wr == 1) PG8_BAR;
    PG8_WAIT_V(2); PG8_BAR;
    PG8_STAGE(PG8_SB(1, 0), cB + kstep, voffB); PG8_STAGE(PG8_SA(1, 0), cA + kstep, voffA); PG8_STAGE(PG8_SB(1, 1), cB + hstepB + kstep, voffB);
    PG8_WAIT_V(6); PG8_BAR;
    for (;;) {
        const bool has_next = S.next(ui + 1, nxt);
        const char* nA = has_next ? (const char*)g.A + (size_t)nxt.pm * tstepA : cA; const char* nB = has_next ? (const char*)g.Bt + (size_t)nxt.pn * tstepB : cB;
#pragma unroll 1
        for (int t = 0; t < nt; t += 2) {
            const bool last = (t == nt - 2);
            const char* a1 = cA + (size_t)(t + 1) * kstep;
            const char* a2 = last ? nA : cA + (size_t)(t + 2) * kstep; const char* b2 = last ? nB : cB + (size_t)(t + 2) * kstep;
            const char* a3 = a2 + kstep; const char* b3 = b2 + kstep;
            PG8_LDB(B0, 0, 0); PG8_LDB(B1, 0, 1); PG8_SCHED; PG8_LDA(At, 0, 0); PG8_STAGE(PG8_SA(1, 1), a1 + hstepA, voffA);
            PG8_WAIT_V(8); PG8_WAIT_L(0); PG8_BAR; PG8_MMA(0, 0, At, B0); PG8_MMA(0, 1, At, B1); PG8_BAR; PG8_SCHED;
            PG8_LDA(At, 0, 1); PG8_STAGE(PG8_SB(0, 0), b2, voffB); PG8_STAGE(PG8_SB(0, 1), b2 + hstepB, voffB); PG8_STAGE(PG8_SA(0, 0), a2, voffA);
            PG8_WAIT_V(8); PG8_WAIT_L(0); PG8_BAR; PG8_MMA(1, 0, At, B0); PG8_MMA(1, 1, At, B1); PG8_BAR; PG8_SCHED;
            PG8_LDB(B0, 1, 0); PG8_LDB(B1, 1, 1); PG8_SCHED; PG8_LDA(At, 1, 0); PG8_STAGE(PG8_SA(0, 1), a2 + hstepA, voffA);
            PG8_WAIT_V(8); PG8_WAIT_L(0); PG8_BAR; PG8_MMA(0, 0, At, B0); PG8_MMA(0, 1, At, B1); PG8_BAR; PG8_SCHED;
            PG8_LDA(At, 1, 1); PG8_STAGE(PG8_SB(1, 0), b3, voffB); PG8_STAGE(PG8_SB(1, 1), b3 + hstepB, voffB); PG8_STAGE(PG8_SA(1, 0), a3, voffA);
            PG8_WAIT_V(8); PG8_WAIT_L(0); PG8_BAR; PG8_MMA(1, 0, At, B0); PG8_MMA(1, 1, At, B1); PG8_BAR; PG8_SCHED;
        }
        if (wr == 0) PG8_BAR;
        E(acc, cur, wr, wc, fr, fq);
        if (!has_next) break;
#pragma unroll
        for (int a = 0; a < 2; ++a)
#pragma unroll
            for (int b = 0; b < 2; ++b)
#pragma unroll
                for (int m = 0; m < 4; ++m)
#pragma unroll
                    for (int n = 0; n < 2; ++n) acc[a][b][m][n] = (f32x4){0.f, 0.f, 0.f, 0.f};
        cur = nxt; cA = nA; cB = nB; ++ui;
        if (wr == 1) PG8_BAR;
    }
    PG8_WAIT_V(0);
    PG8_BAR;
}
template <class Epi1, class Epi2>
__device__ __forceinline__ void gemm_phase_pair(LAS unsigned char* lds, const Gemm g, const Gemm g2, const StaticOrder& S, const Epi1& E, const Epi2& E2) {
    const int stag = 0;
    if (stag > 0) {
        const unsigned long long t0_ = __builtin_amdgcn_s_memrealtime(); const unsigned long long w_ = (unsigned long long)(((blockIdx.x >> 3) & 3) * stag);
        while (__builtin_amdgcn_s_memrealtime() - t0_ < w_) __builtin_amdgcn_s_sleep(8);
    }
    int tid_ = threadIdx.x; asm volatile("" : "+v"(tid_));
    const int tid = tid_, wid = __builtin_amdgcn_readfirstlane(tid >> 6), lane = tid & 63, wr = wid >> 2, wc = wid & 3, fr = lane & 15, fq = lane >> 4;
    const int K = g.K, nt = K / BK, lda = g.lda;
    unsigned voffA[2], voffB[2];
#pragma unroll
    for (int i = 0; i < 2; ++i) { int R, C; stage_rc(tid * 16 + i * 8192, R, C); const int Rb = (R & ~31) + perm32(R & 31);
        voffA[i] = (unsigned)(R * lda + C) * 2u; voffB[i] = (unsigned)(Rb * K + C) * 2u; }
    const size_t kstep = (size_t)(BK * 2);
    const size_t hstepA = (size_t)HALF * lda * 2, hstepB = (size_t)HALF * K * 2;
    const size_t tstepA = 2 * hstepA, tstepB = 2 * hstepB;
    const unsigned ldsw = (unsigned)wid * 1024u;
    const int aoff = lds_byte(wr * 64 + fr, fq * 8), boff = lds_byte(wc * 32 + fr, fq * 8);
#define PG8_SA(b, h) (((b) * 2 + (h)) * HTB)
#define PG8_SB(b, h) ((4 + (b) * 2 + (h)) * HTB)
#define PG8_STAGE(bufoff, gbase, voff) do { _Pragma("unroll") for (int _i = 0; _i < 2; ++_i) \
        { unsigned vo_ = (voff)[_i]; asm volatile("" : "+v"(vo_)); __builtin_amdgcn_global_load_lds((const unsigned*)((const char*)(gbase) + vo_), (LAS unsigned*)(lds + (bufoff) + ldsw + _i * 8192), 16, 0, 0); } } while (0)
#define PG8_LDA(dst, b, h) do { _Pragma("unroll") for (int m = 0; m < 4; ++m) _Pragma("unroll") for (int k = 0; k < 2; ++k) dst[m][k] = *(const LAS bf16x8*)(lds + PG8_SA(b, h) + aoff + m * 2048 + k * 1024); } while (0)
#define PG8_LDB(dst, b, h) do { _Pragma("unroll") for (int n = 0; n < 2; ++n) _Pragma("unroll") for (int k = 0; k < 2; ++k) dst[n][k] = *(const LAS bf16x8*)(lds + PG8_SB(b, h) + boff + n * 2048 + k * 1024); } while (0)
#define PG8_MMA(ai, bj, At, Bt) do { __builtin_amdgcn_s_setprio(1); _Pragma("unroll") for (int m = 0; m < 4; ++m) _Pragma("unroll") for (int n = 0; n < 2; ++n) _Pragma("unroll") for (int k = 0; k < 2; ++k) \
        acc[ai][bj][m][n] = __builtin_amdgcn_mfma_f32_16x16x32_bf16(Bt[n][k], At[m][k], acc[ai][bj][m][n], 0, 0, 0); __builtin_amdgcn_s_setprio(0); } while (0)
#define PG8_WAIT_V(n) asm volatile("s_waitcnt vmcnt(" #n ")" ::: "memory")
#define PG8_WAIT_L(n) asm volatile("s_waitcnt lgkmcnt(" #n ")" ::: "memory")
#define PG8_BAR __builtin_amdgcn_s_barrier()
#define PG8_SCHED __builtin_amdgcn_sched_barrier(0)
    Unit cur, nxt; int ui = 0;
    if (!S.next(0, cur)) return;
    int which = 0;
    f32x4 acc[2][2][4][2];
#pragma unroll
    for (int a = 0; a < 2; ++a)
#pragma unroll
        for (int b = 0; b < 2; ++b)
#pragma unroll
            for (int m = 0; m < 4; ++m)
#pragma unroll
                for (int n = 0; n < 2; ++n) acc[a][b][m][n] = (f32x4){0.f, 0.f, 0.f, 0.f};
    bf16x8 At[4][2], B0[2][2], B1[2][2];
    const char* cA = (const char*)g.A + (size_t)cur.pm * tstepA; const char* cB = (const char*)g.Bt + (size_t)cur.pn * tstepB;
    PG8_STAGE(PG8_SB(0, 0), cB, voffB); PG8_STAGE(PG8_SB(0, 1), cB + hstepB, voffB); PG8_STAGE(PG8_SA(0, 0), cA, voffA); PG8_STAGE(PG8_SA(0, 1), cA + hstepA, voffA);
    if (wr == 1) PG8_BAR;
    PG8_WAIT_V(2); PG8_BAR;
    PG8_STAGE(PG8_SB(1, 0), cB + kstep, voffB); PG8_STAGE(PG8_SA(1, 0), cA + kstep, voffA); PG8_STAGE(PG8_SB(1, 1), cB + hstepB + kstep, voffB);
    PG8_WAIT_V(6); PG8_BAR;
    for (;;) {
        const int nwhich = which ^ 1;
        bool has_next = true; if (which == 0) nxt = cur; else has_next = S.next((ui >> 1) + 1, nxt);
        const char* nA = has_next ? (const char*)(nwhich ? g2.A : g.A) + (size_t)nxt.pm * tstepA : cA; const char* nB = has_next ? (const char*)(nwhich ? g2.Bt : g.Bt) + (size_t)nxt.pn * tstepB : cB;
#pragma unroll 1
        for (int t = 0; t < nt; t += 2) {
            const bool last = (t == nt - 2);
            const char* a1 = cA + (size_t)(t + 1) * kstep;
            const char* a2 = last ? nA : cA + (size_t)(t + 2) * kstep; const char* b2 = last ? nB : cB + (size_t)(t + 2) * kstep;
            const char* a3 = a2 + kstep; const char* b3 = b2 + kstep;
            PG8_LDB(B0, 0, 0); PG8_LDB(B1, 0, 1); PG8_SCHED; PG8_LDA(At, 0, 0); PG8_STAGE(PG8_SA(1, 1), a1 + hstepA, voffA);
            PG8_WAIT_V(8); PG8_WAIT_L(0); PG8_BAR; PG8_MMA(0, 0, At, B0); PG8_MMA(0, 1, At, B1); PG8_BAR; PG8_SCHED;
            PG8_LDA(At, 0, 1); PG8_STAGE(PG8_SB(0, 0), b2, voffB); PG8_STAGE(PG8_SB(0, 1), b2 + hstepB, voffB); PG8_STAGE(PG8_SA(0, 0), a2, voffA);
            PG8_WAIT_V(8); PG8_WAIT_L(0); PG8_BAR; PG8_MMA(1, 0, At, B0); PG8_MMA(1, 1, At, B1); PG8_BAR; PG8_SCHED;
            PG8_LDB(B0, 1, 0); PG8_LDB(B1, 1, 1); PG8_SCHED; PG8_LDA(At, 1, 0); PG8_STAGE(PG8_SA(0, 1), a2 + hstepA, voffA);
            PG8_WAIT_V(8); PG8_WAIT_L(0); PG8_BAR; PG8_MMA(0, 0, At, B0); PG8_MMA(0, 1, At, B1); PG8_BAR; PG8_SCHED;
            PG8_LDA(At, 1, 1); PG8_STAGE(PG8_SB(1, 0), b3, voffB); PG8_STAGE(PG8_SB(1, 1), b3 + hstepB, voffB); PG8_STAGE(PG8_SA(1, 0), a3, voffA);
            PG8_WAIT_V(8); PG8_WAIT_L(0); PG8_BAR; PG8_MMA(1, 0, At, B0); PG8_MMA(1, 1, At, B1); PG8_BAR; PG8_SCHED;
        }
        if (wr == 0) PG8_BAR;
        if (which) E2(acc, cur, wr, wc, fr, fq); else E(acc, cur, wr, wc, fr, fq);
        if (!has_next) break;
#pragma unroll
        for (int a = 0; a < 2; ++a)
#pragma unroll
            for (int b = 0; b < 2; ++b)
#pragma unroll
                for (int m = 0; m < 4; ++m)
#pragma unroll
                    for (int n = 0; n < 2; ++n) acc[a][b][m][n] = (f32x4){0.f, 0.f, 0.f, 0.f};
        cur = nxt; cA = nA; cB = nB; ++ui; which = nwhich;
        if (wr == 1) PG8_BAR;
    }
    PG8_WAIT_V(0);
    PG8_BAR;
#undef PG8_SA
#undef PG8_SB
#undef PG8_STAGE
#undef PG8_LDA
#undef PG8_LDB
#undef PG8_MMA
#undef PG8_WAIT_V
#undef PG8_WAIT_L
#undef PG8_BAR
#undef PG8_SCHED
}
}

typedef f32x4 Acc[2][2][4][2];
__device__ __forceinline__ bool epi_fence() { asm volatile("" ::: "memory"); return true; }
#define EPI_ROWS(u, wr, fr) const int row0_ = (u).pm * 256 + (wr) * 64 + (fr);
#define EPI_LOADV(v) float v[8]; { const f32x4 a0_ = acc[ai][bj][m][0], a1_ = acc[ai][bj][m][1]; v[0] = a0_[0]; v[1] = a0_[1]; v[2] = a0_[2]; v[3] = a0_[3]; v[4] = a1_[0]; v[5] = a1_[1]; v[6] = a1_[2]; v[7] = a1_[3]; }
constexpr int RTAB_OFF = 131072;
template <int NSLOT>
__device__ __forceinline__ void fill_rtab(LAS unsigned char* lds, const float* ss, int pm, float inv_n, float mul) {
    int tid_ = threadIdx.x; asm volatile("" : "+v"(tid_));
    if (tid_ < 256) { const float* s = ss + ((size_t)pm * 256 + tid_) * NSLOT; const float t = NSLOT == 16 ? sum16(s) : sum4(s);
        ((LAS float*)(lds + RTAB_OFF))[tid_] = rsqrtf(t * inv_n + EPS) * mul; }
    asm volatile("s_waitcnt lgkmcnt(0)" ::: "memory"); __builtin_amdgcn_s_barrier(); asm volatile("" ::: "memory");
}
#define RTAB(ai, m) (((const LAS float*)(lds + RTAB_OFF))[(ai) * 128 + wr * 64 + (m) * 16 + fr])

struct EpiZ {
    bf16_t* Z; const float* ssx; float* ssq; float* sskv; const int* pos; LAS unsigned char* lds;
    __device__ __forceinline__ void operator()(const Acc& acc, const pg8::Unit& u, int wr, int wc, int fr, int fq) const {
        EPI_ROWS(u, wr, fr)
        fill_rtab<16>(lds, ssx, u.pm, 1.f / 1024.f, 1.f);
        const int pn = u.pn;
        const int cbase = pn * 256 + wc * 32 + 8 * fq;
#pragma unroll
        for (int ai = 0; ai < 2; ++ai)
#pragma unroll
        for (int m = 0; m < 4; ++m) {
            const int row = row0_ + ai * 128 + m * 16;
            const float rstd = RTAB(ai, m);
            bf16_t* zr = Z + (size_t)row * ZW + cbase;
            float st = 0.f; u32x4 gq8 = (u32x4){0u, 0u, 0u, 0u};
#pragma unroll
            for (int bj = 0; bj < 2; ++bj) {
                EPI_LOADV(v)
#pragma unroll
                for (int j = 0; j < 8; ++j) v[j] *= rstd;
                bool store = true;
                if (pn <= 1) {
#pragma unroll
                    for (int j = 0; j < 8; ++j) v[j] *= (0.125f * LOG2E);
                } else if (pn == 3 || pn == 4 || pn == 7 || pn == 8) {
#pragma unroll
                    for (int j = 0; j < 8; ++j) v[j] = fsilu(v[j]);
                } else if (pn >= 9) {
#pragma unroll
                    for (int j = 0; j < 8; ++j) v[j] = fsigmoid(v[j]);
                } else if (pn == 5) {
#pragma unroll
                    for (int j = 0; j < 8; ++j) st += v[j] * v[j];
                } else if (pn == 6) {
                    if (bj == 0) {
#pragma unroll
                        for (int j = 0; j < 8; ++j) st += v[j] * v[j];
                    } else {
                        if (wc == 0) rope8(v, 4 * fq, (float)pos[row]); else store = false;
                    }
                }
                if (pn >= 9) {
                    u32x2 q8;
                    q8.x = (unsigned)(v[0] * 255.f + 0.5f) | ((unsigned)(v[1] * 255.f + 0.5f) << 8) | ((unsigned)(v[2] * 255.f + 0.5f) << 16) | ((unsigned)(v[3] * 255.f + 0.5f) << 24);
                    q8.y = (unsigned)(v[4] * 255.f + 0.5f) | ((unsigned)(v[5] * 255.f + 0.5f) << 8) | ((unsigned)(v[6] * 255.f + 0.5f) << 16) | ((unsigned)(v[7] * 255.f + 0.5f) << 24);
                    if (bj == 0) { gq8.x = q8.x; gq8.y = q8.y; } else { gq8.z = q8.x; gq8.w = q8.y; }
                } else if (store) *(u32x4*)(zr + bj * 128) = pack8(v);
            }
            if (pn >= 9) *(u32x4*)((unsigned char*)(Z + (size_t)row * ZW + ZC_MA) + (pn - 9) * 256 + (wc * 32 + 8 * fq) * 2) = gq8;
            if (pn == 5 || pn == 6) {
                st += __shfl_xor(st, 16); st += __shfl_xor(st, 32);
                if (fq == 0) { if (pn == 5) ssq[(size_t)row * 4 + wc] = st; else sskv[(size_t)row * 4 + wc] = st; }
            }
        }
    }
};
struct EpiQB {
    bf16_t* QB; const float* ssq; const int* pos; LAS unsigned char* lds;
    __device__ __forceinline__ void operator()(const Acc& acc, const pg8::Unit& u, int wr, int wc, int fr, int fq) const {
        EPI_ROWS(u, wr, fr)
        fill_rtab<4>(lds, ssq, u.pm, 1.f / 256.f, 0.10206207261596577f * LOG2E);
        const int cbase = u.pn * 256 + wc * 32 + 8 * fq;
        const int c0 = cbase, c1 = cbase + 128, cc0 = c0 % 96, cc1 = c1 % 96;
        const bool anyrope = (cc0 >= 64) || (cc1 >= 64);
#pragma unroll
        for (int ai = 0; ai < 2; ++ai)
#pragma unroll
        for (int m = 0; m < 4; ++m) {
            const int row = row0_ + ai * 128 + m * 16;
            epi_fence();
            const float rstd = RTAB(ai, m);
            float posf = 0.f; if (anyrope) posf = (float)pos[row];
#pragma unroll
            for (int bj = 0; bj < 2; ++bj) {
                EPI_LOADV(v)
#pragma unroll
                for (int j = 0; j < 8; ++j) v[j] *= rstd;
                const int cc = bj ? cc1 : cc0;
                if (cc >= 64) rope8(v, (cc - 64) >> 1, posf);
                *(u32x4*)(QB + (size_t)row * 768 + cbase + bj * 128) = pack8(v);
            }
        }
    }
};
struct EpiKVB {
    bf16_t* KVB; const float* sskv; LAS unsigned char* lds;
    __device__ __forceinline__ void operator()(const Acc& acc, const pg8::Unit& u, int wr, int wc, int fr, int fq) const {
        EPI_ROWS(u, wr, fr)
        fill_rtab<4>(lds, sskv, u.pm, 1.f / 128.f, 1.f);
        const int cbase = u.pn * 256 + wc * 32 + 8 * fq;
#pragma unroll
        for (int ai = 0; ai < 2; ++ai)
#pragma unroll
        for (int m = 0; m < 4; ++m) {
            const int row = row0_ + ai * 128 + m * 16;
            const float rstd = RTAB(ai, m);
#pragma unroll
            for (int bj = 0; bj < 2; ++bj) {
                EPI_LOADV(v)
#pragma unroll
                for (int j = 0; j < 8; ++j) v[j] *= rstd;
                *(u32x4*)(KVB + (size_t)row * 1024 + cbase + bj * 128) = pack8(v);
            }
        }
    }
};
template <int SECOND> struct EpiMerge {
    bf16_t* Z; bf16_t* Y;
    __device__ __forceinline__ void operator()(const Acc& acc, const pg8::Unit& u, int wr, int wc, int fr, int fq) const {
        EPI_ROWS(u, wr, fr)
        const int cbase = u.pn * 256 + wc * 32 + 8 * fq;
#pragma unroll
        for (int ai = 0; ai < 2; ++ai) {
            epi_fence();
            u32x4 sgq[4]; u32x4 tg[4][2];
#pragma unroll
            for (int m = 0; m < 4; ++m) { const bf16_t* zr = Z + (size_t)(row0_ + ai * 128 + m * 16) * ZW;
                sgq[m] = *(const u32x4*)((const unsigned char*)(zr + ZC_MA) + (SECOND ? 1024 : 0) + u.pn * 256 + (wc * 32 + 8 * fq) * 2);
#pragma unroll
                for (int bj = 0; bj < 2; ++bj) { if (SECOND) tg[m][bj] = *(const u32x4*)(zr + ZC_MB + cbase + bj * 128); } }
#pragma unroll
            for (int m = 0; m < 4; ++m)
#pragma unroll
                for (int bj = 0; bj < 2; ++bj) {
                    EPI_LOADV(v)
                    const unsigned g0 = bj ? sgq[m].z : sgq[m].x, g1 = bj ? sgq[m].w : sgq[m].y;
                    const float s[8] = {(float)(g0 & 255u), (float)((g0 >> 8) & 255u), (float)((g0 >> 16) & 255u), (float)(g0 >> 24), (float)(g1 & 255u), (float)((g1 >> 8) & 255u), (float)((g1 >> 16) & 255u), (float)(g1 >> 24)};
#pragma unroll
                    for (int j = 0; j < 8; ++j) v[j] *= s[j] * (1.f / 255.f);
                    if (SECOND) { float t[8]; unpack8(tg[m][bj], t);
#pragma unroll
                        for (int j = 0; j < 8; ++j) v[j] += t[j];
                        *(u32x4*)(Y + (size_t)(row0_ + ai * 128 + m * 16) * 1024 + cbase + bj * 128) = pack8(v); }
                    else *(u32x4*)(Z + (size_t)(row0_ + ai * 128 + m * 16) * ZW + ZC_MB + cbase + bj * 128) = pack8(v);
                }
        }
    }
};
template <int BF> struct EpiX1 {
    const float* xin; const bf16_t* xinb; bf16_t* Z; float* ssb;
    __device__ __forceinline__ void operator()(const Acc& acc, const pg8::Unit& u, int wr, int wc, int fr, int fq) const {
        EPI_ROWS(u, wr, fr)
        const int cbase = u.pn * 256 + wc * 32 + 8 * fq;
#pragma unroll
        for (int ai = 0; ai < 2; ++ai) {
            epi_fence();
            float stv[4];
            f32x4 xa[4][2][2]; u32x4 xh[4][2];
#pragma unroll
            for (int m = 0; m < 4; ++m)
#pragma unroll
                for (int bj = 0; bj < 2; ++bj) { const size_t o_ = (size_t)(row0_ + ai * 128 + m * 16) * D + cbase + bj * 128;
                    if (BF) xh[m][bj] = *(const u32x4*)(xinb + o_); else { xa[m][bj][0] = *(const f32x4*)(xin + o_); xa[m][bj][1] = *(const f32x4*)(xin + o_ + 4); } }
#pragma unroll
            for (int m = 0; m < 4; ++m) {
                const int row = row0_ + ai * 128 + m * 16;
                float st = 0.f;
#pragma unroll
                for (int bj = 0; bj < 2; ++bj) {
                    EPI_LOADV(v)
                    if (BF) { float xv[8]; unpack8(xh[m][bj], xv);
#pragma unroll
                        for (int j = 0; j < 8; ++j) v[j] += xv[j]; }
                    else { const f32x4 x0 = xa[m][bj][0], x1 = xa[m][bj][1];
                        v[0] += x0[0]; v[1] += x0[1]; v[2] += x0[2]; v[3] += x0[3]; v[4] += x1[0]; v[5] += x1[1]; v[6] += x1[2]; v[7] += x1[3]; }
#pragma unroll
                    for (int j = 0; j < 8; ++j) st += v[j] * v[j];
                    *(u32x4*)(Z + (size_t)row * ZW + ZC_X1B + cbase + bj * 128) = pack8(v);
                }
                st += __shfl_xor(st, 16); st += __shfl_xor(st, 32);
                stv[m] = st;
            }
            ssb[(size_t)(row0_ + ai * 128 + fq * 16) * 16 + u.pn * 4 + wc] = (fq == 0 ? stv[0] : fq == 1 ? stv[1] : fq == 2 ? stv[2] : stv[3]);
        }
    }
};
struct EpiPP {
    bf16_t* Z;
    __device__ __forceinline__ void operator()(const Acc& acc, const pg8::Unit& u, int wr, int wc, int fr, int fq) const {
        EPI_ROWS(u, wr, fr)
        const int cbase = u.pn * 256 + wc * 32 + 8 * fq;
#pragma unroll
        for (int ai = 0; ai < 2; ++ai)
#pragma unroll
        for (int m = 0; m < 4; ++m) {
            const int row = row0_ + ai * 128 + m * 16;
#pragma unroll
            for (int bj = 0; bj < 2; ++bj) { EPI_LOADV(v) *(u32x4*)(Z + (size_t)row * ZW + ZC_T2 + cbase + bj * 128) = pack8(v); }
        }
    }
};
struct EpiX2 {
    float* xio; const bf16_t* Z; bf16_t* xb; const float* ssb; float* ssa; LAS unsigned char* lds; bool write_xb;
    __device__ __forceinline__ void operator()(const Acc& acc, const pg8::Unit& u, int wr, int wc, int fr, int fq) const {
        EPI_ROWS(u, wr, fr)
        fill_rtab<16>(lds, ssb, u.pm, 1.f / 1024.f, 1.f);
        const int cbase = u.pn * 256 + wc * 32 + 8 * fq;
#pragma unroll
        for (int ai = 0; ai < 2; ++ai) {
        float stv[4];
#pragma unroll
        for (int mp = 0; mp < 2; ++mp) {
            epi_fence();
            u32x4 xa[2][2], tg[2][2];
#pragma unroll
            for (int mm = 0; mm < 2; ++mm)
#pragma unroll
                for (int bj = 0; bj < 2; ++bj) { const int row = row0_ + ai * 128 + (mp * 2 + mm) * 16; const bf16_t* zp = Z + (size_t)row * ZW + cbase + bj * 128;
                    xa[mm][bj] = *(const u32x4*)(zp + ZC_X1B); tg[mm][bj] = *(const u32x4*)(zp + ZC_T2); }
#pragma unroll
            for (int mm = 0; mm < 2; ++mm) {
                const int m = mp * 2 + mm;
                const int row = row0_ + ai * 128 + m * 16;
                const float rstd = RTAB(ai, m);
                float st = 0.f;
#pragma unroll
                for (int bj = 0; bj < 2; ++bj) {
                    EPI_LOADV(v)
                    const size_t off = (size_t)row * D + cbase + bj * 128;
                    float t[8]; unpack8(tg[mm][bj], t);
                    float xv[8]; unpack8(xa[mm][bj], xv);
#pragma unroll
                    for (int j = 0; j < 8; ++j) { v[j] = xv[j] + fsigmoid(v[j] * rstd) * t[j]; st += v[j] * v[j]; }
                    *(u32x4*)(xb + off) = pack8(v);
                }
                st += __shfl_xor(st, 16); st += __shfl_xor(st, 32);
                stv[m] = st;
            }
        }
        ssa[(size_t)(row0_ + ai * 128 + fq * 16) * 16 + u.pn * 4 + wc] = (fq == 0 ? stv[0] : fq == 1 ? stv[1] : fq == 2 ? stv[2] : stv[3]);
        }
    }
};


struct EpiX2F {
    float* out; const bf16_t* Z; const float* ssb; float* ssa; const float* gfin; unsigned* cnt; LAS unsigned char* lds;
    __device__ __forceinline__ void operator()(Acc& acc, const pg8::Unit& u, int wr, int wc, int fr, int fq) const {
        EPI_ROWS(u, wr, fr)
        fill_rtab<16>(lds, ssb, u.pm, 1.f / 1024.f, 1.f);
        const int cbase = u.pn * 256 + wc * 32 + 8 * fq;
#pragma unroll
        for (int ai = 0; ai < 2; ++ai) {
        float stv[4];
#pragma unroll
        for (int mp = 0; mp < 2; ++mp) {
            epi_fence();
            u32x4 xa[2][2], tg[2][2];
#pragma unroll
            for (int mm = 0; mm < 2; ++mm)
#pragma unroll
                for (int bj = 0; bj < 2; ++bj) { const int row = row0_ + ai * 128 + (mp * 2 + mm) * 16; const bf16_t* zp = Z + (size_t)row * ZW + cbase + bj * 128;
                    xa[mm][bj] = *(const u32x4*)(zp + ZC_X1B); tg[mm][bj] = *(const u32x4*)(zp + ZC_T2); }
#pragma unroll
            for (int mm = 0; mm < 2; ++mm) {
                const int m = mp * 2 + mm;
                const int row = row0_ + ai * 128 + m * 16;
                const float rstd = RTAB(ai, m);
                float st = 0.f;
#pragma unroll
                for (int bj = 0; bj < 2; ++bj) {
                    EPI_LOADV(v)
                    float t[8]; unpack8(tg[mm][bj], t);
                    float xv[8]; unpack8(xa[mm][bj], xv);
#pragma unroll
                    for (int j = 0; j < 8; ++j) { v[j] = xv[j] + fsigmoid(v[j] * rstd) * t[j]; st += v[j] * v[j]; }
                    acc[ai][bj][m][0] = (f32x4){v[0], v[1], v[2], v[3]}; acc[ai][bj][m][1] = (f32x4){v[4], v[5], v[6], v[7]};
                }
                st += __shfl_xor(st, 16); st += __shfl_xor(st, 32);
                stv[m] = st;
            }
        }
        __hip_atomic_store(ssa + (size_t)(row0_ + ai * 128 + fq * 16) * 16 + u.pn * 4 + wc, (fq == 0 ? stv[0] : fq == 1 ? stv[1] : fq == 2 ? stv[2] : stv[3]), __ATOMIC_RELAXED, __HIP_MEMORY_SCOPE_AGENT);
        }
        asm volatile("s_waitcnt vmcnt(0)" ::: "memory"); __builtin_amdgcn_s_barrier(); asm volatile("" ::: "memory");
        int tid_ = threadIdx.x; asm volatile("" : "+v"(tid_));
        if (tid_ == 0) {
            __hip_atomic_fetch_add(cnt + u.pm, 1u, __ATOMIC_RELAXED, __HIP_MEMORY_SCOPE_AGENT);
            unsigned sp = 0; while (__hip_atomic_load(cnt + u.pm, __ATOMIC_RELAXED, __HIP_MEMORY_SCOPE_AGENT) < 4u && ++sp < (1u << 22)) __builtin_amdgcn_s_sleep(1);
            __builtin_amdgcn_fence(__ATOMIC_ACQUIRE, "agent"); asm volatile("s_waitcnt vmcnt(0)" ::: "memory");
        }
        asm volatile("s_waitcnt vmcnt(0) lgkmcnt(0)" ::: "memory"); __builtin_amdgcn_s_barrier(); asm volatile("" ::: "memory");
        if (tid_ < 256) { const float* sp_ = ssa + ((size_t)u.pm * 256 + tid_) * 16; float t = 0.f;
#pragma unroll
            for (int k = 0; k < 16; ++k) t += __hip_atomic_load(sp_ + k, __ATOMIC_RELAXED, __HIP_MEMORY_SCOPE_AGENT);
            ((LAS float*)(lds + RTAB_OFF))[tid_] = rsqrtf(t * (1.f / 1024.f) + EPS); }
        asm volatile("s_waitcnt lgkmcnt(0)" ::: "memory"); __builtin_amdgcn_s_barrier(); asm volatile("" ::: "memory");
        f32x4 gq[2][2];
#pragma unroll
        for (int bj = 0; bj < 2; ++bj) { gq[bj][0] = *(const f32x4*)(gfin + cbase + bj * 128); gq[bj][1] = *(const f32x4*)(gfin + cbase + bj * 128 + 4); }
#pragma unroll
        for (int ai = 0; ai < 2; ++ai)
#pragma unroll
        for (int m = 0; m < 4; ++m) {
            const int row = row0_ + ai * 128 + m * 16;
            const float r2 = RTAB(ai, m);
#pragma unroll
            for (int bj = 0; bj < 2; ++bj) { const size_t off = (size_t)row * D + cbase + bj * 128;
                *(f32x4*)(out + off) = acc[ai][bj][m][0] * r2 * gq[bj][0]; *(f32x4*)(out + off + 4) = acc[ai][bj][m][1] * r2 * gq[bj][1]; }
        }
    }
};

namespace att {
typedef short v4i16_t __attribute__((ext_vector_type(4)));
template <int MODE> struct Cfg { static constexpr int DQK = MODE == 0 ? 96 : 64, KROW = DQK + 8, KBUF = 64 * KROW * 2, VBUF = 8192, PBUF = 256, BUF = KBUF + VBUF + PBUF; };
#define MX3(a, b, c) __builtin_fmaxf(__builtin_fmaxf((a), (b)), (c))
__device__ __forceinline__ float rowmax32(const f32x16& p0, const f32x16& p1) {
    float a = MX3(p0[0], p0[1], p1[0]), b = MX3(p0[2], p0[3], p1[1]); a = MX3(a, p1[2], p1[3]);
#pragma unroll
    for (int r = 4; r < 16; r += 4) { a = MX3(a, p0[r], p0[r + 1]); b = MX3(b, p0[r + 2], p0[r + 3]); a = MX3(a, p1[r], p1[r + 1]); b = MX3(b, p1[r + 2], p1[r + 3]); }
    const float m = __builtin_fmaxf(a, b); auto rr = __builtin_amdgcn_permlane32_swap(__float_as_uint(m), __float_as_uint(m), false, false);
    return __builtin_fmaxf(__uint_as_float(rr[0]), __uint_as_float(rr[1])); }
__device__ __forceinline__ bf16x8 vfrag(const LAS unsigned char* p) {
    const v4i16_t lo = __builtin_amdgcn_ds_read_tr16_b64_v4i16((LAS v4i16_t*)p), hi = __builtin_amdgcn_ds_read_tr16_b64_v4i16((LAS v4i16_t*)(p + 512));
    return (bf16x8){lo[0], lo[1], lo[2], lo[3], hi[0], hi[1], hi[2], hi[3]}; }

template <int MODE>
__device__ __forceinline__ void attn_mode(LAS unsigned char* lds, const bf16_t* QB, const bf16_t* KVB, bf16_t* Z, const int* pos, const float* sink, int u_begin, int u_end, int u_step) {
    typedef Cfg<MODE> C;
    constexpr int DQK = C::DQK, KROW = C::KROW, NKS = DQK / 16;
    asm volatile("" : "+s"(u_begin));
    if (u_begin >= u_end) return;
    int tid_ = threadIdx.x; asm volatile("" : "+v"(tid_));
    const int tid = tid_, w = __builtin_amdgcn_readfirstlane(tid >> 6), lane = tid & 63, lq = lane & 31, hh = lane >> 5;
#define ATT_DECODE(u_, b_, hk_, qblk_) do { if (MODE == 0) { const int bh_ = (u_) & 255; qblk_ = 7 - ((u_) >> 8); b_ = bh_ >> 3; hk_ = bh_ & 7; } else { const int v_ = (u_) - 2048; b_ = v_ >> 6; hk_ = (v_ >> 5) & 1; qblk_ = v_ & 31; } } while (0)
#define ATT_GEOM(qblk_, hk_, wq0_, hq_, j0_) do { if (MODE == 0) { wq0_ = (qblk_) * 256 + 32 * w; hq_ = (hk_); j0_ = 0; } else { wq0_ = (qblk_) * 64 + 32 * (w >> 2); hq_ = (hk_) * 4 + (w & 3); j0_ = (qblk_) - 2; if (j0_ < 0) j0_ = 0; } } while (0)
#define ATT_QLOAD(tq_, hq_) do { _Pragma("unroll") for (int ks = 0; ks < NKS; ++ks) { \
        if (MODE == 0) qf[ks] = *(const bf16x8*)(QB + (tq_) * 768 + (hq_) * 96 + ks * 16 + hh * 8); \
        else qf[ks] = *(const bf16x8*)(Z + (tq_) * ZW + ZC_QA + (hq_) * 64 + ks * 16 + hh * 8); } } while (0)
    bf16x8 qf[NKS];
    u32x4 sk0, sk1, sv; int sp = 0;
    sk1 = (u32x4){0u, 0u, 0u, 0u};
    u32x4 nk0, nk1, nv; int np = 0;
    nk0 = nk1 = nv = (u32x4){0u, 0u, 0u, 0u};
    const int vkey = tid >> 3, vpart = tid & 7;
    const int vwr = (vpart >> 2) * 4096 + vkey * 64 + (vpart & 3) * 16;
    const int vrd = (4 * hh + ((lane & 15) >> 2)) * 64 + ((lane >> 4) & 1) * 32 + (lane & 3) * 8;
    const char *pk0 = nullptr, *pk1 = nullptr, *pvv = nullptr, *ppp = nullptr; unsigned inc0 = 0, inc1 = 0;
    int kst0, kst1;
    if (MODE == 0) { kst0 = ((tid / 12) * KROW + (tid % 12) * 8) * 2; kst1 = (((tid + 512) / 12) * KROW + ((tid + 512) % 12) * 8) * 2; }
    else { kst0 = (vkey * KROW + vpart * 8) * 2; kst1 = 0; }
#define ATT_SETUP(tok0, hk, j) do { const size_t kt = (tok0) + (size_t)(j) * 64; \
        if (MODE == 0) { { const int key = tid / 12, part = tid % 12; pk0 = (const char*)(part < 8 ? KVB + (kt + key) * 1024 + (hk) * 128 + part * 8 : Z + (kt + key) * ZW + ZC_KR + (part - 8) * 8); inc0 = part < 8 ? 64u * 1024u * 2u : 64u * ZW * 2u; } \
            { const int c2 = tid + 512, key = c2 / 12, part = c2 % 12; pk1 = (const char*)(part < 8 ? KVB + (kt + key) * 1024 + (hk) * 128 + part * 8 : Z + (kt + key) * ZW + ZC_KR + (part - 8) * 8); inc1 = part < 8 ? 64u * 1024u * 2u : 64u * ZW * 2u; } \
            pvv = (const char*)(KVB + (kt + vkey) * 1024 + (hk) * 128 + 64 + vpart * 8); } \
        else { pk0 = (const char*)(Z + (kt + vkey) * ZW + ZC_KA + (hk) * 64 + vpart * 8); pvv = (const char*)(Z + (kt + vkey) * ZW + ZC_VA + (hk) * 64 + vpart * 8); ppp = (const char*)(pos + kt + (tid & 63)); } } while (0)
#define ATT_LOADP(K0, K1, VV, PP) do { \
        if (MODE == 0) { K0 = *(const u32x4*)pk0; pk0 += inc0; if (tid < 256) { K1 = *(const u32x4*)pk1; pk1 += inc1; } VV = *(const u32x4*)pvv; pvv += 64 * 1024 * 2; } \
        else { K0 = *(const u32x4*)pk0; pk0 += 64 * ZW * 2; VV = *(const u32x4*)pvv; pvv += 64 * ZW * 2; if (tid < 64) PP = *(const int*)ppp; ppp += 256; } } while (0)
    { int b_, hk_, qblk_, wq0_, hq_, j0_; ATT_DECODE(u_begin, b_, hk_, qblk_); ATT_GEOM(qblk_, hk_, wq0_, hq_, j0_);
      const size_t tok0_ = (size_t)b_ * SEQ; ATT_QLOAD(tok0_ + wq0_ + lq, hq_); ATT_SETUP(tok0_, hk_, j0_); ATT_LOADP(sk0, sk1, sv, sp); }
    for (int u = u_begin; u < u_end; u += u_step) {
    int b, hk, qblk; ATT_DECODE(u, b, hk, qblk);
    const size_t tok0 = (size_t)b * SEQ;
    int wq0, hq, j0; ATT_GEOM(qblk, hk, wq0, hq, j0);
    const int q0 = MODE == 0 ? qblk * 256 : qblk * 64;
    const int qq = wq0 + lq;
    const size_t tq = tok0 + qq;
    const int j1 = MODE == 0 ? (q0 + 256) / 64 - 1 : q0 / 64;
    float slope_l2 = 0.f, pqf = 0.f, mrun, lrun;
    if (MODE == 1) { slope_l2 = exp2f(-(float)(hq + 1)) * LOG2E; pqf = (float)pos[tq]; mrun = sink[hq] * LOG2E; lrun = hh == 0 ? 1.f : 0.f; }
    else { mrun = 0.f; lrun = 0.f; }
    f32x16 O0, O1, negm;
#pragma unroll
    for (int i = 0; i < 16; ++i) { O0[i] = 0.f; O1[i] = 0.f; negm[i] = 0.f; }
    bool first = true;
    if (MODE == 1) {
#pragma unroll
        for (int i = 0; i < 16; ++i) negm[i] = -slope_l2 * pqf; }

#define ATT_STORE(bufi) do { LAS unsigned char* bb = lds + (bufi) * C::BUF; \
        *(LAS u32x4*)(bb + kst0) = sk0; \
        if (MODE == 0) { if (tid < 256) *(LAS u32x4*)(bb + kst1) = sk1; } \
        else { if (tid < 64) ((LAS float*)(bb + C::KBUF + C::VBUF))[tid] = (float)sp; } \
        *(LAS u32x4*)(bb + C::KBUF + vwr) = sv; } while (0)
#define ATT_STORE2(bufi, K0, K1, VV, PP) do { LAS unsigned char* bb = lds + (bufi) * C::BUF; \
        *(LAS u32x4*)(bb + kst0) = K0; \
        if (MODE == 0) { if (tid < 256) *(LAS u32x4*)(bb + kst1) = K1; } \
        else { if (tid < 64) ((LAS float*)(bb + C::KBUF + C::VBUF))[tid] = (float)PP; } \
        *(LAS u32x4*)(bb + C::KBUF + vwr) = VV; } while (0)
#define ATT_BAR() do { asm volatile("s_waitcnt lgkmcnt(0)" ::: "memory"); __builtin_amdgcn_s_barrier(); asm volatile("" ::: "memory"); } while (0)

#define ATT_TILE(j, bufi) do { \
        const int k0 = j * 64; \
        const bool active = (MODE == 1) || (k0 <= wq0 + 31); \
        if (active) { \
            const LAS unsigned char* bb = lds + bufi * C::BUF; const LAS bf16_t* Kb = (const LAS bf16_t*)bb; const LAS unsigned char* Vb = bb + C::KBUF + vrd; \
            f32x16 S0, S1; \
            S0 = negm; S1 = negm; \
            bf16x8 kf[2 * NKS]; \
_Pragma("unroll") \
            for (int ks = 0; ks < NKS; ++ks) { \
                kf[2 * ks] = *(const LAS bf16x8*)(Kb + lq * KROW + ks * 16 + hh * 8); \
                kf[2 * ks + 1] = *(const LAS bf16x8*)(Kb + (32 + lq) * KROW + ks * 16 + hh * 8); \
            } \
            __builtin_amdgcn_sched_barrier(0); \
_Pragma("unroll") \
            for (int ks = 0; ks < NKS; ++ks) { \
                S0 = __builtin_amdgcn_mfma_f32_32x32x16_bf16(kf[2 * ks], qf[ks], S0, 0, 0, 0); \
                S1 = __builtin_amdgcn_mfma_f32_32x32x16_bf16(kf[2 * ks + 1], qf[ks], S1, 0, 0, 0); \
            } \
            if (MODE == 1) { \
                const LAS float* pk = (const LAS float*)(bb + C::KBUF + C::VBUF) + 4 * hh; \
                const bool allv = (k0 + 63 <= wq0) && (wq0 + 31 - k0 < 128); \
                const int d0 = qq - k0 - 4 * hh; \
                if (allv) { \
_Pragma("unroll") \
                    for (int i4 = 0; i4 < 4; ++i4) { \
                        const f32x4 pa = *(const LAS f32x4*)(pk + 8 * i4), pb = *(const LAS f32x4*)(pk + 32 + 8 * i4); \
_Pragma("unroll") \
                        for (int ii = 0; ii < 4; ++ii) { S0[4 * i4 + ii] = __builtin_fmaf(slope_l2, pa[ii], S0[4 * i4 + ii]); S1[4 * i4 + ii] = __builtin_fmaf(slope_l2, pb[ii], S1[4 * i4 + ii]); } \
                    } \
                } else { \
_Pragma("unroll") \
                    for (int i4 = 0; i4 < 4; ++i4) { \
                        const f32x4 pa = *(const LAS f32x4*)(pk + 8 * i4), pb = *(const LAS f32x4*)(pk + 32 + 8 * i4); \
_Pragma("unroll") \
                        for (int ii = 0; ii < 4; ++ii) { \
                            const float sa = __builtin_fmaf(slope_l2, pa[ii], S0[4 * i4 + ii]), sb = __builtin_fmaf(slope_l2, pb[ii], S1[4 * i4 + ii]); \
                            S0[4 * i4 + ii] = ((unsigned)(d0 - (8 * i4 + ii)) < 128u) ? sa : -1e30f; S1[4 * i4 + ii] = ((unsigned)(d0 - (32 + 8 * i4 + ii)) < 128u) ? sb : -1e30f; \
                        } \
                    } \
                } \
            } else if (k0 + 63 > wq0) { \
_Pragma("unroll") \
                for (int i = 0; i < 16; ++i) { \
                    const int ka_i = k0 + 8 * (i >> 2) + 4 * hh + (i & 3); \
                    if (ka_i > qq) S0[i] = -1e30f; \
                    if (ka_i + 32 > qq) S1[i] = -1e30f; \
                } \
            } \
            const float mx = rowmax32(S0, S1); \
            if (MODE == 0) { \
                if (first || __builtin_amdgcn_ballot_w64(mx > 8.f) != 0ull) { \
                    const float delta = first ? mx : fmaxf(mx, 0.f); \
                    const float alpha = first ? 1.f : __builtin_amdgcn_exp2f(-delta); \
                    mrun += delta; lrun *= alpha; \
_Pragma("unroll") \
                    for (int i = 0; i < 16; ++i) { S0[i] -= delta; S1[i] -= delta; O0[i] *= alpha; O1[i] *= alpha; negm[i] = -mrun; } \
                    first = false; \
                } \
            } else { \
                const float mnew = fmaxf(mrun, mx); \
                const float alpha = __builtin_amdgcn_exp2f(mrun - mnew); \
                mrun = mnew; lrun *= alpha; \
_Pragma("unroll") \
                for (int i = 0; i < 16; ++i) { S0[i] -= mnew; S1[i] -= mnew; O0[i] *= alpha; O1[i] *= alpha; } \
            } \
            bf16x8 va0[4], va1[4]; \
_Pragma("unroll") \
            for (int t4 = 0; t4 < 4; ++t4) { va0[t4] = vfrag(Vb + t4 * 1024); va1[t4] = vfrag(Vb + 4096 + t4 * 1024); } \
            float ps = 0.f; \
_Pragma("unroll") \
            for (int g = 0; g < 4; ++g) { \
                float e[8]; \
_Pragma("unroll") \
                for (int i = 0; i < 8; ++i) { e[i] = __builtin_amdgcn_exp2f(g < 2 ? S0[8 * (g & 1) + i] : S1[8 * (g & 1) + i]); } \
                ps += ((e[0] + e[1]) + (e[2] + e[3])) + ((e[4] + e[5]) + (e[6] + e[7])); \
                u32x4 a; a.x = cvt_pk_bf16(e[0], e[1]); a.y = cvt_pk_bf16(e[2], e[3]); a.z = cvt_pk_bf16(e[4], e[5]); a.w = cvt_pk_bf16(e[6], e[7]); \
                const bf16x8 pfg = __builtin_bit_cast(bf16x8, a); \
                O0 = __builtin_amdgcn_mfma_f32_32x32x16_bf16(va0[g], pfg, O0, 0, 0, 0); \
                O1 = __builtin_amdgcn_mfma_f32_32x32x16_bf16(va1[g], pfg, O1, 0, 0, 0); \
                __builtin_amdgcn_sched_barrier(0); \
            } \
            lrun += ps; \
        } \
    } while (0)
    ATT_STORE(0);
    ATT_BAR();
    if (j0 < j1) ATT_LOADP(sk0, sk1, sv, sp);
    for (int j = j0; ; ) {
        if (j + 2 <= j1) ATT_LOADP(nk0, nk1, nv, np);
        ATT_TILE(j, 0);
        if (j < j1) ATT_STORE2(1, sk0, sk1, sv, sp);
        ATT_BAR();
        if (++j > j1) break;
        if (j + 2 <= j1) ATT_LOADP(sk0, sk1, sv, sp);
        ATT_TILE(j, 1);
        if (j < j1) ATT_STORE2(0, nk0, nk1, nv, np);
        ATT_BAR();
        if (++j > j1) break;
    }
#undef ATT_TILE
    const float ltot = lrun + __shfl_xor(lrun, 32);
    const float inv = 1.f / ltot;
    if (u + u_step < u_end) {
        int b_, hk_, qblk_, wq0_, hq_, j0_; ATT_DECODE(u + u_step, b_, hk_, qblk_); ATT_GEOM(qblk_, hk_, wq0_, hq_, j0_);
        const size_t tok0_ = (size_t)b_ * SEQ; ATT_QLOAD(tok0_ + wq0_ + lq, hq_); ATT_SETUP(tok0_, hk_, j0_); ATT_LOADP(sk0, sk1, sv, sp); }
    LAS unsigned char* ost = lds + 65536 + w * 4608;
#pragma unroll
    for (int i4 = 0; i4 < 4; ++i4) {
        const int dv0 = 8 * i4 + 4 * hh;
        u32x2 o;
        o.x = cvt_pk_bf16(O0[4 * i4 + 0] * inv, O0[4 * i4 + 1] * inv); o.y = cvt_pk_bf16(O0[4 * i4 + 2] * inv, O0[4 * i4 + 3] * inv);
        *(LAS u32x2*)(ost + lq * 144 + dv0 * 2) = o;
        o.x = cvt_pk_bf16(O1[4 * i4 + 0] * inv, O1[4 * i4 + 1] * inv); o.y = cvt_pk_bf16(O1[4 * i4 + 2] * inv, O1[4 * i4 + 3] * inv);
        *(LAS u32x2*)(ost + lq * 144 + 64 + dv0 * 2) = o;
    }
    asm volatile("s_waitcnt lgkmcnt(0)" ::: "memory");
    {
        const int chunk = lane & 7;
        bf16_t* obase = Z + (tok0 + wq0) * ZW + (MODE == 0 ? ZC_GB : ZC_GA) + hq * 64 + chunk * 8;
        u32x4 gv[4], ov[4];
#pragma unroll
        for (int k = 0; k < 4; ++k) { const int row = (lane >> 3) + 8 * k; gv[k] = *(const u32x4*)(obase + (size_t)row * ZW); ov[k] = *(const LAS u32x4*)(ost + row * 144 + chunk * 16); }
#pragma unroll
        for (int k = 0; k < 4; ++k) { const int row = (lane >> 3) + 8 * k; float a[8], g[8]; unpack8(ov[k], a); unpack8(gv[k], g);
#pragma unroll
            for (int e = 0; e < 8; ++e) a[e] *= g[e];
            *(u32x4*)(obase + (size_t)row * ZW) = pack8(a); }
    }
    }
#undef ATT_SETUP
#undef ATT_LOADP
#undef ATT_STORE
#undef ATT_STORE2
#undef ATT_BAR
#undef ATT_DECODE
#undef ATT_GEOM
#undef ATT_QLOAD
}
#undef MX3
}

#define XB_TMO      128
#define XB_XCNT(j)  (256  + 64 * (j))
#define XB_XSUB(j)  (1280 + 64 * (j))
#define XB_XGEN(j)  (2304 + 64 * (j))
#define XB_TOP      3328
#define XB_TOPGEN   3392
#define XCD_BAR_WORDS 3456
#define XB_SPIN_CAP (1u << 18)

__device__ __forceinline__ unsigned xb_ld(unsigned* p)              { return __hip_atomic_load(p, __ATOMIC_RELAXED, __HIP_MEMORY_SCOPE_AGENT); }
__device__ __forceinline__ unsigned xb_add(unsigned* p, unsigned v) { return __hip_atomic_fetch_add(p, v, __ATOMIC_RELAXED, __HIP_MEMORY_SCOPE_AGENT); }
__device__ __forceinline__ unsigned xb_xcc_id() { return (unsigned)__builtin_amdgcn_s_getreg((3 << 11) | 20) & 0xFu; }
#define XB_SPIN(cond, bar) do { unsigned _sp = 0; while (cond) { __builtin_amdgcn_s_sleep(1); \
    if ((++_sp & 255u) == 0u) { if (xb_ld(&(bar)[XB_TMO])) break; if (_sp > XB_SPIN_CAP) { atomicAdd(&(bar)[XB_TMO], 1u); break; } } } } while (0)

struct XcdBarrier {
    unsigned* bar; unsigned x;
    volatile LAS unsigned* st;
};

__device__ __forceinline__ XcdBarrier xcd_barrier_post(unsigned* bar, volatile LAS unsigned* st) {
    XcdBarrier b; b.bar = bar; b.x = xb_xcc_id(); b.st = st;
    if (threadIdx.x == 0) (void)xb_add(&bar[XB_XCNT(b.x)], 1u);
    return b;
}
__device__ __forceinline__ void xcd_barrier_complete(unsigned* bar, unsigned x, unsigned& nloc, unsigned& nx) {
    const unsigned G = gridDim.x * gridDim.y * gridDim.z;
    unsigned sum, cnt, mine, sp = 0u;
    for (;;) {
        sum = 0u; cnt = 0u; mine = 0u;
#pragma unroll
        for (unsigned j = 0; j < 16; ++j) { const unsigned c = xb_ld(&bar[XB_XCNT(j)]); sum += c; cnt += (c > 0u) ? 1u : 0u; mine = (j == x) ? c : mine; }
        if (sum == G) break;
        __builtin_amdgcn_s_sleep(1);
        if ((++sp & 255u) == 0u) { if (xb_ld(&bar[XB_TMO])) break; if (sp > XB_SPIN_CAP) { atomicAdd(&bar[XB_TMO], 1u); break; } }
    }
    nloc = mine > 0u ? mine : 1u; nx = cnt > 0u ? cnt : 1u;
}

__device__ __forceinline__ void xcd_barrier(const XcdBarrier& b) {
    asm volatile("s_waitcnt vmcnt(0)" ::: "memory");
    __syncthreads();
    if (threadIdx.x == 0) {
        unsigned* bar = b.bar;
        __builtin_amdgcn_s_waitcnt(0);
        unsigned nloc = b.st[0], nx = b.st[1];
        if (nloc == 0u) { xcd_barrier_complete(bar, b.x, nloc, nx); b.st[0] = nloc; b.st[1] = nx; }
        const unsigned old = xb_add(&bar[XB_XSUB(b.x)], 1u);
        const unsigned gen = old / nloc;
        if (old + 1u == (gen + 1u) * nloc) {
            __builtin_amdgcn_fence(__ATOMIC_RELEASE, "agent");
            asm volatile("s_waitcnt vmcnt(0)" ::: "memory");
            const unsigned og = xb_add(&bar[XB_TOP], 1u);
            const unsigned tg = og / nx;
            if (og + 1u == (tg + 1u) * nx) xb_add(&bar[XB_TOPGEN], 1u);
            else XB_SPIN(xb_ld(&bar[XB_TOPGEN]) == tg, bar);
            __builtin_amdgcn_fence(__ATOMIC_ACQUIRE, "agent");
            xb_add(&bar[XB_XGEN(b.x)], 1u);
            asm volatile("s_waitcnt vmcnt(0)" ::: "memory");
        } else {
            XB_SPIN(xb_ld(&bar[XB_XGEN(b.x)]) == gen, bar);
            __builtin_amdgcn_fence(__ATOMIC_ACQUIRE, "agent");
            asm volatile("s_waitcnt vmcnt(0)" ::: "memory");
        }
    }
    __syncthreads();
}


__device__ __forceinline__ int colmap(int type, int n) {
    if (type == 1) {
        if (n < 1664) return n;
        if (n < 1696) { const int j = n - 1664; return 1664 + (j >> 1) + 16 * (j & 1); }
        if (n < 1792) return -1;
        return n - 96;
    }
    if (type == 2) {
        const int h = n / 96, c = n % 96; if (c < 64) return n; const int j = c - 64; return h * 96 + 64 + (j >> 1) + 16 * (j & 1);
    }
    return n;
}
__device__ __forceinline__ void wprep(const float* W, int K, int Nsrc, const float* g, bf16_t* dst, int Ndst, int type, size_t gtid, size_t gthreads) {
    const size_t total = (size_t)Ndst * (K / 8);
    for (size_t idx = gtid; idx < total; idx += gthreads) {
        const int n = (int)(idx % Ndst), kc = (int)(idx / Ndst);
        const int src = colmap(type, n);
        float v[8];
#pragma unroll
        for (int j = 0; j < 8; ++j) { const int k = kc * 8 + j; v[j] = src < 0 ? 0.f : W[(size_t)k * Nsrc + src] * (g ? g[k] : 1.f); }
        *(u32x4*)(dst + (size_t)n * K + kc * 8) = pack8(v);
    }
}

__device__ __forceinline__ void wprep_item(const float* W, int K, int Nsrc, const float* g, bf16_t* dst, int Ndst, int type, LAS float* scr, int item, int lane) {
    const int nblk = Ndst / 32, kb = item / nblk, nb = item % nblk, k0 = 64 * kb, n0 = 32 * nb;
    const int src = colmap(type, n0 + (lane & 31));
#pragma unroll 8
    for (int i = 0; i < 32; ++i) { const int kk = 2 * i + (lane >> 5); scr[kk * 33 + (lane & 31)] = src < 0 ? 0.f : W[(size_t)(k0 + kk) * Nsrc + src] * (g ? g[k0 + kk] : 1.f); }
    asm volatile("s_waitcnt lgkmcnt(0)" ::: "memory");
    const int c = lane & 7;
#pragma unroll
    for (int j = 0; j < 4; ++j) { const int n = (lane >> 3) + 8 * j; const LAS float* sp = scr + (8 * c) * 33 + n;
        u32x4 o; o.x = cvt_pk_bf16(sp[0 * 33], sp[1 * 33]); o.y = cvt_pk_bf16(sp[2 * 33], sp[3 * 33]); o.z = cvt_pk_bf16(sp[4 * 33], sp[5 * 33]); o.w = cvt_pk_bf16(sp[6 * 33], sp[7 * 33]);
        *(u32x4*)(dst + (size_t)(n0 + n) * K + k0 + 8 * c) = o; }
    asm volatile("s_waitcnt lgkmcnt(0)" ::: "memory");
}
constexpr int LDS_BYTES = 131072 + 1024 + 64;
constexpr int BARST_OFF = 131072 + 1024;
constexpr size_t WS_BAR = WS_W + 31 * MiB + 768 * 1024;
constexpr int STAG_P1 = 0, STAG_P4 = 0, STAG_P5 = 0, STAG_P6 = 0;
constexpr int N_PHASES = 1 + 6 * DEPTH + 1;

__global__ void __launch_bounds__(512, 2) fwd_megakernel(Params P) {
    extern __shared__ __attribute__((aligned(16))) unsigned char lds_raw[];
    LAS unsigned char* lds = (LAS unsigned char*)lds_raw;
    cg::grid_group grid = cg::this_grid();
    const int G = gridDim.x, bid = blockIdx.x;
    if (threadIdx.x < 2) ((LAS unsigned*)(lds + BARST_OFF))[threadIdx.x] = 0u;
    __syncthreads();
    XcdBarrier xbar; xbar.bar = (unsigned*)(P.ws + WS_BAR); xbar.x = 0; xbar.st = (volatile LAS unsigned*)(lds + BARST_OFF);
    unsigned char* ws = P.ws;
    bf16_t* Wb = (bf16_t*)(ws + WS_W);
    float* SSXA = (float*)(ws + WS_SSXA); float* SSXB = (float*)(ws + WS_SSXB); float* SSQ = (float*)(ws + WS_SSQ); float* SSKV = (float*)(ws + WS_SSKV);
    bf16_t* PB = (bf16_t*)(ws + WS_PB); bf16_t* XB = (bf16_t*)(ws + WS_XB); bf16_t* QB = (bf16_t*)(ws + WS_QB); bf16_t* KVB = (bf16_t*)(ws + WS_KVB); bf16_t* Z = (bf16_t*)(ws + WS_Z);
    const int lo = P.ph_lo, hi = P.ph_hi;
    int ph = 0;
    if (bid == 0) { unsigned* bw = (unsigned*)(P.ws + WS_BAR); for (int i = threadIdx.x; i < 4096 + 256; i += 512) bw[i] = 0u; }
#define PHASE_BEGIN if (ph >= lo && ph < hi) {
#if PROBE_SET
    unsigned long long* TS = (unsigned long long*)(ws + WS_W + 31 * MiB + 512 * 1024);
    if (bid == 0 && threadIdx.x == 0) TS[15] = __builtin_amdgcn_s_memrealtime();
#define PHASE_END   if (ph == 12 && bid == 0 && threadIdx.x == 0) TS[ph] = __builtin_amdgcn_s_memrealtime(); if (ph + 1 < hi) { if (ph == lo) { grid.sync(); xbar = xcd_barrier_post((unsigned*)(P.ws + WS_BAR), (volatile LAS unsigned*)(lds + BARST_OFF)); } else xcd_barrier(xbar); } if (ph < 12 && bid == 0 && threadIdx.x == 0) TS[ph] = __builtin_amdgcn_s_memrealtime(); } ++ph;
#else
#define PHASE_END   if (ph + 1 < hi && !(ph + 2 == N_PHASES && G == 256)) { if (ph == lo) { grid.sync(); xbar = xcd_barrier_post((unsigned*)(P.ws + WS_BAR), (volatile LAS unsigned*)(lds + BARST_OFF)); } else xcd_barrier(xbar); } } ++ph;
#endif

    PHASE_BEGIN
#if (PHMASK >> 0) & 1
    {
        int tid_ = threadIdx.x; asm volatile("" : "+v"(tid_)); const int tid = tid_, lane = tid & 63, wave = tid >> 6;
        const size_t gtid = (size_t)bid * 512 + tid, gthreads = (size_t)G * 512;
        {
            LAS float* scr = (LAS float*)(lds + wave * 16384);
            const int gwv = bid * 8 + wave, ngw = G * 8;
            constexpr int I_IN = 16 * 136, I_UQ = 4 * 24, I_UKV = 2 * 32, I_A = 8 * 32, I_OUT = 16 * 32, I_PP = 4 * 32, I_L = I_IN + I_UQ + I_UKV + 2 * I_A + 2 * I_OUT + I_PP;
            for (int it = gwv; it < DEPTH * I_L; it += ngw) {
                const int L = it / I_L; int r = it % I_L;
                bf16_t* wl = Wb + (size_t)L * WO_END;
                if (r < I_IN) { wprep_item(P.w_in + (size_t)L * 1024 * IN_WIDTH, 1024, IN_WIDTH, P.g_mix + L * 1024, wl + WO_IN, ZW, 1, scr, r, lane); continue; } r -= I_IN;
                if (r < I_UQ) { wprep_item(P.w_uq + (size_t)L * 256 * 768, 256, 768, P.g_q + L * 256, wl + WO_UQ, 768, 2, scr, r, lane); continue; } r -= I_UQ;
                if (r < I_UKV) { wprep_item(P.w_ukv + (size_t)L * 128 * 1024, 128, 1024, P.g_kv + L * 128, wl + WO_UKV, 1024, 0, scr, r, lane); continue; } r -= I_UKV;
                if (r < I_A) { wprep_item(P.w_br_a + (size_t)L * 512 * 1024, 512, 1024, nullptr, wl + WO_A, 1024, 0, scr, r, lane); continue; } r -= I_A;
                if (r < I_A) { wprep_item(P.w_br_b + (size_t)L * 512 * 1024, 512, 1024, nullptr, wl + WO_B, 1024, 0, scr, r, lane); continue; } r -= I_A;
                if (r < I_OUT) { wprep_item(P.w_out + (size_t)L * 1024 * 1024, 1024, 1024, nullptr, wl + WO_OUT, 1024, 0, scr, r, lane); continue; } r -= I_OUT;
                if (r < I_OUT) { wprep_item(P.w_ple_gate + (size_t)L * 1024 * 1024, 1024, 1024, P.g_ple + L * 1024, wl + WO_PG, 1024, 0, scr, r, lane); continue; } r -= I_OUT;
                wprep_item(P.w_ple_proj + (size_t)L * 256 * 1024, 256, 1024, nullptr, wl + WO_PP, 1024, 0, scr, r, lane);
            }
        }
        const int gw = bid * 8 + wave, NGW = G * 8;
        for (int r = gw; r < T; r += NGW) {
            const f32x4* xr = (const f32x4*)(P.x + (size_t)r * D);
            float s = 0.f;
#pragma unroll
            for (int j = 0; j < 2; ++j) { const f32x4 v = xr[2 * (lane + 64 * j)], w2 = xr[2 * (lane + 64 * j) + 1];
                s += ((v.x * v.x + v.y * v.y) + (v.z * v.z + v.w * v.w)) + ((w2.x * w2.x + w2.y * w2.y) + (w2.z * w2.z + w2.w * w2.w));
                u32x4 o; o.x = cvt_pk_bf16(v.x, v.y); o.y = cvt_pk_bf16(v.z, v.w); o.z = cvt_pk_bf16(w2.x, w2.y); o.w = cvt_pk_bf16(w2.z, w2.w); *((u32x4*)(XB + (size_t)r * D) + lane + 64 * j) = o; }
#pragma unroll
            for (int o = 1; o < 64; o <<= 1) s += __shfl_xor(s, o);
            if (lane < 16) SSXA[(size_t)r * 16 + lane] = lane == 0 ? s : 0.f;
        }
        const size_t np8 = (size_t)DEPTH * T * PLE / 8;
        for (size_t i = gtid; i < np8; i += gthreads) { const f32x4 a = *(const f32x4*)(P.p + i * 8), c = *(const f32x4*)(P.p + i * 8 + 4);
            u32x4 o; o.x = cvt_pk_bf16(a.x, a.y); o.y = cvt_pk_bf16(a.z, a.w); o.z = cvt_pk_bf16(c.x, c.y); o.w = cvt_pk_bf16(c.z, c.w); *(u32x4*)(PB + i * 8) = o; }
    }
#endif
    PHASE_END

#pragma unroll 1
    for (int L = 0; L < DEPTH; ++L) {
        const bf16_t* wl = Wb + (size_t)L * WO_END;
        PHASE_BEGIN
#if (PHMASK >> 1) & 1
        { pg8::Gemm g{XB, wl + WO_IN, T, ZW, 1024, 1024}; pg8::StaticOrder S; S.init(T, ZW, G, bid);
          EpiZ E{Z, SSXA, SSQ, SSKV, P.pos, lds}; pg8::gemm_phase(lds, g, S, E, STAG_P1); }
    #endif
    PHASE_END
        PHASE_BEGIN
#if (PHMASK >> 2) & 1
        { pg8::Gemm g{Z + ZC_BQD, wl + WO_UQ, T, 768, 256, ZW}; pg8::StaticOrder S; S.init(T, 768, G, bid);
          EpiQB E{QB, SSQ, P.pos, lds}; pg8::gemm_phase(lds, g, S, E); }
        { pg8::Gemm g{Z + ZC_BKVD, wl + WO_UKV, T, 1024, 128, ZW}; pg8::StaticOrder S; S.init(T, 1024, G, bid);
          EpiKVB E{KVB, SSKV, lds}; pg8::gemm_phase(lds, g, S, E); }
    #endif
    PHASE_END
        PHASE_BEGIN
#if (PHMASK >> 3) & 1
        {
            __syncthreads();
            att::attn_mode<0>(lds, QB, KVB, Z, P.pos, nullptr, bid, 2048, G);
            { const int u1 = bid + ((2048 - bid + G - 1) / G) * G; att::attn_mode<1>(lds, QB, KVB, Z, P.pos, P.sink + L * 8, u1, 4096, G); }
        }
    #endif
    PHASE_END
        PHASE_BEGIN
#if (PHMASK >> 4) & 1
        { pg8::Gemm g{Z + ZC_GA, wl + WO_A, T, 1024, 512, ZW}; pg8::Gemm g2{Z + ZC_GB, wl + WO_B, T, 1024, 512, ZW}; pg8::StaticOrder S; S.init(T, 1024, G, bid);
          EpiMerge<0> E{Z, KVB}; EpiMerge<1> E2{Z, KVB}; pg8::gemm_phase_pair(lds, g, g2, S, E, E2); }
    #endif
    PHASE_END
        PHASE_BEGIN
#if (PHMASK >> 5) & 1
        { pg8::Gemm g{KVB, wl + WO_OUT, T, 1024, 1024, 1024}; pg8::StaticOrder S; S.init(T, 1024, G, bid);
          EpiX1<1> E{P.x, XB, Z, SSXB}; pg8::gemm_phase(lds, g, S, E, STAG_P5); }
        { pg8::Gemm g{PB + (size_t)L * T * PLE, wl + WO_PP, T, 1024, 256, 256}; pg8::StaticOrder S; S.init(T, 1024, G, bid);
          EpiPP E{Z}; pg8::gemm_phase(lds, g, S, E); }
    #endif
    PHASE_END
        PHASE_BEGIN
#if (PHMASK >> 6) & 1
        { pg8::Gemm g{Z + ZC_X1B, wl + WO_PG, T, 1024, 1024, ZW}; pg8::StaticOrder S; S.init(T, 1024, G, bid);
          if (L + 1 == DEPTH && G == 256) { EpiX2F E{P.out, Z, SSXB, SSXA, P.g_final, (unsigned*)(P.ws + WS_BAR) + 4096, lds}; pg8::gemm_phase(lds, g, S, E, STAG_P6); }
          else { EpiX2 E{P.out, Z, XB, SSXB, SSXA, lds, L + 1 < DEPTH}; pg8::gemm_phase(lds, g, S, E, STAG_P6); } }
    #endif
    PHASE_END
    }
    PHASE_BEGIN
#if (PHMASK >> 7) & 1
    {
        int tid_ = threadIdx.x; asm volatile("" : "+v"(tid_)); const int tid = tid_, lane = tid & 63, wave = tid >> 6;
        const int gw = G == 256 ? T : bid * 8 + wave, NGW = G * 8;
#if PROBE_SET
        int krows = 0;
        { unsigned long long prev = TS[15], sel = 0; const unsigned long long t0 = prev;
          for (int k = 0; k <= 12; ++k) { const unsigned long long tk = TS[k]; if ((PROBE_SET >> k) & 1) sel += tk - prev; prev = tk; }
          krows = (int)((float)sel / (float)(prev - t0) * 4096.f + 0.5f); }
#endif
        for (int r = gw; r < T; r += NGW) {
            const float rstd = rsqrtf(sum16(SSXA + (size_t)r * 16) * (1.f / 1024.f) + EPS);
            f32x4* xr = (f32x4*)(P.out + (size_t)r * D) + lane; const f32x4* gr = (const f32x4*)P.g_final + lane; const u32x2* xbr = (const u32x2*)(XB + (size_t)r * D) + lane;
#pragma unroll
            for (int j = 0; j < 4; ++j) { const u32x2 xw = xbr[64 * j]; f32x4 v = (f32x4){bflo(xw.x), bfhi(xw.x), bflo(xw.y), bfhi(xw.y)}; const f32x4 gg = gr[64 * j]; v.x *= rstd * gg.x; v.y *= rstd * gg.y; v.z *= rstd * gg.z; v.w *= rstd * gg.w;
#if PROBE_SET
                if (r < krows) { v.x += 0.015f; v.y += 0.015f; v.z += 0.015f; v.w += 0.015f; }
#endif
                xr[64 * j] = v; }
        }
    }
#endif
    PHASE_END
#undef PHASE_BEGIN
#undef PHASE_END
}

extern "C" void kernel_launch(void* const* d_in, const int* in_sizes, int n_in, void* d_out, int out_size, void* d_ws, size_t ws_size, hipStream_t stream) {
    static int grid = 0;
    if (grid == 0) {
        if (n_in != 17 || in_sizes[0] != T * D || out_size != T * D || ws_size < WS_END) {
            fprintf(stderr, "kernel_launch: unexpected shapes/workspace: n_in %d in0 %d out %d ws %zu (need %zu)\n", n_in, n_in > 0 ? in_sizes[0] : -1, out_size, ws_size, (size_t)WS_END); grid = -1; return; }
        int dev = 0, cus = 0, per_cu = 0;
        hipGetDevice(&dev); hipDeviceGetAttribute(&cus, hipDeviceAttributeMultiprocessorCount, dev);
        if (hipFuncSetAttribute((const void*)fwd_megakernel, hipFuncAttributeMaxDynamicSharedMemorySize, LDS_BYTES) != hipSuccess) { fprintf(stderr, "kernel_launch: hipFuncSetAttribute failed\n"); grid = -1; return; }
        if (hipOccupancyMaxActiveBlocksPerMultiprocessor(&per_cu, (const void*)fwd_megakernel, 512, LDS_BYTES) != hipSuccess || per_cu < 1) { fprintf(stderr, "kernel_launch: occupancy query gave %d\n", per_cu); per_cu = 1; }
        (void)hipGetLastError();
        grid = cus * 1;
        fprintf(stderr, "kernel_launch: grid %d (cus %d, per_cu %d)\n", grid, cus, per_cu);
    }
    if (grid < 0) return;
    Params p{};
    p.x = (const float*)d_in[0]; p.p = (const float*)d_in[1]; p.pos = (const int*)d_in[2];
    p.g_mix = (const float*)d_in[3]; p.w_in = (const float*)d_in[4]; p.sink = (const float*)d_in[5]; p.g_q = (const float*)d_in[6]; p.w_uq = (const float*)d_in[7];
    p.g_kv = (const float*)d_in[8]; p.w_ukv = (const float*)d_in[9]; p.w_br_a = (const float*)d_in[10]; p.w_br_b = (const float*)d_in[11]; p.w_out = (const float*)d_in[12];
    p.g_ple = (const float*)d_in[13]; p.w_ple_gate = (const float*)d_in[14]; p.w_ple_proj = (const float*)d_in[15]; p.g_final = (const float*)d_in[16];
    p.out = (float*)d_out; p.ws = (unsigned char*)d_ws;
#if ONE_LAUNCH
    p.ph_lo = 0; p.ph_hi = N_PHASES;
    { void* args[] = {&p}; hipError_t e = hipLaunchCooperativeKernel((const void*)fwd_megakernel, dim3(grid), dim3(512), args, LDS_BYTES, stream);
      if (e != hipSuccess) fprintf(stderr, "cooperative launch failed: %s (grid %d)\n", hipGetErrorString(e), grid); }
#else
    for (int ph = 0; ph < N_PHASES; ++ph) {
        p.ph_lo = ph; p.ph_hi = ph + 1;
        void* args[] = {&p}; hipError_t e = hipLaunchCooperativeKernel((const void*)fwd_megakernel, dim3(grid), dim3(512), args, LDS_BYTES, stream);
        if (e != hipSuccess) { fprintf(stderr, "cooperative launch %d failed: %s (grid %d)\n", ph, hipGetErrorString(e), grid); break; }
    }
#endif
}
```

```cpp
#include <hip/hip_runtime.h>
#include <hip/hip_cooperative_groups.h>
#include <cstdio>
#include <cstdint>
namespace cg = cooperative_groups;

#ifndef PHMASK
#define PHMASK 255
#endif
#ifndef PROBE_SET
#define PROBE_SET 0
#endif
#ifndef ONE_LAUNCH
#define ONE_LAUNCH 1
#endif

#define LAS __attribute__((address_space(3)))
typedef unsigned short bf16_t;
typedef short bf16x8 __attribute__((ext_vector_type(8)));
typedef float f32x4 __attribute__((ext_vector_type(4)));
typedef float f32x16 __attribute__((ext_vector_type(16)));
typedef unsigned u32x4 __attribute__((ext_vector_type(4)));
typedef unsigned u32x2 __attribute__((ext_vector_type(2)));

constexpr int BATCH = 32, SEQ = 2048, T = BATCH * SEQ, D = 1024, DEPTH = 2, PLE = 256;
constexpr int ZW = 4352;
constexpr int ZC_QA = 0, ZC_KA = 512, ZC_VA = 640, ZC_GA = 768, ZC_BQD = 1280, ZC_BKVD = 1536, ZC_KR = 1664, ZC_GB = 1792, ZC_MA = 2304, ZC_MB = 3328;
constexpr int ZC_X1B = ZC_MA, ZC_T2 = 0;
constexpr int IN_WIDTH = 4256;
constexpr float EPS = 1e-6f;
constexpr float LOG2E = 1.4426950408889634f;

constexpr size_t WO_IN = 0, WO_UQ = WO_IN + (size_t)ZW * 1024, WO_UKV = WO_UQ + 768 * 256, WO_A = WO_UKV + 1024 * 128, WO_B = WO_A + 1024 * 512,
                 WO_OUT = WO_B + 1024 * 512, WO_PG = WO_OUT + 1024 * 1024, WO_PP = WO_PG + 1024 * 1024, WO_END = WO_PP + 1024 * 256;
constexpr size_t MiB = 1u << 20;
constexpr size_t WS_W = 0, WS_SSXA = 32 * MiB, WS_SSXB = 36 * MiB, WS_SSQ = 40 * MiB, WS_SSKV = 41 * MiB, WS_PB = 42 * MiB, WS_XB = 106 * MiB,
                 WS_QB = 234 * MiB, WS_KVB = 330 * MiB, WS_Z = 458 * MiB, WS_END = 1002 * MiB;
static_assert(2 * WO_END * 2 <= 32 * MiB, "weights fit");
static_assert((size_t)T * ZW * 2 == 544 * MiB, "Z size");

struct Params {
    const float* x; const float* p; const int* pos;
    const float *g_mix, *w_in, *sink, *g_q, *w_uq, *g_kv, *w_ukv, *w_br_a, *w_br_b, *w_out, *g_ple, *w_ple_gate, *w_ple_proj, *g_final;
    float* out; unsigned char* ws;
    int ph_lo, ph_hi;
};

__device__ __forceinline__ unsigned cvt_pk_bf16(float lo, float hi) { unsigned r; asm volatile("v_cvt_pk_bf16_f32 %0, %1, %2" : "=v"(r) : "v"(lo), "v"(hi)); return r; }
__device__ __forceinline__ float bflo(unsigned w) { return __uint_as_float(w << 16); }
__device__ __forceinline__ float bfhi(unsigned w) { return __uint_as_float(w & 0xffff0000u); }
__device__ __forceinline__ float fsigmoid(float x) { return __builtin_amdgcn_rcpf(1.f + __expf(-x)); }
__device__ __forceinline__ float fsilu(float x) { return x * fsigmoid(x); }
__device__ __forceinline__ u32x4 pack8(const float* v) { u32x4 w; w.x = cvt_pk_bf16(v[0], v[1]); w.y = cvt_pk_bf16(v[2], v[3]); w.z = cvt_pk_bf16(v[4], v[5]); w.w = cvt_pk_bf16(v[6], v[7]); return w; }
__device__ __forceinline__ void unpack8(u32x4 w, float* v) { v[0] = bflo(w.x); v[1] = bfhi(w.x); v[2] = bflo(w.y); v[3] = bfhi(w.y); v[4] = bflo(w.z); v[5] = bfhi(w.z); v[6] = bflo(w.w); v[7] = bfhi(w.w); }
__device__ __forceinline__ float sum16(const float* s) { const f32x4 a = *(const f32x4*)s, b = *(const f32x4*)(s + 4), c = *(const f32x4*)(s + 8), d = *(const f32x4*)(s + 12);
    return ((a.x + a.y) + (a.z + a.w)) + ((b.x + b.y) + (b.z + b.w)) + ((c.x + c.y) + (c.z + c.w)) + ((d.x + d.y) + (d.z + d.w)); }
__device__ __forceinline__ float sum4(const float* s) { const f32x4 a = *(const f32x4*)s; return (a.x + a.y) + (a.z + a.w); }
__device__ __forceinline__ void rope8(float* v, int i0, float posf) {
#pragma unroll
    for (int j = 0; j < 4; ++j) {
        const float ci = __builtin_amdgcn_exp2f(-(float)(i0 + j) * 0.83048202372184059f) * 0.15915494309189535f;
        float r = posf * ci; r = r - rintf(r);
        const float sn = __builtin_amdgcn_sinf(r), cs = __builtin_amdgcn_cosf(r);
        const float x1 = v[2 * j], x2 = v[2 * j + 1];
        v[2 * j] = x1 * cs - x2 * sn; v[2 * j + 1] = x2 * cs + x1 * sn;
    }
}

namespace pg8 {
constexpr int BM = 256, BK = 64, HALF = 128, HTB = HALF * BK * 2, STAGE_BYTES = 8 * HTB, NXCD = 8, WGM = 8;
__host__ __device__ __forceinline__ int lds_byte(int r, int c) { const int st = (r >> 4) * 2 + (c >> 5), rr = r & 15, cc = c & 31, ob = rr * 64 + cc * 2; return st * 1024 + (ob ^ (((ob >> 9) & 1) << 5)); }
__host__ __device__ __forceinline__ void stage_rc(int b, int& R, int& C) { const int st = b / 1024, sb = b % 1024, swz = sb ^ (((sb >> 9) & 1) << 5); R = (st >> 1) * 16 + swz / 64; C = (st & 1) * 32 + (swz % 64) / 2; }
__host__ __device__ __forceinline__ int perm32(int rho) { const int n = rho >> 4, i = rho & 15; return 8 * (i >> 2) + 4 * n + (i & 3); }

struct Unit { int pm, pn; };
struct Gemm { const bf16_t* A; const bf16_t* Bt; int M, N, K, lda; };

struct StaticOrder {
    int nM, nN, nwg, G, c;
    __host__ __device__ void init(int M, int N, int G_, int c_) { nM = M / BM; nN = N / BM; nwg = nM * nN; G = G_; c = c_; }
    __host__ __device__ bool next(int i, Unit& u) const {
        const long L = (long)i * G + c; if (L >= nwg) return false;
        int wgid = (int)L; { const int q = nwg / NXCD, r = nwg % NXCD, xcd = wgid % NXCD, off = wgid / NXCD; wgid = (xcd < r ? xcd * (q + 1) : r * (q + 1) + (xcd - r) * q) + off; }
        const int nig = WGM * nN, gid = wgid / nig, fm = gid * WGM, gsz = (nM - fm) < WGM ? (nM - fm) : WGM;
        u.pm = fm + ((wgid % nig) % gsz); u.pn = (wgid % nig) / gsz; return true;
    }
};

template <class Epi>
__device__ __forceinline__ void gemm_phase(LAS unsigned char* lds, const Gemm g, const StaticOrder& S, const Epi& E, int stag = 0) {
    if (stag > 0) {
        const unsigned long long t0_ = __builtin_amdgcn_s_memrealtime(); const unsigned long long w_ = (unsigned long long)(((blockIdx.x >> 3) & 3) * stag);
        while (__builtin_amdgcn_s_memrealtime() - t0_ < w_) __builtin_amdgcn_s_sleep(8);
    }
    int tid_ = threadIdx.x; asm volatile("" : "+v"(tid_));
    const int tid = tid_, wid = __builtin_amdgcn_readfirstlane(tid >> 6), lane = tid & 63, wr = wid >> 2, wc = wid & 3, fr = lane & 15, fq = lane >> 4;
    const int K = g.K, nt = K / BK, lda = g.lda;
    unsigned voffA[2], voffB[2];
#pragma unroll
    for (int i = 0; i < 2; ++i) { int R, C; stage_rc(tid * 16 + i * 8192, R, C); const int Rb = (R & ~31) + perm32(R & 31);
        voffA[i] = (unsigned)(R * lda + C) * 2u; voffB[i] = (unsigned)(Rb * K + C) * 2u; }
    const size_t kstep = (size_t)(BK * 2);
    const size_t hstepA = (size_t)HALF * lda * 2, hstepB = (size_t)HALF * K * 2;
    const size_t tstepA = 2 * hstepA, tstepB = 2 * hstepB;
    const unsigned ldsw = (unsigned)wid * 1024u;
    const int aoff = lds_byte(wr * 64 + fr, fq * 8), boff = lds_byte(wc * 32 + fr, fq * 8);
#define PG8_SA(b, h) (((b) * 2 + (h)) * HTB)
#define PG8_SB(b, h) ((4 + (b) * 2 + (h)) * HTB)
#define PG8_STAGE(bufoff, gbase, voff) do { _Pragma("unroll") for (int _i = 0; _i < 2; ++_i) \
        { unsigned vo_ = (voff)[_i]; asm volatile("" : "+v"(vo_)); __builtin_amdgcn_global_load_lds((const unsigned*)((const char*)(gbase) + vo_), (LAS unsigned*)(lds + (bufoff) + ldsw + _i * 8192), 16, 0, 0); } } while (0)
#define PG8_LDA(dst, b, h) do { _Pragma("unroll") for (int m = 0; m < 4; ++m) _Pragma("unroll") for (int k = 0; k < 2; ++k) dst[m][k] = *(const LAS bf16x8*)(lds + PG8_SA(b, h) + aoff + m * 2048 + k * 1024); } while (0)
#define PG8_LDB(dst, b, h) do { _Pragma("unroll") for (int n = 0; n < 2; ++n) _Pragma("unroll") for (int k = 0; k < 2; ++k) dst[n][k] = *(const LAS bf16x8*)(lds + PG8_SB(b, h) + boff + n * 2048 + k * 1024); } while (0)
#define PG8_MMA(ai, bj, At, Bt) do { __builtin_amdgcn_s_setprio(1); _Pragma("unroll") for (int m = 0; m < 4; ++m) _Pragma("unroll") for (int n = 0; n < 2; ++n) _Pragma("unroll") for (int k = 0; k < 2; ++k) \
        acc[ai][bj][m][n] = __builtin_amdgcn_mfma_f32_16x16x32_bf16(Bt[n][k], At[m][k], acc[ai][bj][m][n], 0, 0, 0); __builtin_amdgcn_s_setprio(0); } while (0)
#define PG8_WAIT_V(n) asm volatile("s_waitcnt vmcnt(" #n ")" ::: "memory")
#define PG8_WAIT_L(n) asm volatile("s_waitcnt lgkmcnt(" #n ")" ::: "memory")
#define PG8_BAR __builtin_amdgcn_s_barrier()
#define PG8_SCHED __builtin_amdgcn_sched_barrier(0)
    Unit cur, nxt; int ui = 0;
    if (!S.next(0, cur)) return;
    f32x4 acc[2][2][4][2];
#pragma unroll
    for (int a = 0; a < 2; ++a)
#pragma unroll
        for (int b = 0; b < 2; ++b)
#pragma unroll
            for (int m = 0; m < 4; ++m)
#pragma unroll
                for (int n = 0; n < 2; ++n) acc[a][b][m][n] = (f32x4){0.f, 0.f, 0.f, 0.f};
    bf16x8 At[4][2], B0[2][2], B1[2][2];
    const char* cA = (const char*)g.A + (size_t)cur.pm * tstepA; const char* cB = (const char*)g.Bt + (size_t)cur.pn * tstepB;
    PG8_STAGE(PG8_SB(0, 0), cB, voffB); PG8_STAGE(PG8_SB(0, 1), cB + hstepB, voffB); PG8_STAGE(PG8_SA(0, 0), cA, voffA); PG8_STAGE(PG8_SA(0, 1), cA + hstepA, voffA);
    if (wr == 1) PG8_BAR;
    PG8_WAIT_V(2); PG8_BAR;
    PG8_STAGE(PG8_SB(1, 0), cB + kstep, voffB); PG8_STAGE(PG8_SA(1, 0), cA + kstep, voffA); PG8_STAGE(PG8_SB(1, 1), cB + hstepB + kstep, voffB);
    PG8_WAIT_V(6); PG8_BAR;
    for (;;) {
        const bool has_next = S.next(ui + 1, nxt);
        const char* nA = has_next ? (const char*)g.A + (size_t)nxt.pm * tstepA : cA; const char* nB = has_next ? (const char*)g.Bt + (size_t)nxt.pn * tstepB : cB;
#pragma unroll 1
        for (int t = 0; t < nt; t += 2) {
            const bool last = (t == nt - 2);
            const char* a1 = cA + (size_t)(t + 1) * kstep;
            const char* a2 = last ? nA : cA + (size_t)(t + 2) * kstep; const char* b2 = last ? nB : cB + (size_t)(t + 2) * kstep;
            const char* a3 = a2 + kstep; const char* b3 = b2 + kstep;
            PG8_LDB(B0, 0, 0); PG8_LDB(B1, 0, 1); PG8_SCHED; PG8_LDA(At, 0, 0); PG8_STAGE(PG8_SA(1, 1), a1 + hstepA, voffA);
            PG8_WAIT_V(8); PG8_WAIT_L(0); PG8_BAR; PG8_MMA(0, 0, At, B0); PG8_MMA(0, 1, At, B1); PG8_BAR; PG8_SCHED;
            PG8_LDA(At, 0, 1); PG8_STAGE(PG8_SB(0, 0), b2, voffB); PG8_STAGE(PG8_SB(0, 1), b2 + hstepB, voffB); PG8_STAGE(PG8_SA(0, 0), a2, voffA);
            PG8_WAIT_V(8); PG8_WAIT_L(0); PG8_BAR; PG8_MMA(1, 0, At, B0); PG8_MMA(1, 1, At, B1); PG8_BAR; PG8_SCHED;
            PG8_LDB(B0, 1, 0); PG8_LDB(B1, 1, 1); PG8_SCHED; PG8_LDA(At, 1, 0); PG8_STAGE(PG8_SA(0, 1), a2 + hstepA, voffA);
            PG8_WAIT_V(8); PG8_WAIT_L(0); PG8_BAR; PG8_MMA(0, 0, At, B0); PG8_MMA(0, 1, At, B1); PG8_BAR; PG8_SCHED;
            PG8_LDA(At, 1, 1); PG8_STAGE(PG8_SB(1, 0), b3, voffB); PG8_STAGE(PG8_SB(1, 1), b3 + hstepB, voffB); PG8_STAGE(PG8_SA(1, 0), a3, voffA);
            PG8_WAIT_V(8); PG8_WAIT_L(0); PG8_BAR; PG8_MMA(1, 0, At, B0); PG8_MMA(1, 1, At, B1); PG8_BAR; PG8_SCHED;
        }
        if (wr == 0) PG8_BAR;
        E(acc, cur, wr, wc, fr, fq);
        if (!has_next) break;
#pragma unroll
        for (int a = 0; a < 2; ++a)
#pragma unroll
            for (int b = 0; b < 2; ++b)
#pragma unroll
                for (int m = 0; m < 4; ++m)
#pragma unroll
                    for (int n = 0; n < 2; ++n) acc[a][b][m][n] = (f32x4){0.f, 0.f, 0.f, 0.f};
        cur = nxt; cA = nA; cB = nB; ++ui;
        if (wr == 1) PG8_BAR;
    }
    PG8_WAIT_V(0);
    PG8_BAR;
}
template <class Epi1, class Epi2>
__device__ __forceinline__ void gemm_phase_pair(LAS unsigned char* lds, const Gemm g, const Gemm g2, const StaticOrder& S, const Epi1& E, const Epi2& E2) {
    const int stag = 0;
    if (stag > 0) {
        const unsigned long long t0_ = __builtin_amdgcn_s_memrealtime(); const unsigned long long w_ = (unsigned long long)(((blockIdx.x >> 3) & 3) * stag);
        while (__builtin_amdgcn_s_memrealtime() - t0_ < w_) __builtin_amdgcn_s_sleep(8);
    }
    int tid_ = threadIdx.x; asm volatile("" : "+v"(tid_));
    const int tid = tid_, wid = __builtin_amdgcn_readfirstlane(tid >> 6), lane = tid & 63, wr = wid >> 2, wc = wid & 3, fr = lane & 15, fq = lane >> 4;
    const int K = g.K, nt = K / BK, lda = g.lda;
    unsigned voffA[2], voffB[2];
#pragma unroll
    for (int i = 0; i < 2; ++i) { int R, C; stage_rc(tid * 16 + i * 8192, R, C); const int Rb = (R & ~31) + perm32(R & 31);
        voffA[i] = (unsigned)(R * lda + C) * 2u; voffB[i] = (unsigned)(Rb * K + C) * 2u; }
    const size_t kstep = (size_t)(BK * 2);
    const size_t hstepA = (size_t)HALF * lda * 2, hstepB = (size_t)HALF * K * 2;
    const size_t tstepA = 2 * hstepA, tstepB = 2 * hstepB;
    const unsigned ldsw = (unsigned)wid * 1024u;
    const int aoff = lds_byte(wr * 64 + fr, fq * 8), boff = lds_byte(wc * 32 + fr, fq * 8);
#define PG8_SA(b, h) (((b) * 2 + (h)) * HTB)
#define PG8_SB(b, h) ((4 + (b) * 2 + (h)) * HTB)
#define PG8_STAGE(bufoff, gbase, voff) do { _Pragma("unroll") for (int _i = 0; _i < 2; ++_i) \
        { unsigned vo_ = (voff)[_i]; asm volatile("" : "+v"(vo_)); __builtin_amdgcn_global_load_lds((const unsigned*)((const char*)(gbase) + vo_), (LAS unsigned*)(lds + (bufoff) + ldsw + _i * 8192), 16, 0, 0); } } while (0)
#define PG8_LDA(dst, b, h) do { _Pragma("unroll") for (int m = 0; m < 4; ++m) _Pragma("unroll") for (int k = 0; k < 2; ++k) dst[m][k] = *(const LAS bf16x8*)(lds + PG8_SA(b, h) + aoff + m * 2048 + k * 1024); } while (0)
#define PG8_LDB(dst, b, h) do { _Pragma("unroll") for (int n = 0; n < 2; ++n) _Pragma("unroll") for (int k = 0; k < 2; ++k) dst[n][k] = *(const LAS bf16x8*)(lds + PG8_SB(b, h) + boff + n * 2048 + k * 1024); } while (0)
#define PG8_MMA(ai, bj, At, Bt) do { __builtin_amdgcn_s_setprio(1); _Pragma("unroll") for (int m = 0; m < 4; ++m) _Pragma("unroll") for (int n = 0; n < 2; ++n) _Pragma("unroll") for (int k = 0; k < 2; ++k) \
        acc[ai][bj][m][n] = __builtin_amdgcn_mfma_f32_16x16x32_bf16(Bt[n][k], At[m][k], acc[ai][bj][m][n], 0, 0, 0); __builtin_amdgcn_s_setprio(0); } while (0)
#define PG8_WAIT_V(n) asm volatile("s_waitcnt vmcnt(" #n ")" ::: "memory")
#define PG8_WAIT_L(n) asm volatile("s_waitcnt lgkmcnt(" #n ")" ::: "memory")
#define PG8_BAR __builtin_amdgcn_s_barrier()
#define PG8_SCHED __builtin_amdgcn_sched_barrier(0)
    Unit cur, nxt; int ui = 0;
    if (!S.next(0, cur)) return;
    int which = 0;
    f32x4 acc[2][2][4][2];
#pragma unroll
    for (int a = 0; a < 2; ++a)
#pragma unroll
        for (int b = 0; b < 2; ++b)
#pragma unroll
            for (int m = 0; m < 4; ++m)
#pragma unroll
                for (int n = 0; n < 2; ++n) acc[a][b][m][n] = (f32x4){0.f, 0.f, 0.f, 0.f};
    bf16x8 At[4][2], B0[2][2], B1[2][2];
    const char* cA = (const char*)g.A + (size_t)cur.pm * tstepA; const char* cB = (const char*)g.Bt + (size_t)cur.pn * tstepB;
    PG8_STAGE(PG8_SB(0, 0), cB, voffB); PG8_STAGE(PG8_SB(0, 1), cB + hstepB, voffB); PG8_STAGE(PG8_SA(0, 0), cA, voffA); PG8_STAGE(PG8_SA(0, 1), cA + hstepA, voffA);
    if (wr == 1) PG8_BAR;
    PG8_WAIT_V(2); PG8_BAR;
    PG8_STAGE(PG8_SB(1, 0), cB + kstep, voffB); PG8_STAGE(PG8_SA(1, 0), cA + kstep, voffA); PG8_STAGE(PG8_SB(1, 1), cB + hstepB + kstep, voffB);
    PG8_WAIT_V(6); PG8_BAR;
    for (;;) {
        const int nwhich = which ^ 1;
        bool has_next = true; if (which == 0) nxt = cur; else has_next = S.next((ui >> 1) + 1, nxt);
        const char* nA = has_next ? (const char*)(nwhich ? g2.A : g.A) + (size_t)nxt.pm * tstepA : cA; const char* nB = has_next ? (const char*)(nwhich ? g2.Bt : g.Bt) + (size_t)nxt.pn * tstepB : cB;
#pragma unroll 1
        for (int t = 0; t < nt; t += 2) {
            const bool last = (t == nt - 2);
            const char* a1 = cA + (size_t)(t + 1) * kstep;
            const char* a2 = last ? nA : cA + (size_t)(t + 2) * kstep; const char* b2 = last ? nB : cB + (size_t)(t + 2) * kstep;
            const char* a3 = a2 + kstep; const char* b3 = b2 + kstep;
            PG8_LDB(B0, 0, 0); PG8_LDB(B1, 0, 1); PG8_SCHED; PG8_LDA(At, 0, 0); PG8_STAGE(PG8_SA(1, 1), a1 + hstepA, voffA);
            PG8_WAIT_V(8); PG8_WAIT_L(0); PG8_BAR; PG8_MMA(0, 0, At, B0); PG8_MMA(0, 1, At, B1); PG8_BAR; PG8_SCHED;
            PG8_LDA(At, 0, 1); PG8_STAGE(PG8_SB(0, 0), b2, voffB); PG8_STAGE(PG8_SB(0, 1), b2 + hstepB, voffB); PG8_STAGE(PG8_SA(0, 0), a2, voffA);
            PG8_WAIT_V(8); PG8_WAIT_L(0); PG8_BAR; PG8_MMA(1, 0, At, B0); PG8_MMA(1, 1, At, B1); PG8_BAR; PG8_SCHED;
            PG8_LDB(B0, 1, 0); PG8_LDB(B1, 1, 1); PG8_SCHED; PG8_LDA(At, 1, 0); PG8_STAGE(PG8_SA(0, 1), a2 + hstepA, voffA);
            PG8_WAIT_V(8); PG8_WAIT_L(0); PG8_BAR; PG8_MMA(0, 0, At, B0); PG8_MMA(0, 1, At, B1); PG8_BAR; PG8_SCHED;
            PG8_LDA(At, 1, 1); PG8_STAGE(PG8_SB(1, 0), b3, voffB); PG8_STAGE(PG8_SB(1, 1), b3 + hstepB, voffB); PG8_STAGE(PG8_SA(1, 0), a3, voffA);
            PG8_WAIT_V(8); PG8_WAIT_L(0); PG8_BAR; PG8_MMA(1, 0, At, B0); PG8_MMA(1, 1, At, B1); PG8_BAR; PG8_SCHED;
        }
        if (wr == 0) PG8_BAR;
        if (which) E2(acc, cur, wr, wc, fr, fq); else E(acc, cur, wr, wc, fr, fq);
        if (!has_next) break;
#pragma unroll
        for (int a = 0; a < 2; ++a)
#pragma unroll
            for (int b = 0; b < 2; ++b)
#pragma unroll
                for (int m = 0; m < 4; ++m)
#pragma unroll
                    for (int n = 0; n < 2; ++n) acc[a][b][m][n] = (f32x4){0.f, 0.f, 0.f, 0.f};
        cur = nxt; cA = nA; cB = nB; ++ui; which = nwhich;
        if (wr == 1) PG8_BAR;
    }
    PG8_WAIT_V(0);
    PG8_BAR;
#undef PG8_SA
#undef PG8_SB
#undef PG8_STAGE
#undef PG8_LDA
#undef PG8_LDB
#undef PG8_MMA
#undef PG8_WAIT_V
#undef PG8_WAIT_L
#undef PG8_BAR
#undef PG8_SCHED
}
}

typedef f32x4 Acc[2][2][4][2];
__device__ __forceinline__ bool epi_fence() { asm volatile("" ::: "memory"); return true; }
#define EPI_ROWS(u, wr, fr) const int row0_ = (u).pm * 256 + (wr) * 64 + (fr);
#define EPI_LOADV(v) float v[8]; { const f32x4 a0_ = acc[ai][bj][m][0], a1_ = acc[ai][bj][m][1]; v[0] = a0_[0]; v[1] = a0_[1]; v[2] = a0_[2]; v[3] = a0_[3]; v[4] = a1_[0]; v[5] = a1_[1]; v[6] = a1_[2]; v[7] = a1_[3]; }
constexpr int RTAB_OFF = 131072;
template <int NSLOT>
__device__ __forceinline__ void fill_rtab(LAS unsigned char* lds, const float* ss, int pm, float inv_n, float mul) {
    int tid_ = threadIdx.x; asm volatile("" : "+v"(tid_));
    if (tid_ < 256) { const float* s = ss + ((size_t)pm * 256 + tid_) * NSLOT; const float t = NSLOT == 16 ? sum16(s) : sum4(s);
        ((LAS float*)(lds + RTAB_OFF))[tid_] = rsqrtf(t * inv_n + EPS) * mul; }
    asm volatile("s_waitcnt lgkmcnt(0)" ::: "memory"); __builtin_amdgcn_s_barrier(); asm volatile("" ::: "memory");
}
#define RTAB(ai, m) (((const LAS float*)(lds + RTAB_OFF))[(ai) * 128 + wr * 64 + (m) * 16 + fr])

struct EpiZ {
    bf16_t* Z; const float* ssx; float* ssq; float* sskv; const int* pos; LAS unsigned char* lds;
    __device__ __forceinline__ void operator()(const Acc& acc, const pg8::Unit& u, int wr, int wc, int fr, int fq) const {
        EPI_ROWS(u, wr, fr)
        { volatile LAS int* lastpm = (volatile LAS int*)(lds + 131072 + 1024 + 16);
          if (lastpm[0] != u.pm) { fill_rtab<16>(lds, ssx, u.pm, 1.f / 1024.f, 1.f); int t_ = threadIdx.x; asm volatile("" : "+v"(t_)); if (t_ == 0) lastpm[0] = u.pm; } }
        const int pn = u.pn;
        const int cbase = pn * 256 + wc * 32 + 8 * fq;
#pragma unroll
        for (int ai = 0; ai < 2; ++ai)
#pragma unroll
        for (int m = 0; m < 4; ++m) {
            const int row = row0_ + ai * 128 + m * 16;
            const float rstd = RTAB(ai, m);
            bf16_t* zr = Z + (size_t)row * ZW + cbase;
            float st = 0.f; u32x4 gq8 = (u32x4){0u, 0u, 0u, 0u};
#pragma unroll
            for (int bj = 0; bj < 2; ++bj) {
                EPI_LOADV(v)
#pragma unroll
                for (int j = 0; j < 8; ++j) v[j] *= rstd;
                bool store = true;
                if (pn <= 1) {
#pragma unroll
                    for (int j = 0; j < 8; ++j) v[j] *= (0.125f * LOG2E);
                } else if (pn == 3 || pn == 4 || pn == 7 || pn == 8) {
#pragma unroll
                    for (int j = 0; j < 8; ++j) v[j] = fsilu(v[j]);
                } else if (pn >= 9) {
#pragma unroll
                    for (int j = 0; j < 8; ++j) v[j] = fsigmoid(v[j]);
                } else if (pn == 5) {
#pragma unroll
                    for (int j = 0; j < 8; ++j) st += v[j] * v[j];
                } else if (pn == 6) {
                    if (bj == 0) {
#pragma unroll
                        for (int j = 0; j < 8; ++j) st += v[j] * v[j];
                    } else {
                        if (wc == 0) rope8(v, 4 * fq, (float)pos[row]); else store = false;
                    }
                }
                if (pn >= 9) {
                    u32x2 q8;
                    q8.x = (unsigned)(v[0] * 255.f + 0.5f) | ((unsigned)(v[1] * 255.f + 0.5f) << 8) | ((unsigned)(v[2] * 255.f + 0.5f) << 16) | ((unsigned)(v[3] * 255.f + 0.5f) << 24);
                    q8.y = (unsigned)(v[4] * 255.f + 0.5f) | ((unsigned)(v[5] * 255.f + 0.5f) << 8) | ((unsigned)(v[6] * 255.f + 0.5f) << 16) | ((unsigned)(v[7] * 255.f + 0.5f) << 24);
                    if (bj == 0) { gq8.x = q8.x; gq8.y = q8.y; } else { gq8.z = q8.x; gq8.w = q8.y; }
                } else if (store) *(u32x4*)(zr + bj * 128) = pack8(v);
            }
            if (pn >= 9) *(u32x4*)((unsigned char*)(Z + (size_t)row * ZW + ZC_MA) + (pn - 9) * 256 + (wc * 32 + 8 * fq) * 2) = gq8;
            if (pn == 5 || pn == 6) {
                st += __shfl_xor(st, 16); st += __shfl_xor(st, 32);
                if (fq == 0) { if (pn == 5) ssq[(size_t)row * 4 + wc] = st; else sskv[(size_t)row * 4 + wc] = st; }
            }
        }
    }
};
struct EpiQB {
    bf16_t* QB; const float* ssq; const int* pos; LAS unsigned char* lds;
    __device__ __forceinline__ void operator()(const Acc& acc, const pg8::Unit& u, int wr, int wc, int fr, int fq) const {
        EPI_ROWS(u, wr, fr)
        fill_rtab<4>(lds, ssq, u.pm, 1.f / 256.f, 0.10206207261596577f * LOG2E);
        const int cbase = u.pn * 256 + wc * 32 + 8 * fq;
        const int c0 = cbase, c1 = cbase + 128, cc0 = c0 % 96, cc1 = c1 % 96;
        const bool anyrope = (cc0 >= 64) || (cc1 >= 64);
#pragma unroll
        for (int ai = 0; ai < 2; ++ai)
#pragma unroll
        for (int m = 0; m < 4; ++m) {
            const int row = row0_ + ai * 128 + m * 16;
            epi_fence();
            const float rstd = RTAB(ai, m);
            float posf = 0.f; if (anyrope) posf = (float)pos[row];
#pragma unroll
            for (int bj = 0; bj < 2; ++bj) {
                EPI_LOADV(v)
#pragma unroll
                for (int j = 0; j < 8; ++j) v[j] *= rstd;
                const int cc = bj ? cc1 : cc0;
                if (cc >= 64) rope8(v, (cc - 64) >> 1, posf);
                *(u32x4*)(QB + (size_t)row * 768 + cbase + bj * 128) = pack8(v);
            }
        }
    }
};
struct EpiKVB {
    bf16_t* KVB; const float* sskv; LAS unsigned char* lds;
    __device__ __forceinline__ void operator()(const Acc& acc, const pg8::Unit& u, int wr, int wc, int fr, int fq) const {
        EPI_ROWS(u, wr, fr)
        fill_rtab<4>(lds, sskv, u.pm, 1.f / 128.f, 1.f);
        const int cbase = u.pn * 256 + wc * 32 + 8 * fq;
#pragma unroll
        for (int ai = 0; ai < 2; ++ai)
#pragma unroll
        for (int m = 0; m < 4; ++m) {
            const int row = row0_ + ai * 128 + m * 16;
            const float rstd = RTAB(ai, m);
#pragma unroll
            for (int bj = 0; bj < 2; ++bj) {
                EPI_LOADV(v)
#pragma unroll
                for (int j = 0; j < 8; ++j) v[j] *= rstd;
                *(u32x4*)(KVB + (size_t)row * 1024 + cbase + bj * 128) = pack8(v);
            }
        }
    }
};
template <int SECOND> struct EpiMerge {
    bf16_t* Z; bf16_t* Y;
    __device__ __forceinline__ void operator()(const Acc& acc, const pg8::Unit& u, int wr, int wc, int fr, int fq) const {
        EPI_ROWS(u, wr, fr)
        const int cbase = u.pn * 256 + wc * 32 + 8 * fq;
#pragma unroll
        for (int ai = 0; ai < 2; ++ai) {
            epi_fence();
            u32x4 sgq[4]; u32x4 tg[4][2];
#pragma unroll
            for (int m = 0; m < 4; ++m) { const bf16_t* zr = Z + (size_t)(row0_ + ai * 128 + m * 16) * ZW;
                sgq[m] = *(const u32x4*)((const unsigned char*)(zr + ZC_MA) + (SECOND ? 1024 : 0) + u.pn * 256 + (wc * 32 + 8 * fq) * 2);
#pragma unroll
                for (int bj = 0; bj < 2; ++bj) { if (SECOND) tg[m][bj] = *(const u32x4*)(zr + ZC_MB + cbase + bj * 128); } }
#pragma unroll
            for (int m = 0; m < 4; ++m)
#pragma unroll
                for (int bj = 0; bj < 2; ++bj) {
                    EPI_LOADV(v)
                    const unsigned g0 = bj ? sgq[m].z : sgq[m].x, g1 = bj ? sgq[m].w : sgq[m].y;
                    const float s[8] = {(float)(g0 & 255u), (float)((g0 >> 8) & 255u), (float)((g0 >> 16) & 255u), (float)(g0 >> 24), (float)(g1 & 255u), (float)((g1 >> 8) & 255u), (float)((g1 >> 16) & 255u), (float)(g1 >> 24)};
#pragma unroll
                    for (int j = 0; j < 8; ++j) v[j] *= s[j] * (1.f / 255.f);
                    if (SECOND) { float t[8]; unpack8(tg[m][bj], t);
#pragma unroll
                        for (int j = 0; j < 8; ++j) v[j] += t[j];
                        *(u32x4*)(Y + (size_t)(row0_ + ai * 128 + m * 16) * 1024 + cbase + bj * 128) = pack8(v); }
                    else *(u32x4*)(Z + (size_t)(row0_ + ai * 128 + m * 16) * ZW + ZC_MB + cbase + bj * 128) = pack8(v);
                }
        }
    }
};
template <int BF> struct EpiX1 {
    const float* xin; const bf16_t* xinb; bf16_t* Z; float* ssb;
    __device__ __forceinline__ void operator()(const Acc& acc, const pg8::Unit& u, int wr, int wc, int fr, int fq) const {
        EPI_ROWS(u, wr, fr)
        const int cbase = u.pn * 256 + wc * 32 + 8 * fq;
#pragma unroll
        for (int ai = 0; ai < 2; ++ai) {
            epi_fence();
            float stv[4];
            f32x4 xa[4][2][2]; u32x4 xh[4][2];
#pragma unroll
            for (int m = 0; m < 4; ++m)
#pragma unroll
                for (int bj = 0; bj < 2; ++bj) { const size_t o_ = (size_t)(row0_ + ai * 128 + m * 16) * D + cbase + bj * 128;
                    if (BF) xh[m][bj] = *(const u32x4*)(xinb + o_); else { xa[m][bj][0] = *(const f32x4*)(xin + o_); xa[m][bj][1] = *(const f32x4*)(xin + o_ + 4); } }
#pragma unroll
            for (int m = 0; m < 4; ++m) {
                const int row = row0_ + ai * 128 + m * 16;
                float st = 0.f;
#pragma unroll
                for (int bj = 0; bj < 2; ++bj) {
                    EPI_LOADV(v)
                    if (BF) { float xv[8]; unpack8(xh[m][bj], xv);
#pragma unroll
                        for (int j = 0; j < 8; ++j) v[j] += xv[j]; }
                    else { const f32x4 x0 = xa[m][bj][0], x1 = xa[m][bj][1];
                        v[0] += x0[0]; v[1] += x0[1]; v[2] += x0[2]; v[3] += x0[3]; v[4] += x1[0]; v[5] += x1[1]; v[6] += x1[2]; v[7] += x1[3]; }
#pragma unroll
                    for (int j = 0; j < 8; ++j) st += v[j] * v[j];
                    *(u32x4*)(Z + (size_t)row * ZW + ZC_X1B + cbase + bj * 128) = pack8(v);
                }
                st += __shfl_xor(st, 16); st += __shfl_xor(st, 32);
                stv[m] = st;
            }
            ssb[(size_t)(row0_ + ai * 128 + fq * 16) * 16 + u.pn * 4 + wc] = (fq == 0 ? stv[0] : fq == 1 ? stv[1] : fq == 2 ? stv[2] : stv[3]);
        }
    }
};
struct EpiPP {
    bf16_t* Z;
    __device__ __forceinline__ void operator()(const Acc& acc, const pg8::Unit& u, int wr, int wc, int fr, int fq) const {
        EPI_ROWS(u, wr, fr)
        const int cbase = u.pn * 256 + wc * 32 + 8 * fq;
#pragma unroll
        for (int ai = 0; ai < 2; ++ai)
#pragma unroll
        for (int m = 0; m < 4; ++m) {
            const int row = row0_ + ai * 128 + m * 16;
#pragma unroll
            for (int bj = 0; bj < 2; ++bj) { EPI_LOADV(v) *(u32x4*)(Z + (size_t)row * ZW + ZC_T2 + cbase + bj * 128) = pack8(v); }
        }
    }
};
struct EpiX2 {
    float* xio; const bf16_t* Z; bf16_t* xb; const float* ssb; float* ssa; LAS unsigned char* lds; bool write_xb;
    __device__ __forceinline__ void operator()(const Acc& acc, const pg8::Unit& u, int wr, int wc, int fr, int fq) const {
        EPI_ROWS(u, wr, fr)
        fill_rtab<16>(lds, ssb, u.pm, 1.f / 1024.f, 1.f);
        const int cbase = u.pn * 256 + wc * 32 + 8 * fq;
#pragma unroll
        for (int ai = 0; ai < 2; ++ai) {
        float stv[4];
#pragma unroll
        for (int mp = 0; mp < 2; ++mp) {
            epi_fence();
            u32x4 xa[2][2], tg[2][2];
#pragma unroll
            for (int mm = 0; mm < 2; ++mm)
#pragma unroll
                for (int bj = 0; bj < 2; ++bj) { const int row = row0_ + ai * 128 + (mp * 2 + mm) * 16; const bf16_t* zp = Z + (size_t)row * ZW + cbase + bj * 128;
                    xa[mm][bj] = *(const u32x4*)(zp + ZC_X1B); tg[mm][bj] = *(const u32x4*)(zp + ZC_T2); }
#pragma unroll
            for (int mm = 0; mm < 2; ++mm) {
                const int m = mp * 2 + mm;
                const int row = row0_ + ai * 128 + m * 16;
                const float rstd = RTAB(ai, m);
                float st = 0.f;
#pragma unroll
                for (int bj = 0; bj < 2; ++bj) {
                    EPI_LOADV(v)
                    const size_t off = (size_t)row * D + cbase + bj * 128;
                    float t[8]; unpack8(tg[mm][bj], t);
                    float xv[8]; unpack8(xa[mm][bj], xv);
#pragma unroll
                    for (int j = 0; j < 8; ++j) { v[j] = xv[j] + fsigmoid(v[j] * rstd) * t[j]; st += v[j] * v[j]; }
                    *(u32x4*)(xb + off) = pack8(v);
                }
                st += __shfl_xor(st, 16); st += __shfl_xor(st, 32);
                stv[m] = st;
            }
        }
        ssa[(size_t)(row0_ + ai * 128 + fq * 16) * 16 + u.pn * 4 + wc] = (fq == 0 ? stv[0] : fq == 1 ? stv[1] : fq == 2 ? stv[2] : stv[3]);
        }
    }
};


struct EpiX2F {
    float* out; const bf16_t* Z; const float* ssb; float* ssa; const float* gfin; unsigned* cnt; LAS unsigned char* lds;
    __device__ __forceinline__ void operator()(Acc& acc, const pg8::Unit& u, int wr, int wc, int fr, int fq) const {
        EPI_ROWS(u, wr, fr)
        fill_rtab<16>(lds, ssb, u.pm, 1.f / 1024.f, 1.f);
        const int cbase = u.pn * 256 + wc * 32 + 8 * fq;
#pragma unroll
        for (int ai = 0; ai < 2; ++ai) {
        float stv[4];
#pragma unroll
        for (int mp = 0; mp < 2; ++mp) {
            epi_fence();
            u32x4 xa[2][2], tg[2][2];
#pragma unroll
            for (int mm = 0; mm < 2; ++mm)
#pragma unroll
                for (int bj = 0; bj < 2; ++bj) { const int row = row0_ + ai * 128 + (mp * 2 + mm) * 16; const bf16_t* zp = Z + (size_t)row * ZW + cbase + bj * 128;
                    xa[mm][bj] = *(const u32x4*)(zp + ZC_X1B); tg[mm][bj] = *(const u32x4*)(zp + ZC_T2); }
#pragma unroll
            for (int mm = 0; mm < 2; ++mm) {
                const int m = mp * 2 + mm;
                const int row = row0_ + ai * 128 + m * 16;
                const float rstd = RTAB(ai, m);
                float st = 0.f;
#pragma unroll
                for (int bj = 0; bj < 2; ++bj) {
                    EPI_LOADV(v)
                    float t[8]; unpack8(tg[mm][bj], t);
                    float xv[8]; unpack8(xa[mm][bj], xv);
#pragma unroll
                    for (int j = 0; j < 8; ++j) { v[j] = xv[j] + fsigmoid(v[j] * rstd) * t[j]; st += v[j] * v[j]; }
                    acc[ai][bj][m][0] = (f32x4){v[0], v[1], v[2], v[3]}; acc[ai][bj][m][1] = (f32x4){v[4], v[5], v[6], v[7]};
                }
                st += __shfl_xor(st, 16); st += __shfl_xor(st, 32);
                stv[m] = st;
            }
        }
        __hip_atomic_store(ssa + (size_t)(row0_ + ai * 128 + fq * 16) * 16 + u.pn * 4 + wc, (fq == 0 ? stv[0] : fq == 1 ? stv[1] : fq == 2 ? stv[2] : stv[3]), __ATOMIC_RELAXED, __HIP_MEMORY_SCOPE_AGENT);
        }
        asm volatile("s_waitcnt vmcnt(0)" ::: "memory"); __builtin_amdgcn_s_barrier(); asm volatile("" ::: "memory");
        int tid_ = threadIdx.x; asm volatile("" : "+v"(tid_));
        if (tid_ == 0) {
            __hip_atomic_fetch_add(cnt + u.pm, 1u, __ATOMIC_RELAXED, __HIP_MEMORY_SCOPE_AGENT);
            unsigned sp = 0; while (__hip_atomic_load(cnt + u.pm, __ATOMIC_RELAXED, __HIP_MEMORY_SCOPE_AGENT) < 4u && ++sp < (1u << 22)) __builtin_amdgcn_s_sleep(1);
            __builtin_amdgcn_fence(__ATOMIC_ACQUIRE, "agent"); asm volatile("s_waitcnt vmcnt(0)" ::: "memory");
        }
        asm volatile("s_waitcnt vmcnt(0) lgkmcnt(0)" ::: "memory"); __builtin_amdgcn_s_barrier(); asm volatile("" ::: "memory");
        if (tid_ < 256) { const float* sp_ = ssa + ((size_t)u.pm * 256 + tid_) * 16; float t = 0.f;
#pragma unroll
            for (int k = 0; k < 16; ++k) t += __hip_atomic_load(sp_ + k, __ATOMIC_RELAXED, __HIP_MEMORY_SCOPE_AGENT);
            ((LAS float*)(lds + RTAB_OFF))[tid_] = rsqrtf(t * (1.f / 1024.f) + EPS); }
        asm volatile("s_waitcnt lgkmcnt(0)" ::: "memory"); __builtin_amdgcn_s_barrier(); asm volatile("" ::: "memory");
        f32x4 gq[2][2];
#pragma unroll
        for (int bj = 0; bj < 2; ++bj) { gq[bj][0] = *(const f32x4*)(gfin + cbase + bj * 128); gq[bj][1] = *(const f32x4*)(gfin + cbase + bj * 128 + 4); }
#pragma unroll
        for (int ai = 0; ai < 2; ++ai)
#pragma unroll
        for (int m = 0; m < 4; ++m) {
            const int row = row0_ + ai * 128 + m * 16;
            const float r2 = RTAB(ai, m);
#pragma unroll
            for (int bj = 0; bj < 2; ++bj) { const size_t off = (size_t)row * D + cbase + bj * 128;
                *(f32x4*)(out + off) = acc[ai][bj][m][0] * r2 * gq[bj][0]; *(f32x4*)(out + off + 4) = acc[ai][bj][m][1] * r2 * gq[bj][1]; }
        }
    }
};

namespace att {
typedef short v4i16_t __attribute__((ext_vector_type(4)));
template <int MODE> struct Cfg { static constexpr int DQK = MODE == 0 ? 96 : 64, KROW = DQK + 8, KBUF = 64 * KROW * 2, VBUF = 8192, PBUF = 256, BUF = KBUF + VBUF + PBUF; };
#define MX3(a, b, c) __builtin_fmaxf(__builtin_fmaxf((a), (b)), (c))
__device__ __forceinline__ float rowmax32(const f32x16& p0, const f32x16& p1) {
    float a = MX3(p0[0], p0[1], p1[0]), b = MX3(p0[2], p0[3], p1[1]); a = MX3(a, p1[2], p1[3]);
#pragma unroll
    for (int r = 4; r < 16; r += 4) { a = MX3(a, p0[r], p0[r + 1]); b = MX3(b, p0[r + 2], p0[r + 3]); a = MX3(a, p1[r], p1[r + 1]); b = MX3(b, p1[r + 2], p1[r + 3]); }
    const float m = __builtin_fmaxf(a, b); auto rr = __builtin_amdgcn_permlane32_swap(__float_as_uint(m), __float_as_uint(m), false, false);
    return __builtin_fmaxf(__uint_as_float(rr[0]), __uint_as_float(rr[1])); }
__device__ __forceinline__ bf16x8 vfrag(const LAS unsigned char* p) {
    const v4i16_t lo = __builtin_amdgcn_ds_read_tr16_b64_v4i16((LAS v4i16_t*)p), hi = __builtin_amdgcn_ds_read_tr16_b64_v4i16((LAS v4i16_t*)(p + 512));
    return (bf16x8){lo[0], lo[1], lo[2], lo[3], hi[0], hi[1], hi[2], hi[3]}; }

template <int MODE>
__device__ __forceinline__ void attn_mode(LAS unsigned char* lds, const bf16_t* QB, const bf16_t* KVB, bf16_t* Z, const int* pos, const float* sink, int u_begin, int u_end, int u_step) {
    typedef Cfg<MODE> C;
    constexpr int DQK = C::DQK, KROW = C::KROW, NKS = DQK / 16;
    asm volatile("" : "+s"(u_begin));
    if (u_begin >= u_end) return;
    int tid_ = threadIdx.x; asm volatile("" : "+v"(tid_));
    const int tid = tid_, w = __builtin_amdgcn_readfirstlane(tid >> 6), lane = tid & 63, lq = lane & 31, hh = lane >> 5;
#define ATT_DECODE(u_, b_, hk_, qblk_) do { if (MODE == 0) { const int bh_ = (u_) & 255; qblk_ = 7 - ((u_) >> 8); b_ = bh_ >> 3; hk_ = bh_ & 7; } else { const int v_ = (u_) - 2048; b_ = v_ >> 6; hk_ = (v_ >> 5) & 1; qblk_ = v_ & 31; } } while (0)
#define ATT_GEOM(qblk_, hk_, wq0_, hq_, j0_) do { if (MODE == 0) { wq0_ = (qblk_) * 256 + 32 * w; hq_ = (hk_); j0_ = 0; } else { wq0_ = (qblk_) * 64 + 32 * (w >> 2); hq_ = (hk_) * 4 + (w & 3); j0_ = (qblk_) - 2; if (j0_ < 0) j0_ = 0; } } while (0)
#define ATT_QLOAD(tq_, hq_) do { _Pragma("unroll") for (int ks = 0; ks < NKS; ++ks) { \
        if (MODE == 0) qf[ks] = *(const bf16x8*)(QB + (tq_) * 768 + (hq_) * 96 + ks * 16 + hh * 8); \
        else qf[ks] = *(const bf16x8*)(Z + (tq_) * ZW + ZC_QA + (hq_) * 64 + ks * 16 + hh * 8); } } while (0)
    bf16x8 qf[NKS];
    u32x4 sk0, sk1, sv; int sp = 0;
    sk1 = (u32x4){0u, 0u, 0u, 0u};
    u32x4 nk0, nk1, nv; int np = 0;
    nk0 = nk1 = nv = (u32x4){0u, 0u, 0u, 0u};
    const int vkey = tid >> 3, vpart = tid & 7;
    const int vwr = (vpart >> 2) * 4096 + vkey * 64 + (vpart & 3) * 16;
    const int vrd = (4 * hh + ((lane & 15) >> 2)) * 64 + ((lane >> 4) & 1) * 32 + (lane & 3) * 8;
    const char *pk0 = nullptr, *pk1 = nullptr, *pvv = nullptr, *ppp = nullptr; unsigned inc0 = 0, inc1 = 0;
    int kst0, kst1;
    if (MODE == 0) { kst0 = ((tid / 12) * KROW + (tid % 12) * 8) * 2; kst1 = (((tid + 512) / 12) * KROW + ((tid + 512) % 12) * 8) * 2; }
    else { kst0 = (vkey * KROW + vpart * 8) * 2; kst1 = 0; }
#define ATT_SETUP(tok0, hk, j) do { const size_t kt = (tok0) + (size_t)(j) * 64; \
        if (MODE == 0) { { const int key = tid / 12, part = tid % 12; pk0 = (const char*)(part < 8 ? KVB + (kt + key) * 1024 + (hk) * 128 + part * 8 : Z + (kt + key) * ZW + ZC_KR + (part - 8) * 8); inc0 = part < 8 ? 64u * 1024u * 2u : 64u * ZW * 2u; } \
            { const int c2 = tid + 512, key = c2 / 12, part = c2 % 12; pk1 = (const char*)(part < 8 ? KVB + (kt + key) * 1024 + (hk) * 128 + part * 8 : Z + (kt + key) * ZW + ZC_KR + (part - 8) * 8); inc1 = part < 8 ? 64u * 1024u * 2u : 64u * ZW * 2u; } \
            pvv = (const char*)(KVB + (kt + vkey) * 1024 + (hk) * 128 + 64 + vpart * 8); } \
        else { pk0 = (const char*)(Z + (kt + vkey) * ZW + ZC_KA + (hk) * 64 + vpart * 8); pvv = (const char*)(Z + (kt + vkey) * ZW + ZC_VA + (hk) * 64 + vpart * 8); ppp = (const char*)(pos + kt + (tid & 63)); } } while (0)
#define ATT_LOADP(K0, K1, VV, PP) do { \
        if (MODE == 0) { K0 = *(const u32x4*)pk0; pk0 += inc0; if (tid < 256) { K1 = *(const u32x4*)pk1; pk1 += inc1; } VV = *(const u32x4*)pvv; pvv += 64 * 1024 * 2; } \
        else { K0 = *(const u32x4*)pk0; pk0 += 64 * ZW * 2; VV = *(const u32x4*)pvv; pvv += 64 * ZW * 2; if (tid < 64) PP = *(const int*)ppp; ppp += 256; } } while (0)
    { int b_, hk_, qblk_, wq0_, hq_, j0_; ATT_DECODE(u_begin, b_, hk_, qblk_); ATT_GEOM(qblk_, hk_, wq0_, hq_, j0_);
      const size_t tok0_ = (size_t)b_ * SEQ; ATT_QLOAD(tok0_ + wq0_ + lq, hq_); ATT_SETUP(tok0_, hk_, j0_); ATT_LOADP(sk0, sk1, sv, sp); }
    for (int u = u_begin; u < u_end; u += u_step) {
    int b, hk, qblk; ATT_DECODE(u, b, hk, qblk);
    const size_t tok0 = (size_t)b * SEQ;
    int wq0, hq, j0; ATT_GEOM(qblk, hk, wq0, hq, j0);
    const int q0 = MODE == 0 ? qblk * 256 : qblk * 64;
    const int qq = wq0 + lq;
    const size_t tq = tok0 + qq;
    const int j1 = MODE == 0 ? (q0 + 256) / 64 - 1 : q0 / 64;
    float slope_l2 = 0.f, pqf = 0.f, mrun, lrun;
    if (MODE == 1) { slope_l2 = exp2f(-(float)(hq + 1)) * LOG2E; pqf = (float)pos[tq]; mrun = sink[hq] * LOG2E; lrun = hh == 0 ? 1.f : 0.f; }
    else { mrun = 0.f; lrun = 0.f; }
    f32x16 O0, O1, negm;
#pragma unroll
    for (int i = 0; i < 16; ++i) { O0[i] = 0.f; O1[i] = 0.f; negm[i] = 0.f; }
    bool first = true;
    if (MODE == 1) {
#pragma unroll
        for (int i = 0; i < 16; ++i) negm[i] = -slope_l2 * pqf; }

#define ATT_STORE(bufi) do { LAS unsigned char* bb = lds + (bufi) * C::BUF; \
        *(LAS u32x4*)(bb + kst0) = sk0; \
        if (MODE == 0) { if (tid < 256) *(LAS u32x4*)(bb + kst1) = sk1; } \
        else { if (tid < 64) ((LAS float*)(bb + C::KBUF + C::VBUF))[tid] = (float)sp; } \
        *(LAS u32x4*)(bb + C::KBUF + vwr) = sv; } while (0)
#define ATT_STORE2(bufi, K0, K1, VV, PP) do { LAS unsigned char* bb = lds + (bufi) * C::BUF; \
        *(LAS u32x4*)(bb + kst0) = K0; \
        if (MODE == 0) { if (tid < 256) *(LAS u32x4*)(bb + kst1) = K1; } \
        else { if (tid < 64) ((LAS float*)(bb + C::KBUF + C::VBUF))[tid] = (float)PP; } \
        *(LAS u32x4*)(bb + C::KBUF + vwr) = VV; } while (0)
#define ATT_BAR() do { asm volatile("s_waitcnt lgkmcnt(0)" ::: "memory"); __builtin_amdgcn_s_barrier(); asm volatile("" ::: "memory"); } while (0)

#define ATT_TILE(j, bufi) do { \
        const int k0 = j * 64; \
        const bool active = (MODE == 1) || (k0 <= wq0 + 31); \
        if (active) { \
            const LAS unsigned char* bb = lds + bufi * C::BUF; const LAS bf16_t* Kb = (const LAS bf16_t*)bb; const LAS unsigned char* Vb = bb + C::KBUF + vrd; \
            f32x16 S0, S1; \
            S0 = negm; S1 = negm; \
            bf16x8 kf[2 * NKS]; \
_Pragma("unroll") \
            for (int ks = 0; ks < NKS; ++ks) { \
                kf[2 * ks] = *(const LAS bf16x8*)(Kb + lq * KROW + ks * 16 + hh * 8); \
                kf[2 * ks + 1] = *(const LAS bf16x8*)(Kb + (32 + lq) * KROW + ks * 16 + hh * 8); \
            } \
            __builtin_amdgcn_sched_barrier(0); \
_Pragma("unroll") \
            for (int ks = 0; ks < NKS; ++ks) { \
                S0 = __builtin_amdgcn_mfma_f32_32x32x16_bf16(kf[2 * ks], qf[ks], S0, 0, 0, 0); \
                S1 = __builtin_amdgcn_mfma_f32_32x32x16_bf16(kf[2 * ks + 1], qf[ks], S1, 0, 0, 0); \
            } \
            if (MODE == 1) { \
                const LAS float* pk = (const LAS float*)(bb + C::KBUF + C::VBUF) + 4 * hh; \
                const bool allv = (k0 + 63 <= wq0) && (wq0 + 31 - k0 < 128); \
                const int d0 = qq - k0 - 4 * hh; \
                if (allv) { \
_Pragma("unroll") \
                    for (int i4 = 0; i4 < 4; ++i4) { \
                        const f32x4 pa = *(const LAS f32x4*)(pk + 8 * i4), pb = *(const LAS f32x4*)(pk + 32 + 8 * i4); \
_Pragma("unroll") \
                        for (int ii = 0; ii < 4; ++ii) { S0[4 * i4 + ii] = __builtin_fmaf(slope_l2, pa[ii], S0[4 * i4 + ii]); S1[4 * i4 + ii] = __builtin_fmaf(slope_l2, pb[ii], S1[4 * i4 + ii]); } \
                    } \
                } else { \
_Pragma("unroll") \
                    for (int i4 = 0; i4 < 4; ++i4) { \
                        const f32x4 pa = *(const LAS f32x4*)(pk + 8 * i4), pb = *(const LAS f32x4*)(pk + 32 + 8 * i4); \
_Pragma("unroll") \
                        for (int ii = 0; ii < 4; ++ii) { \
                            const float sa = __builtin_fmaf(slope_l2, pa[ii], S0[4 * i4 + ii]), sb = __builtin_fmaf(slope_l2, pb[ii], S1[4 * i4 + ii]); \
                            S0[4 * i4 + ii] = ((unsigned)(d0 - (8 * i4 + ii)) < 128u) ? sa : -1e30f; S1[4 * i4 + ii] = ((unsigned)(d0 - (32 + 8 * i4 + ii)) < 128u) ? sb : -1e30f; \
                        } \
                    } \
                } \
            } else if (k0 + 63 > wq0) { \
_Pragma("unroll") \
                for (int i = 0; i < 16; ++i) { \
                    const int ka_i = k0 + 8 * (i >> 2) + 4 * hh + (i & 3); \
                    if (ka_i > qq) S0[i] = -1e30f; \
                    if (ka_i + 32 > qq) S1[i] = -1e30f; \
                } \
            } \
            const float mx = rowmax32(S0, S1); \
            if (MODE == 0) { \
                if (first || __builtin_amdgcn_ballot_w64(mx > 8.f) != 0ull) { \
                    const float delta = first ? mx : fmaxf(mx, 0.f); \
                    const float alpha = first ? 1.f : __builtin_amdgcn_exp2f(-delta); \
                    mrun += delta; lrun *= alpha; \
_Pragma("unroll") \
                    for (int i = 0; i < 16; ++i) { S0[i] -= delta; S1[i] -= delta; O0[i] *= alpha; O1[i] *= alpha; negm[i] = -mrun; } \
                    first = false; \
                } \
            } else { \
                const float mnew = fmaxf(mrun, mx); \
                const float alpha = __builtin_amdgcn_exp2f(mrun - mnew); \
                mrun = mnew; lrun *= alpha; \
_Pragma("unroll") \
                for (int i = 0; i < 16; ++i) { S0[i] -= mnew; S1[i] -= mnew; O0[i] *= alpha; O1[i] *= alpha; } \
            } \
            bf16x8 va0[4], va1[4]; \
_Pragma("unroll") \
            for (int t4 = 0; t4 < 4; ++t4) { va0[t4] = vfrag(Vb + t4 * 1024); va1[t4] = vfrag(Vb + 4096 + t4 * 1024); } \
            float ps = 0.f; \
_Pragma("unroll") \
            for (int g = 0; g < 4; ++g) { \
                float e[8]; \
_Pragma("unroll") \
                for (int i = 0; i < 8; ++i) { e[i] = __builtin_amdgcn_exp2f(g < 2 ? S0[8 * (g & 1) + i] : S1[8 * (g & 1) + i]); } \
                ps += ((e[0] + e[1]) + (e[2] + e[3])) + ((e[4] + e[5]) + (e[6] + e[7])); \
                u32x4 a; a.x = cvt_pk_bf16(e[0], e[1]); a.y = cvt_pk_bf16(e[2], e[3]); a.z = cvt_pk_bf16(e[4], e[5]); a.w = cvt_pk_bf16(e[6], e[7]); \
                const bf16x8 pfg = __builtin_bit_cast(bf16x8, a); \
                O0 = __builtin_amdgcn_mfma_f32_32x32x16_bf16(va0[g], pfg, O0, 0, 0, 0); \
                O1 = __builtin_amdgcn_mfma_f32_32x32x16_bf16(va1[g], pfg, O1, 0, 0, 0); \
                __builtin_amdgcn_sched_barrier(0); \
            } \
            lrun += ps; \
        } \
    } while (0)
    ATT_STORE(0);
    ATT_BAR();
    if (j0 < j1) ATT_LOADP(sk0, sk1, sv, sp);
    for (int j = j0; ; ) {
        if (j + 2 <= j1) ATT_LOADP(nk0, nk1, nv, np);
        ATT_TILE(j, 0);
        if (j < j1) ATT_STORE2(1, sk0, sk1, sv, sp);
        ATT_BAR();
        if (++j > j1) break;
        if (j + 2 <= j1) ATT_LOADP(sk0, sk1, sv, sp);
        ATT_TILE(j, 1);
        if (j < j1) ATT_STORE2(0, nk0, nk1, nv, np);
        ATT_BAR();
        if (++j > j1) break;
    }
#undef ATT_TILE
    const float ltot = lrun + __shfl_xor(lrun, 32);
    const float inv = 1.f / ltot;
    if (u + u_step < u_end) {
        int b_, hk_, qblk_, wq0_, hq_, j0_; ATT_DECODE(u + u_step, b_, hk_, qblk_); ATT_GEOM(qblk_, hk_, wq0_, hq_, j0_);
        const size_t tok0_ = (size_t)b_ * SEQ; ATT_QLOAD(tok0_ + wq0_ + lq, hq_); ATT_SETUP(tok0_, hk_, j0_); ATT_LOADP(sk0, sk1, sv, sp); }
    LAS unsigned char* ost = lds + 65536 + w * 4608;
#pragma unroll
    for (int i4 = 0; i4 < 4; ++i4) {
        const int dv0 = 8 * i4 + 4 * hh;
        u32x2 o;
        o.x = cvt_pk_bf16(O0[4 * i4 + 0] * inv, O0[4 * i4 + 1] * inv); o.y = cvt_pk_bf16(O0[4 * i4 + 2] * inv, O0[4 * i4 + 3] * inv);
        *(LAS u32x2*)(ost + lq * 144 + dv0 * 2) = o;
        o.x = cvt_pk_bf16(O1[4 * i4 + 0] * inv, O1[4 * i4 + 1] * inv); o.y = cvt_pk_bf16(O1[4 * i4 + 2] * inv, O1[4 * i4 + 3] * inv);
        *(LAS u32x2*)(ost + lq * 144 + 64 + dv0 * 2) = o;
    }
    asm volatile("s_waitcnt lgkmcnt(0)" ::: "memory");
    {
        const int chunk = lane & 7;
        bf16_t* obase = Z + (tok0 + wq0) * ZW + (MODE == 0 ? ZC_GB : ZC_GA) + hq * 64 + chunk * 8;
        u32x4 gv[4], ov[4];
#pragma unroll
        for (int k = 0; k < 4; ++k) { const int row = (lane >> 3) + 8 * k; gv[k] = *(const u32x4*)(obase + (size_t)row * ZW); ov[k] = *(const LAS u32x4*)(ost + row * 144 + chunk * 16); }
#pragma unroll
        for (int k = 0; k < 4; ++k) { const int row = (lane >> 3) + 8 * k; float a[8], g[8]; unpack8(ov[k], a); unpack8(gv[k], g);
#pragma unroll
            for (int e = 0; e < 8; ++e) a[e] *= g[e];
            *(u32x4*)(obase + (size_t)row * ZW) = pack8(a); }
    }
    }
#undef ATT_SETUP
#undef ATT_LOADP
#undef ATT_STORE
#undef ATT_STORE2
#undef ATT_BAR
#undef ATT_DECODE
#undef ATT_GEOM
#undef ATT_QLOAD
}
#undef MX3
}

#define XB_TMO      128
#define XB_XCNT(j)  (256  + 64 * (j))
#define XB_XSUB(j)  (1280 + 64 * (j))
#define XB_XGEN(j)  (2304 + 64 * (j))
#define XB_TOP      3328
#define XB_TOPGEN   3392
#define XCD_BAR_WORDS 3456
#define XB_SPIN_CAP (1u << 18)

__device__ __forceinline__ unsigned xb_ld(unsigned* p)              { return __hip_atomic_load(p, __ATOMIC_RELAXED, __HIP_MEMORY_SCOPE_AGENT); }
__device__ __forceinline__ unsigned xb_add(unsigned* p, unsigned v) { return __hip_atomic_fetch_add(p, v, __ATOMIC_RELAXED, __HIP_MEMORY_SCOPE_AGENT); }
__device__ __forceinline__ unsigned xb_xcc_id() { return (unsigned)__builtin_amdgcn_s_getreg((3 << 11) | 20) & 0xFu; }
#define XB_SPIN(cond, bar) do { unsigned _sp = 0; while (cond) { __builtin_amdgcn_s_sleep(1); \
    if ((++_sp & 255u) == 0u) { if (xb_ld(&(bar)[XB_TMO])) break; if (_sp > XB_SPIN_CAP) { atomicAdd(&(bar)[XB_TMO], 1u); break; } } } } while (0)

struct XcdBarrier {
    unsigned* bar; unsigned x;
    volatile LAS unsigned* st;
};

__device__ __forceinline__ XcdBarrier xcd_barrier_post(unsigned* bar, volatile LAS unsigned* st) {
    XcdBarrier b; b.bar = bar; b.x = xb_xcc_id(); b.st = st;
    if (threadIdx.x == 0) (void)xb_add(&bar[XB_XCNT(b.x)], 1u);
    return b;
}
__device__ __forceinline__ void xcd_barrier_complete(unsigned* bar, unsigned x, unsigned& nloc, unsigned& nx) {
    const unsigned G = gridDim.x * gridDim.y * gridDim.z;
    unsigned sum, cnt, mine, sp = 0u;
    for (;;) {
        sum = 0u; cnt = 0u; mine = 0u;
#pragma unroll
        for (unsigned j = 0; j < 16; ++j) { const unsigned c = xb_ld(&bar[XB_XCNT(j)]); sum += c; cnt += (c > 0u) ? 1u : 0u; mine = (j == x) ? c : mine; }
        if (sum == G) break;
        __builtin_amdgcn_s_sleep(1);
        if ((++sp & 255u) == 0u) { if (xb_ld(&bar[XB_TMO])) break; if (sp > XB_SPIN_CAP) { atomicAdd(&bar[XB_TMO], 1u); break; } }
    }
    nloc = mine > 0u ? mine : 1u; nx = cnt > 0u ? cnt : 1u;
}

__device__ __forceinline__ void xcd_barrier(const XcdBarrier& b) {
    asm volatile("s_waitcnt vmcnt(0)" ::: "memory");
    __syncthreads();
    if (threadIdx.x == 0) {
        unsigned* bar = b.bar;
        __builtin_amdgcn_s_waitcnt(0);
        unsigned nloc = b.st[0], nx = b.st[1];
        if (nloc == 0u) { xcd_barrier_complete(bar, b.x, nloc, nx); b.st[0] = nloc; b.st[1] = nx; }
        const unsigned old = xb_add(&bar[XB_XSUB(b.x)], 1u);
        const unsigned gen = old / nloc;
        if (old + 1u == (gen + 1u) * nloc) {
            __builtin_amdgcn_fence(__ATOMIC_RELEASE, "agent");
            asm volatile("s_waitcnt vmcnt(0)" ::: "memory");
            const unsigned og = xb_add(&bar[XB_TOP], 1u);
            const unsigned tg = og / nx;
            if (og + 1u == (tg + 1u) * nx) xb_add(&bar[XB_TOPGEN], 1u);
            else XB_SPIN(xb_ld(&bar[XB_TOPGEN]) == tg, bar);
            __builtin_amdgcn_fence(__ATOMIC_ACQUIRE, "agent");
            xb_add(&bar[XB_XGEN(b.x)], 1u);
            asm volatile("s_waitcnt vmcnt(0)" ::: "memory");
        } else {
            XB_SPIN(xb_ld(&bar[XB_XGEN(b.x)]) == gen, bar);
            __builtin_amdgcn_fence(__ATOMIC_ACQUIRE, "agent");
            asm volatile("s_waitcnt vmcnt(0)" ::: "memory");
        }
    }
    __syncthreads();
}


__device__ __forceinline__ int colmap(int type, int n) {
    if (type == 1) {
        if (n < 1664) return n;
        if (n < 1696) { const int j = n - 1664; return 1664 + (j >> 1) + 16 * (j & 1); }
        if (n < 1792) return -1;
        return n - 96;
    }
    if (type == 2) {
        const int h = n / 96, c = n % 96; if (c < 64) return n; const int j = c - 64; return h * 96 + 64 + (j >> 1) + 16 * (j & 1);
    }
    return n;
}
__device__ __forceinline__ void wprep(const float* W, int K, int Nsrc, const float* g, bf16_t* dst, int Ndst, int type, size_t gtid, size_t gthreads) {
    const size_t total = (size_t)Ndst * (K / 8);
    for (size_t idx = gtid; idx < total; idx += gthreads) {
        const int n = (int)(idx % Ndst), kc = (int)(idx / Ndst);
        const int src = colmap(type, n);
        float v[8];
#pragma unroll
        for (int j = 0; j < 8; ++j) { const int k = kc * 8 + j; v[j] = src < 0 ? 0.f : W[(size_t)k * Nsrc + src] * (g ? g[k] : 1.f); }
        *(u32x4*)(dst + (size_t)n * K + kc * 8) = pack8(v);
    }
}

__device__ __forceinline__ void wprep_item(const float* W, int K, int Nsrc, const float* g, bf16_t* dst, int Ndst, int type, LAS float* scr, int item, int lane) {
    const int nblk = Ndst / 32, kb = item / nblk, nb = item % nblk, k0 = 64 * kb, n0 = 32 * nb;
    const int src = colmap(type, n0 + (lane & 31));
#pragma unroll 8
    for (int i = 0; i < 32; ++i) { const int kk = 2 * i + (lane >> 5); scr[kk * 33 + (lane & 31)] = src < 0 ? 0.f : W[(size_t)(k0 + kk) * Nsrc + src] * (g ? g[k0 + kk] : 1.f); }
    asm volatile("s_waitcnt lgkmcnt(0)" ::: "memory");
    const int c = lane & 7;
#pragma unroll
    for (int j = 0; j < 4; ++j) { const int n = (lane >> 3) + 8 * j; const LAS float* sp = scr + (8 * c) * 33 + n;
        u32x4 o; o.x = cvt_pk_bf16(sp[0 * 33], sp[1 * 33]); o.y = cvt_pk_bf16(sp[2 * 33], sp[3 * 33]); o.z = cvt_pk_bf16(sp[4 * 33], sp[5 * 33]); o.w = cvt_pk_bf16(sp[6 * 33], sp[7 * 33]);
        *(u32x4*)(dst + (size_t)(n0 + n) * K + k0 + 8 * c) = o; }
    asm volatile("s_waitcnt lgkmcnt(0)" ::: "memory");
}
constexpr int LDS_BYTES = 131072 + 1024 + 64;
constexpr int BARST_OFF = 131072 + 1024;
constexpr size_t WS_BAR = WS_W + 31 * MiB + 768 * 1024;
constexpr int STAG_P1 = 0, STAG_P4 = 0, STAG_P5 = 0, STAG_P6 = 0;
constexpr int N_PHASES = 1 + 6 * DEPTH + 1;

__global__ void __launch_bounds__(512, 2) fwd_megakernel(Params P) {
    extern __shared__ __attribute__((aligned(16))) unsigned char lds_raw[];
    LAS unsigned char* lds = (LAS unsigned char*)lds_raw;
    cg::grid_group grid = cg::this_grid();
    const int G = gridDim.x, bid = blockIdx.x;
    if (threadIdx.x < 2) ((LAS unsigned*)(lds + BARST_OFF))[threadIdx.x] = 0u;
    __syncthreads();
    XcdBarrier xbar; xbar.bar = (unsigned*)(P.ws + WS_BAR); xbar.x = 0; xbar.st = (volatile LAS unsigned*)(lds + BARST_OFF);
    unsigned char* ws = P.ws;
    bf16_t* Wb = (bf16_t*)(ws + WS_W);
    float* SSXA = (float*)(ws + WS_SSXA); float* SSXB = (float*)(ws + WS_SSXB); float* SSQ = (float*)(ws + WS_SSQ); float* SSKV = (float*)(ws + WS_SSKV);
    bf16_t* PB = (bf16_t*)(ws + WS_PB); bf16_t* XB = (bf16_t*)(ws + WS_XB); bf16_t* QB = (bf16_t*)(ws + WS_QB); bf16_t* KVB = (bf16_t*)(ws + WS_KVB); bf16_t* Z = (bf16_t*)(ws + WS_Z);
    const int lo = P.ph_lo, hi = P.ph_hi;
    int ph = 0;
    if (bid == 0) { unsigned* bw = (unsigned*)(P.ws + WS_BAR); for (int i = threadIdx.x; i < 4096 + 256; i += 512) bw[i] = 0u; }
#define PHASE_BEGIN if (ph >= lo && ph < hi) {
#if PROBE_SET
    unsigned long long* TS = (unsigned long long*)(ws + WS_W + 31 * MiB + 512 * 1024);
    if (bid == 0 && threadIdx.x == 0) TS[15] = __builtin_amdgcn_s_memrealtime();
#define PHASE_END   if (ph == 12 && bid == 0 && threadIdx.x == 0) TS[ph] = __builtin_amdgcn_s_memrealtime(); if (ph + 1 < hi) { if (ph == lo) { grid.sync(); xbar = xcd_barrier_post((unsigned*)(P.ws + WS_BAR), (volatile LAS unsigned*)(lds + BARST_OFF)); } else xcd_barrier(xbar); } if (ph < 12 && bid == 0 && threadIdx.x == 0) TS[ph] = __builtin_amdgcn_s_memrealtime(); } ++ph;
#else
#define PHASE_END   if (ph + 1 < hi && !(ph + 2 == N_PHASES && G == 256)) { if (ph == lo) { grid.sync(); xbar = xcd_barrier_post((unsigned*)(P.ws + WS_BAR), (volatile LAS unsigned*)(lds + BARST_OFF)); } else xcd_barrier(xbar); } } ++ph;
#endif

    PHASE_BEGIN
#if (PHMASK >> 0) & 1
    {
        int tid_ = threadIdx.x; asm volatile("" : "+v"(tid_)); const int tid = tid_, lane = tid & 63, wave = tid >> 6;
        const size_t gtid = (size_t)bid * 512 + tid, gthreads = (size_t)G * 512;
        {
            LAS float* scr = (LAS float*)(lds + wave * 16384);
            const int gwv = bid * 8 + wave, ngw = G * 8;
            constexpr int I_IN = 16 * 136, I_UQ = 4 * 24, I_UKV = 2 * 32, I_A = 8 * 32, I_OUT = 16 * 32, I_PP = 4 * 32, I_L = I_IN + I_UQ + I_UKV + 2 * I_A + 2 * I_OUT + I_PP;
            for (int it = gwv; it < DEPTH * I_L; it += ngw) {
                const int L = it / I_L; int r = it % I_L;
                bf16_t* wl = Wb + (size_t)L * WO_END;
                if (r < I_IN) { wprep_item(P.w_in + (size_t)L * 1024 * IN_WIDTH, 1024, IN_WIDTH, P.g_mix + L * 1024, wl + WO_IN, ZW, 1, scr, r, lane); continue; } r -= I_IN;
                if (r < I_UQ) { wprep_item(P.w_uq + (size_t)L * 256 * 768, 256, 768, P.g_q + L * 256, wl + WO_UQ, 768, 2, scr, r, lane); continue; } r -= I_UQ;
                if (r < I_UKV) { wprep_item(P.w_ukv + (size_t)L * 128 * 1024, 128, 1024, P.g_kv + L * 128, wl + WO_UKV, 1024, 0, scr, r, lane); continue; } r -= I_UKV;
                if (r < I_A) { wprep_item(P.w_br_a + (size_t)L * 512 * 1024, 512, 1024, nullptr, wl + WO_A, 1024, 0, scr, r, lane); continue; } r -= I_A;
                if (r < I_A) { wprep_item(P.w_br_b + (size_t)L * 512 * 1024, 512, 1024, nullptr, wl + WO_B, 1024, 0, scr, r, lane); continue; } r -= I_A;
                if (r < I_OUT) { wprep_item(P.w_out + (size_t)L * 1024 * 1024, 1024, 1024, nullptr, wl + WO_OUT, 1024, 0, scr, r, lane); continue; } r -= I_OUT;
                if (r < I_OUT) { wprep_item(P.w_ple_gate + (size_t)L * 1024 * 1024, 1024, 1024, P.g_ple + L * 1024, wl + WO_PG, 1024, 0, scr, r, lane); continue; } r -= I_OUT;
                wprep_item(P.w_ple_proj + (size_t)L * 256 * 1024, 256, 1024, nullptr, wl + WO_PP, 1024, 0, scr, r, lane);
            }
        }
        const int gw = bid * 8 + wave, NGW = G * 8;
        for (int r = gw; r < T; r += NGW) {
            const f32x4* xr = (const f32x4*)(P.x + (size_t)r * D);
            float s = 0.f;
#pragma unroll
            for (int j = 0; j < 2; ++j) { const f32x4 v = xr[2 * (lane + 64 * j)], w2 = xr[2 * (lane + 64 * j) + 1];
                s += ((v.x * v.x + v.y * v.y) + (v.z * v.z + v.w * v.w)) + ((w2.x * w2.x + w2.y * w2.y) + (w2.z * w2.z + w2.w * w2.w));
                u32x4 o; o.x = cvt_pk_bf16(v.x, v.y); o.y = cvt_pk_bf16(v.z, v.w); o.z = cvt_pk_bf16(w2.x, w2.y); o.w = cvt_pk_bf16(w2.z, w2.w); *((u32x4*)(XB + (size_t)r * D) + lane + 64 * j) = o; }
#pragma unroll
            for (int o = 1; o < 64; o <<= 1) s += __shfl_xor(s, o);
            if (lane < 16) SSXA[(size_t)r * 16 + lane] = lane == 0 ? s : 0.f;
        }
        const size_t np8 = (size_t)DEPTH * T * PLE / 8;
        for (size_t i = gtid; i < np8; i += gthreads) { const f32x4 a = *(const f32x4*)(P.p + i * 8), c = *(const f32x4*)(P.p + i * 8 + 4);
            u32x4 o; o.x = cvt_pk_bf16(a.x, a.y); o.y = cvt_pk_bf16(a.z, a.w); o.z = cvt_pk_bf16(c.x, c.y); o.w = cvt_pk_bf16(c.z, c.w); *(u32x4*)(PB + i * 8) = o; }
    }
#endif
    PHASE_END

#pragma unroll 1
    for (int L = 0; L < DEPTH; ++L) {
        const bf16_t* wl = Wb + (size_t)L * WO_END;
        PHASE_BEGIN
#if (PHMASK >> 1) & 1
        { int t_ = threadIdx.x; asm volatile("" : "+v"(t_)); if (t_ == 0) ((volatile LAS int*)(lds + 131072 + 1024 + 16))[0] = -1; }
        { pg8::Gemm g{XB, wl + WO_IN, T, ZW, 1024, 1024}; pg8::StaticOrder S; S.init(T, ZW, G, bid);
          EpiZ E{Z, SSXA, SSQ, SSKV, P.pos, lds}; pg8::gemm_phase(lds, g, S, E, STAG_P1); }
    #endif
    PHASE_END
        PHASE_BEGIN
#if (PHMASK >> 2) & 1
        { pg8::Gemm g{Z + ZC_BQD, wl + WO_UQ, T, 768, 256, ZW}; pg8::StaticOrder S; S.init(T, 768, G, bid);
          EpiQB E{QB, SSQ, P.pos, lds}; pg8::gemm_phase(lds, g, S, E); }
        { pg8::Gemm g{Z + ZC_BKVD, wl + WO_UKV, T, 1024, 128, ZW}; pg8::StaticOrder S; S.init(T, 1024, G, bid);
          EpiKVB E{KVB, SSKV, lds}; pg8::gemm_phase(lds, g, S, E); }
    #endif
    PHASE_END
        PHASE_BEGIN
#if (PHMASK >> 3) & 1
        {
            __syncthreads();
            att::attn_mode<0>(lds, QB, KVB, Z, P.pos, nullptr, bid, 2048, G);
            { const int u1 = bid + ((2048 - bid + G - 1) / G) * G; att::attn_mode<1>(lds, QB, KVB, Z, P.pos, P.sink + L * 8, u1, 4096, G); }
        }
    #endif
    PHASE_END
        PHASE_BEGIN
#if (PHMASK >> 4) & 1
        { pg8::Gemm g{Z + ZC_GA, wl + WO_A, T, 1024, 512, ZW}; pg8::Gemm g2{Z + ZC_GB, wl + WO_B, T, 1024, 512, ZW}; pg8::StaticOrder S; S.init(T, 1024, G, bid);
          EpiMerge<0> E{Z, KVB}; EpiMerge<1> E2{Z, KVB}; pg8::gemm_phase_pair(lds, g, g2, S, E, E2); }
    #endif
    PHASE_END
        PHASE_BEGIN
#if (PHMASK >> 5) & 1
        { pg8::Gemm g{KVB, wl + WO_OUT, T, 1024, 1024, 1024}; pg8::StaticOrder S; S.init(T, 1024, G, bid);
          EpiX1<1> E{P.x, XB, Z, SSXB}; pg8::gemm_phase(lds, g, S, E, STAG_P5); }
        { pg8::Gemm g{PB + (size_t)L * T * PLE, wl + WO_PP, T, 1024, 256, 256}; pg8::StaticOrder S; S.init(T, 1024, G, bid);
          EpiPP E{Z}; pg8::gemm_phase(lds, g, S, E); }
    #endif
    PHASE_END
        PHASE_BEGIN
#if (PHMASK >> 6) & 1
        { pg8::Gemm g{Z + ZC_X1B, wl + WO_PG, T, 1024, 1024, ZW}; pg8::StaticOrder S; S.init(T, 1024, G, bid);
          if (L + 1 == DEPTH && G == 256) { EpiX2F E{P.out, Z, SSXB, SSXA, P.g_final, (unsigned*)(P.ws + WS_BAR) + 4096, lds}; pg8::gemm_phase(lds, g, S, E, STAG_P6); }
          else { EpiX2 E{P.out, Z, XB, SSXB, SSXA, lds, L + 1 < DEPTH}; pg8::gemm_phase(lds, g, S, E, STAG_P6); } }
    #endif
    PHASE_END
    }
    PHASE_BEGIN
#if (PHMASK >> 7) & 1
    {
        int tid_ = threadIdx.x; asm volatile("" : "+v"(tid_)); const int tid = tid_, lane = tid & 63, wave = tid >> 6;
        const int gw = G == 256 ? T : bid * 8 + wave, NGW = G * 8;
#if PROBE_SET
        int krows = 0;
        { unsigned long long prev = TS[15], sel = 0; const unsigned long long t0 = prev;
          for (int k = 0; k <= 12; ++k) { const unsigned long long tk = TS[k]; if ((PROBE_SET >> k) & 1) sel += tk - prev; prev = tk; }
          krows = (int)((float)sel / (float)(prev - t0) * 4096.f + 0.5f); }
#endif
        for (int r = gw; r < T; r += NGW) {
            const float rstd = rsqrtf(sum16(SSXA + (size_t)r * 16) * (1.f / 1024.f) + EPS);
            f32x4* xr = (f32x4*)(P.out + (size_t)r * D) + lane; const f32x4* gr = (const f32x4*)P.g_final + lane; const u32x2* xbr = (const u32x2*)(XB + (size_t)r * D) + lane;
#pragma unroll
            for (int j = 0; j < 4; ++j) { const u32x2 xw = xbr[64 * j]; f32x4 v = (f32x4){bflo(xw.x), bfhi(xw.x), bflo(xw.y), bfhi(xw.y)}; const f32x4 gg = gr[64 * j]; v.x *= rstd * gg.x; v.y *= rstd * gg.y; v.z *= rstd * gg.z; v.w *= rstd * gg.w;
#if PROBE_SET
                if (r < krows) { v.x += 0.015f; v.y += 0.015f; v.z += 0.015f; v.w += 0.015f; }
#endif
                xr[64 * j] = v; }
        }
    }
#endif
    PHASE_END
#undef PHASE_BEGIN
#undef PHASE_END
}

extern "C" void kernel_launch(void* const* d_in, const int* in_sizes, int n_in, void* d_out, int out_size, void* d_ws, size_t ws_size, hipStream_t stream) {
    static int grid = 0;
    if (grid == 0) {
        if (n_in != 17 || in_sizes[0] != T * D || out_size != T * D || ws_size < WS_END) {
            fprintf(stderr, "kernel_launch: unexpected shapes/workspace: n_in %d in0 %d out %d ws %zu (need %zu)\n", n_in, n_in > 0 ? in_sizes[0] : -1, out_size, ws_size, (size_t)WS_END); grid = -1; return; }
        int dev = 0, cus = 0, per_cu = 0;
        hipGetDevice(&dev); hipDeviceGetAttribute(&cus, hipDeviceAttributeMultiprocessorCount, dev);
        if (hipFuncSetAttribute((const void*)fwd_megakernel, hipFuncAttributeMaxDynamicSharedMemorySize, LDS_BYTES) != hipSuccess) { fprintf(stderr, "kernel_launch: hipFuncSetAttribute failed\n"); grid = -1; return; }
        if (hipOccupancyMaxActiveBlocksPerMultiprocessor(&per_cu, (const void*)fwd_megakernel, 512, LDS_BYTES) != hipSuccess || per_cu < 1) { fprintf(stderr, "kernel_launch: occupancy query gave %d\n", per_cu); per_cu = 1; }
        (void)hipGetLastError();
        grid = cus * 1;
        fprintf(stderr, "kernel_launch: grid %d (cus %d, per_cu %d)\n", grid, cus, per_cu);
    }
    if (grid < 0) return;
    Params p{};
    p.x = (const float*)d_in[0]; p.p = (const float*)d_in[1]; p.pos = (const int*)d_in[2];
    p.g_mix = (const float*)d_in[3]; p.w_in = (const float*)d_in[4]; p.sink = (const float*)d_in[5]; p.g_q = (const float*)d_in[6]; p.w_uq = (const float*)d_in[7];
    p.g_kv = (const float*)d_in[8]; p.w_ukv = (const float*)d_in[9]; p.w_br_a = (const float*)d_in[10]; p.w_br_b = (const float*)d_in[11]; p.w_out = (const float*)d_in[12];
    p.g_ple = (const float*)d_in[13]; p.w_ple_gate = (const float*)d_in[14]; p.w_ple_proj = (const float*)d_in[15]; p.g_final = (const float*)d_in[16];
    p.out = (float*)d_out; p.ws = (unsigned char*)d_ws;
#if ONE_LAUNCH
    p.ph_lo = 0; p.ph_hi = N_PHASES;
    { void* args[] = {&p}; hipError_t e = hipLaunchCooperativeKernel((const void*)fwd_megakernel, dim3(grid), dim3(512), args, LDS_BYTES, stream);
      if (e != hipSuccess) fprintf(stderr, "cooperative launch failed: %s (grid %d)\n", hipGetErrorString(e), grid); }
#else
    for (int ph = 0; ph < N_PHASES; ++ph) {
        p.ph_lo = ph; p.ph_hi = ph + 1;
        void* args[] = {&p}; hipError_t e = hipLaunchCooperativeKernel((const void*)fwd_megakernel, dim3(grid), dim3(512), args, LDS_BYTES, stream);
        if (e != hipSuccess) { fprintf(stderr, "cooperative launch %d failed: %s (grid %d)\n", ph, hipGetErrorString(e), grid); break; }
    }
#endif
}
```
